# Optimizing an MI355X kernel written in HIP

```python
import jax, jax.numpy as jnp
from jax import lax
import numpy as np

D_MODEL = 1024
BATCH = 8
SEQ = 4096
DEPTH = 1

GRID_W = 64
EPS = 1e-6
NEG_INF = -1e30

NA_HEADS = 8
NA_HEAD_DIM = 64
NA_WIN_H = 8
NA_WIN_W = 16
NA_QBLOCK_W = 16
NA_BAND_W = NA_QBLOCK_W + NA_WIN_W
NA_WIDTH = NA_HEADS * NA_HEAD_DIM

MLA_HEADS = 8
MLA_QK_NOPE = 64
MLA_QK_ROPE = 32
MLA_V_DIM = 64
MLA_Q_LORA = 256
MLA_KV_LORA = 128
MLA_QBLOCK = 128
MLA_WIDTH = MLA_HEADS * MLA_V_DIM
ROPE_THETA = 10000.0

MIX_WIDTH = NA_WIDTH + MLA_WIDTH
D_IN = 3 * NA_WIDTH + MLA_Q_LORA + MLA_KV_LORA + MLA_QK_ROPE
D_FF = 2816

kernel_name = "hybrid_na_mla_macaron_block"


def rms_norm(x, g):
    xf = x.astype(jnp.float32)
    y = xf * lax.rsqrt(jnp.mean(xf * xf, axis=-1, keepdims=True) + EPS)
    return (y * g.astype(jnp.float32)).astype(x.dtype)


def swiglu(h, w_gu, w_down):
    gate, up = jnp.split(h @ w_gu, 2, axis=-1)
    return (jax.nn.silu(gate) * up) @ w_down


def grid_rope_tables(seq):
    t = jnp.arange(seq)
    row = (t // GRID_W).astype(jnp.float32)
    col = (t % GRID_W).astype(jnp.float32)
    n_freq = MLA_QK_ROPE // 4
    inv_freq = 1.0 / (ROPE_THETA ** (jnp.arange(n_freq, dtype=jnp.float32) / n_freq))
    ang = jnp.concatenate([row[:, None] * inv_freq[None, :], col[:, None] * inv_freq[None, :]], axis=-1)
    return jnp.cos(ang), jnp.sin(ang)


def apply_rope(x, cos, sin):
    xf = x.astype(jnp.float32)
    x1, x2 = jnp.split(xf, 2, axis=-1)
    return jnp.concatenate([x1 * cos - x2 * sin, x2 * cos + x1 * sin], axis=-1).astype(x.dtype)


def neighbourhood_attention(q, k, v, rpb):
    B, S, H, D = q.shape
    R = S // GRID_W
    KH = min(NA_WIN_H, R)
    NCB = GRID_W // NA_QBLOCK_W
    rows = jnp.arange(R)
    row_start = jnp.clip(rows - KH // 2, 0, R - KH)
    key_rows = row_start[:, None] + jnp.arange(KH)
    c0 = jnp.arange(NCB) * NA_QBLOCK_W
    band_start = jnp.clip(c0 - NA_WIN_W // 2, 0, GRID_W - NA_BAND_W)
    key_cols = band_start[:, None] + jnp.arange(NA_BAND_W)
    q_cols = c0[:, None] + jnp.arange(NA_QBLOCK_W)
    win_start = jnp.clip(q_cols - NA_WIN_W // 2, 0, GRID_W - NA_WIN_W)
    kc = key_cols[:, None, :]
    col_mask = (kc >= win_start[..., None]) & (kc < win_start[..., None] + NA_WIN_W)
    row_off = key_rows - rows[:, None] + (NA_WIN_H - 1)
    col_off = jnp.clip(kc - q_cols[:, :, None] + (NA_WIN_W - 1), 0, 2 * NA_WIN_W - 2)
    bias = rpb.astype(jnp.float32)[:, row_off[:, None, None, :, None], col_off[None, :, :, None, :]]
    bias = bias.transpose(1, 2, 0, 3, 4, 5)
    bias = jnp.where(col_mask[:, None, :, None, :], bias, NEG_INF)
    qg = q.reshape(B, R, NCB, NA_QBLOCK_W, H, D)
    ridx = key_rows[:, None, :, None]
    cidx = key_cols[None, :, None, :]
    kg = k.reshape(B, R, GRID_W, H, D)[:, ridx, cidx]
    vg = v.reshape(B, R, GRID_W, H, D)[:, ridx, cidx]
    s = jnp.einsum('brnqhd,brnijhd->brnhqij', qg, kg).astype(jnp.float32) * (D ** -0.5)
    s = s + bias[None]
    sh = s.shape
    p = jax.nn.softmax(s.reshape(sh[:-2] + (sh[-2] * sh[-1],)), axis=-1).reshape(sh)
    o = jnp.einsum('brnhqij,brnijhd->brnqhd', p.astype(v.dtype), vg)
    return o.reshape(B, S, H * D)


def latent_attention(c_q, c_kv, k_rope, q_norm_g, w_uq, kv_norm_g, w_ukv, cos, sin):
    B, S, _ = c_q.shape
    H = MLA_HEADS
    q = (rms_norm(c_q, q_norm_g) @ w_uq).reshape(B, S, H, MLA_QK_NOPE + MLA_QK_ROPE)
    q_nope, q_rot = jnp.split(q, [MLA_QK_NOPE], axis=-1)
    kv = (rms_norm(c_kv, kv_norm_g) @ w_ukv).reshape(B, S, H, MLA_QK_NOPE + MLA_V_DIM)
    k_nope, v = jnp.split(kv, [MLA_QK_NOPE], axis=-1)
    q_rot = apply_rope(q_rot, cos[:, None, :], sin[:, None, :])
    k_rot = apply_rope(k_rope, cos, sin)
    scale = (MLA_QK_NOPE + MLA_QK_ROPE) ** -0.5
    nqb = S // MLA_QBLOCK

    def block(args):
        qn, qr = args
        s = (jnp.einsum('bqhd,bkhd->bhqk', qn, k_nope)
             + jnp.einsum('bqhd,bkd->bhqk', qr, k_rot)).astype(jnp.float32) * scale
        p = jax.nn.softmax(s, axis=-1)
        return jnp.einsum('bhqk,bkhd->bqhd', p.astype(v.dtype), v)

    qn_b = q_nope.reshape(B, nqb, MLA_QBLOCK, H, MLA_QK_NOPE).swapaxes(0, 1)
    qr_b = q_rot.reshape(B, nqb, MLA_QBLOCK, H, MLA_QK_ROPE).swapaxes(0, 1)
    o = lax.map(block, (qn_b, qr_b))
    return o.swapaxes(0, 1).reshape(B, S, H * MLA_V_DIM)


def setup_inputs(seed: int = 0) -> dict:
    key = jax.random.key(seed)
    ks = iter(jax.random.split(key, 32))

    def w(shape, fan_in):
        return jax.random.normal(next(ks), shape, jnp.float32) * (fan_in ** -0.5)

    def gain(n):
        return 1.0 + 0.05 * jax.random.normal(next(ks), (DEPTH, n), jnp.float32)

    L = DEPTH
    return {
        "x": jax.random.normal(next(ks), (BATCH, SEQ, D_MODEL), jnp.float32),
        "ffn1_pre_g": gain(D_MODEL),
        "ffn1_w_gu": w((L, D_MODEL, 2 * D_FF), D_MODEL),
        "ffn1_w_down": w((L, D_FF, D_MODEL), D_FF),
        "ffn1_post_g": gain(D_MODEL),
        "mix_pre_g": gain(D_MODEL),
        "w_in": w((L, D_MODEL, D_IN), D_MODEL),
        "na_rpb": 0.1 * jax.random.normal(next(ks), (L, NA_HEADS, 2 * NA_WIN_H - 1, 2 * NA_WIN_W - 1), jnp.float32),
        "mla_q_norm_g": gain(MLA_Q_LORA),
        "mla_w_uq": w((L, MLA_Q_LORA, MLA_HEADS * (MLA_QK_NOPE + MLA_QK_ROPE)), MLA_Q_LORA),
        "mla_kv_norm_g": gain(MLA_KV_LORA),
        "mla_w_ukv": w((L, MLA_KV_LORA, MLA_HEADS * (MLA_QK_NOPE + MLA_V_DIM)), MLA_KV_LORA),
        "na_out_norm_g": gain(NA_WIDTH),
        "mla_out_norm_g": gain(MLA_WIDTH),
        "w_out": w((L, MIX_WIDTH, D_MODEL), MIX_WIDTH),
        "mix_post_g": gain(D_MODEL),
        "ffn2_pre_g": gain(D_MODEL),
        "ffn2_w_gu": w((L, D_MODEL, 2 * D_FF), D_MODEL),
        "ffn2_w_down": w((L, D_FF, D_MODEL), D_FF),
        "ffn2_post_g": gain(D_MODEL),
    }


def reference(x, ffn1_pre_g, ffn1_w_gu, ffn1_w_down, ffn1_post_g, mix_pre_g, w_in, na_rpb,
              mla_q_norm_g, mla_w_uq, mla_kv_norm_g, mla_w_ukv, na_out_norm_g, mla_out_norm_g,
              w_out, mix_post_g, ffn2_pre_g, ffn2_w_gu, ffn2_w_down, ffn2_post_g):
    B, S, _ = x.shape
    cos, sin = grid_rope_tables(S)
    split_at = [NA_WIDTH, 2 * NA_WIDTH, 3 * NA_WIDTH,
                3 * NA_WIDTH + MLA_Q_LORA, 3 * NA_WIDTH + MLA_Q_LORA + MLA_KV_LORA]
    h = x
    for l in range(DEPTH):
        f = swiglu(rms_norm(h, ffn1_pre_g[l]), ffn1_w_gu[l], ffn1_w_down[l])
        h = h + 0.5 * rms_norm(f, ffn1_post_g[l])
        z = rms_norm(h, mix_pre_g[l]) @ w_in[l]
        q_na, k_na, v_na, c_q, c_kv, k_rope = jnp.split(z, split_at, axis=-1)
        hs = (B, S, NA_HEADS, NA_HEAD_DIM)
        o_na = neighbourhood_attention(q_na.reshape(hs), k_na.reshape(hs), v_na.reshape(hs), na_rpb[l])
        o_mla = latent_attention(c_q, c_kv, k_rope, mla_q_norm_g[l], mla_w_uq[l],
                                 mla_kv_norm_g[l], mla_w_ukv[l], cos, sin)
        mixed = jnp.concatenate([rms_norm(o_na, na_out_norm_g[l]),
                                 rms_norm(o_mla, mla_out_norm_g[l])], axis=-1) @ w_out[l]
        h = h + rms_norm(mixed, mix_post_g[l])
        f = swiglu(rms_norm(h, ffn2_pre_g[l]), ffn2_w_gu[l], ffn2_w_down[l])
        h = h + 0.5 * rms_norm(f, ffn2_post_g[l])
    return h
```

```cpp
#include <hip/hip_runtime.h>
#include <hip/hip_cooperative_groups.h>
#include <cstdio>
namespace cg = cooperative_groups;
#include <cstdint>
namespace pg8 {
#define PG8_LAS __attribute__((address_space(3)))
typedef unsigned short bf16_t;
typedef short bf16x8 __attribute__((ext_vector_type(8)));
typedef float f32x4 __attribute__((ext_vector_type(4)));
typedef unsigned u32x4 __attribute__((ext_vector_type(4)));
constexpr int BM = 256, BK = 64, HALF = 128, HTB = HALF * BK * 2  , STAGE_BYTES = 8 * HTB, NXCD = 8, WGM = 8;

__host__ __device__ __forceinline__ int lds_byte(int r, int c) { const int st = (r >> 4) * 2 + (c >> 5), rr = r & 15, cc = c & 31, ob = rr * 64 + cc * 2; return st * 1024 + (ob ^ (((ob >> 9) & 1) << 5)); }
__host__ __device__ __forceinline__ void stage_rc(int b, int& R, int& C) { const int st = b / 1024, sb = b % 1024, swz = sb ^ (((sb >> 9) & 1) << 5); R = (st >> 1) * 16 + swz / 64; C = (st & 1) * 32 + (swz % 64) / 2; }
__host__ __device__ __forceinline__ int perm32(int rho) { const int n = rho >> 4, i = rho & 15; return 8 * (i >> 2) + 4 * n + (i & 3); }

struct Unit { int pm, pn; };
struct Gemm { const bf16_t* A; const bf16_t* Bt; int M, N, K; };

struct StaticOrder {
    int nM, nN, nwg, G, c;
    __host__ __device__ void init(int M, int N, int G_, int c_) { nM = M / BM; nN = N / BM; nwg = nM * nN; G = G_; c = c_; }
    __host__ __device__ bool next(int i, Unit& u) const {
        const long L = (long)i * G + c; if (L >= nwg) return false;
        int wgid = (int)L; { const int q = nwg / NXCD, r = nwg % NXCD, xcd = wgid % NXCD, off = wgid / NXCD; wgid = (xcd < r ? xcd * (q + 1) : r * (q + 1) + (xcd - r) * q) + off; }
        const int nig = WGM * nN, gid = wgid / nig, fm = gid * WGM, gsz = (nM - fm) < WGM ? (nM - fm) : WGM;
        u.pm = fm + ((wgid % nig) % gsz); u.pn = (wgid % nig) / gsz; return true;
    }
    __device__ __forceinline__ void a_ready(const Unit&) const {}
    __device__ __forceinline__ void done(const Unit&) const {}
};

__device__ __forceinline__ unsigned cvt_pk_bf16(float lo, float hi) { unsigned r; asm volatile("v_cvt_pk_bf16_f32 %0, %1, %2" : "=v"(r) : "v"(lo), "v"(hi)); return r; }
typedef float f32x2 __attribute__((ext_vector_type(2)));
__device__ __forceinline__ f32x2 gelu_pk(f32x2 v) {
    const f32x2 av = __builtin_elementwise_abs(v), d = av * 0.2316418882f + 1.0f;
    f32x2 t; t.x = __builtin_amdgcn_rcpf(d.x); t.y = __builtin_amdgcn_rcpf(d.y);
    f32x2 q = t * 0.5307027145f + (-0.7265760135f); q = q * t + 0.7107068705f; q = q * t + (-0.142248368f); q = q * t + 0.127414796f; q = q * t;
    const f32x2 s = (v * v) * (-0.72134752044f);
    f32x2 e; e.x = __builtin_amdgcn_exp2f(s.x); e.y = __builtin_amdgcn_exp2f(s.y);
    const f32x2 m = v * (q * e), r = v - m;
    f32x2 o; o.x = v.x < 0.f ? m.x : r.x; o.y = v.y < 0.f ? m.y : r.y; return o;
}

template <int ACT  > struct EpiBf16 {
    static constexpr bool PERM = true, AFTER_DRAIN = false; static_assert(ACT == 0 || ACT == 1, "EpiBf16: ACT is 0 (none) or 1 (gelu_pk)");
    bf16_t* O; int ldc; const float* bias; int split_cols; size_t split_stride; float scale0;
    __device__ __forceinline__ void operator()(const f32x4 (&acc)[2][2][4][2], const Unit& u, int wr, int wc, int fr, int fq) const {
        const int row0 = u.pm * BM + wr * 64 + fr; int colt = u.pn * BM; bf16_t* base = O;
        float sc = 1.f; if (split_cols) { const int t = colt / split_cols; base += (size_t)t * split_stride; colt -= t * split_cols; if (t == 0) sc = scale0; }
        const int col0 = colt + wc * 32 + 8 * fq, bcol0 = u.pn * BM + wc * 32 + 8 * fq;
        f32x4 bv[2][2];
#pragma unroll
        for (int bj = 0; bj < 2; ++bj)
#pragma unroll
            for (int n = 0; n < 2; ++n) bv[bj][n] = bias ? *(const f32x4*)(bias + bcol0 + bj * HALF + 4 * n) : (f32x4){0.f, 0.f, 0.f, 0.f};
#pragma unroll
        for (int ai = 0; ai < 2; ++ai)
#pragma unroll
            for (int m = 0; m < 4; ++m) { bf16_t* rowp = base + (size_t)(row0 + ai * HALF + m * 16) * ldc + col0;
#pragma unroll
                for (int bj = 0; bj < 2; ++bj) { f32x4 v0 = acc[ai][bj][m][0] + bv[bj][0], v1 = acc[ai][bj][m][1] + bv[bj][1];
                    if (ACT == 1) { f32x2 a = gelu_pk((f32x2){v0[0], v0[1]}), b = gelu_pk((f32x2){v0[2], v0[3]}), c = gelu_pk((f32x2){v1[0], v1[1]}), d = gelu_pk((f32x2){v1[2], v1[3]});
                        v0 = (f32x4){a.x, a.y, b.x, b.y}; v1 = (f32x4){c.x, c.y, d.x, d.y}; }
                    v0 = v0 * sc; v1 = v1 * sc; u32x4 w; w.x = cvt_pk_bf16(v0[0], v0[1]); w.y = cvt_pk_bf16(v0[2], v0[3]); w.z = cvt_pk_bf16(v1[0], v1[1]); w.w = cvt_pk_bf16(v1[2], v1[3]);
                    *(u32x4*)(rowp + bj * HALF) = w; } }
    }
};

struct PanelStats {
    unsigned* xbuf;
    unsigned* cnt;
    unsigned* tmo;
    int ntn; float eps;
    unsigned code;
    __device__ __forceinline__ bool run(const f32x4 (&v)[2][2][4][2], const Unit& u, int wr, int wc, int fr, int fq, PG8_LAS unsigned char* lds, int wid, int lane) const {
        typedef float f32x2v __attribute__((ext_vector_type(2)));
        PG8_LAS f32x2v* P = (PG8_LAS f32x2v*)lds;
        PG8_LAS f32x2v* S = (PG8_LAS f32x2v*)(lds + 8192);
        PG8_LAS unsigned* flag = (PG8_LAS unsigned*)(lds + 8192 + 2048);
#pragma unroll
        for (int ai = 0; ai < 2; ++ai)
#pragma unroll
            for (int m = 0; m < 4; ++m) {
                float s = 0.f;
#pragma unroll
                for (int bj = 0; bj < 2; ++bj)
#pragma unroll
                    for (int n = 0; n < 2; ++n) { const f32x4 x = v[ai][bj][m][n]; s += (x[0] + x[1]) + (x[2] + x[3]); }
                s += __shfl_xor(s, 16); s += __shfl_xor(s, 32);
                const float mw = s * (1.0f / 64.0f); float q = 0.f;
#pragma unroll
                for (int bj = 0; bj < 2; ++bj)
#pragma unroll
                    for (int n = 0; n < 2; ++n) { const f32x4 d = v[ai][bj][m][n] - mw; q += (d[0] * d[0] + d[1] * d[1]) + (d[2] * d[2] + d[3] * d[3]); }
                q += __shfl_xor(q, 16); q += __shfl_xor(q, 32);
                if (fq == 0) P[(ai * HALF + wr * 64 + m * 16 + fr) * 4 + wc] = (f32x2v){mw, q};
            }
        asm volatile("s_waitcnt lgkmcnt(0)" ::: "memory"); __builtin_amdgcn_s_barrier(); asm volatile("" ::: "memory");
#if defined(BROKEN_EXCHANGE_NO_WAIT)
#warning BROKEN CONTROL BUILD: the row-statistics exchange does not wait; results are wrong by design
        if (blockIdx.x >= 64) { const long long t0_ = clock64(); while (clock64() - t0_ < 60000) __builtin_amdgcn_s_sleep(8); }
#endif
        const int row = wid * 32 + (lane & 31);
        if (lane < 32) {
            const f32x2v a = P[row * 4 + 0], b = P[row * 4 + 1], c = P[row * 4 + 2], d = P[row * 4 + 3];
            const float mt = (a.x + b.x + c.x + d.x) * 0.25f;
            const float da = a.x - mt, db = b.x - mt, dc = c.x - mt, dd = d.x - mt;
            const float m2 = (a.y + b.y) + (c.y + d.y) + 64.0f * ((da * da + db * db) + (dc * dc + dd * dd));
            unsigned long long* slot = (unsigned long long*)xbuf + ((size_t)(u.pm * BM + row) * 4 + u.pn);
            __hip_atomic_store(slot, ((unsigned long long)__float_as_uint(m2) << 32) | __float_as_uint(mt), __ATOMIC_RELAXED, __HIP_MEMORY_SCOPE_AGENT);
        }
        asm volatile("s_waitcnt vmcnt(0)" ::: "memory");
        if (lane == 0) __hip_atomic_fetch_add(cnt + 64 * u.pm, 1u, __ATOMIC_RELAXED, __HIP_MEMORY_SCOPE_AGENT);
        if (wid == 0) {
            bool dead = false; const unsigned long long t0 = __builtin_amdgcn_s_memrealtime(); const unsigned want = 8u * (unsigned)ntn;
            for (;;) {
#if defined(BROKEN_EXCHANGE_NO_WAIT)
                break;
#endif
                if ((unsigned)__builtin_amdgcn_readfirstlane(__hip_atomic_load(cnt + 64 * u.pm, __ATOMIC_RELAXED, __HIP_MEMORY_SCOPE_AGENT)) >= want) break;
                if (__builtin_amdgcn_s_memrealtime() - t0 > 2000000ull) {
                    if (lane == 0) { unsigned expect = 0u; __hip_atomic_compare_exchange_strong(tmo + 1, &expect, code | (unsigned)(u.pm & 0xff), __ATOMIC_RELAXED, __ATOMIC_RELAXED, __HIP_MEMORY_SCOPE_AGENT);
                                     __hip_atomic_store(tmo, 1u, __ATOMIC_RELAXED, __HIP_MEMORY_SCOPE_AGENT); }
                    dead = true; break; }
                __builtin_amdgcn_s_sleep(2);
            }
            __builtin_amdgcn_fence(__ATOMIC_ACQUIRE, "agent");
            if (lane == 0) flag[0] = dead ? 1u : 0u;
        }
        asm volatile("s_waitcnt vmcnt(0) lgkmcnt(0)" ::: "memory"); __builtin_amdgcn_s_barrier(); asm volatile("" ::: "memory");
        const bool bad = flag[0] != 0u;
        if (lane < 32) {
            const unsigned long long* slot = (const unsigned long long*)xbuf + (size_t)(u.pm * BM + row) * 4; float mt[4], m2[4]; float ms = 0.f;
#pragma unroll
            for (int t = 0; t < 4; ++t) { if (t < ntn) { const unsigned long long w = __hip_atomic_load(slot + t, __ATOMIC_RELAXED, __HIP_MEMORY_SCOPE_AGENT); mt[t] = __uint_as_float((unsigned)w); m2[t] = __uint_as_float((unsigned)(w >> 32)); } else { mt[t] = 0.f; m2[t] = 0.f; } ms += mt[t]; }
            const float mean = ms / (float)ntn; float q = 0.f;
#pragma unroll
            for (int t = 0; t < 4; ++t) if (t < ntn) { const float dm = mt[t] - mean; q += m2[t] + 256.0f * dm * dm; }
            S[row] = (f32x2v){mean, 1.0f / sqrtf(q / (256.0f * (float)ntn) + eps)};
        }
        asm volatile("s_waitcnt lgkmcnt(0)" ::: "memory"); __builtin_amdgcn_s_barrier(); asm volatile("" ::: "memory");
        return bad;
    }
};
struct EpiLnRes {
    static constexpr bool PERM = false, AFTER_DRAIN = true;
    const float* base; float* out; int ldc; const float* bias; PanelStats st; unsigned poison;
    __device__ __forceinline__ void fused(f32x4 (&acc)[2][2][4][2], const Unit& u, int wr, int wc, int fr, int fq, PG8_LAS unsigned char* lds, int wid, int lane) const {
        typedef float f32x2v __attribute__((ext_vector_type(2)));
        const PG8_LAS f32x2v* S = (const PG8_LAS f32x2v*)(lds + 8192);
        const int col0 = u.pn * BM + wc * 32 + 4 * fq;
#pragma unroll
        for (int bj = 0; bj < 2; ++bj)
#pragma unroll
            for (int n = 0; n < 2; ++n) { const f32x4 bv = bias ? *(const f32x4*)(bias + col0 + bj * HALF + n * 16) : (f32x4){0.f, 0.f, 0.f, 0.f};
#pragma unroll
                for (int ai = 0; ai < 2; ++ai)
#pragma unroll
                    for (int m = 0; m < 4; ++m) acc[ai][bj][m][n] += bv; }
        f32x4 pre[4][2][2];
#pragma unroll
        for (int m = 0; m < 4; ++m) { const size_t off = (size_t)(u.pm * BM + wr * 64 + m * 16 + fr) * ldc + col0;
#pragma unroll
            for (int bj = 0; bj < 2; ++bj)
#pragma unroll
                for (int n = 0; n < 2; ++n) pre[m][bj][n] = *(const f32x4*)(base + off + bj * HALF + n * 16); }
        const bool bad = st.run(acc, u, wr, wc, fr, fq, lds, wid, lane) || poison != 0u;
        const float qnan = __builtin_nanf("");
#pragma unroll
        for (int ai = 0; ai < 2; ++ai)
#pragma unroll
            for (int m = 0; m < 4; ++m) { const int r = ai * HALF + wr * 64 + m * 16 + fr; const f32x2v sr = S[r]; const size_t off = (size_t)(u.pm * BM + r) * ldc + col0;
#pragma unroll
                for (int bj = 0; bj < 2; ++bj)
#pragma unroll
                    for (int n = 0; n < 2; ++n) { const f32x4 bs = ai == 0 ? pre[m][bj][n] : *(const f32x4*)(base + off + bj * HALF + n * 16); f32x4 o = bs + (acc[ai][bj][m][n] - sr.x) * sr.y;
                        if (bad) o = (f32x4){qnan, qnan, qnan, qnan}; *(f32x4*)(out + off + bj * HALF + n * 16) = o; }
                if (m & 1) asm volatile("" ::: "memory"); }
    }
};
struct EpiLnResLn {
    static constexpr bool PERM = false, AFTER_DRAIN = true;
    const float* base; float* out; bf16_t* xn; int ldc; const float* bias; PanelStats st1, st2; unsigned poison;
    __device__ __forceinline__ void fused(f32x4 (&acc)[2][2][4][2], const Unit& u, int wr, int wc, int fr, int fq, PG8_LAS unsigned char* lds, int wid, int lane) const {
        typedef float f32x2v __attribute__((ext_vector_type(2))); typedef unsigned u32x2v __attribute__((ext_vector_type(2)));
        const PG8_LAS f32x2v* S = (const PG8_LAS f32x2v*)(lds + 8192);
        const int col0 = u.pn * BM + wc * 32 + 4 * fq;
#pragma unroll
        for (int bj = 0; bj < 2; ++bj)
#pragma unroll
            for (int n = 0; n < 2; ++n) { const f32x4 bv = bias ? *(const f32x4*)(bias + col0 + bj * HALF + n * 16) : (f32x4){0.f, 0.f, 0.f, 0.f};
#pragma unroll
                for (int ai = 0; ai < 2; ++ai)
#pragma unroll
                    for (int m = 0; m < 4; ++m) acc[ai][bj][m][n] += bv; }
        bool bad = st1.run(acc, u, wr, wc, fr, fq, lds, wid, lane) || poison != 0u;
        const float qnan = __builtin_nanf("");
#pragma unroll
        for (int ai = 0; ai < 2; ++ai)
#pragma unroll
            for (int m = 0; m < 4; ++m) { const int r = ai * HALF + wr * 64 + m * 16 + fr; const f32x2v sr = S[r]; const size_t off = (size_t)(u.pm * BM + r) * ldc + col0;
#pragma unroll
                for (int bj = 0; bj < 2; ++bj)
#pragma unroll
                    for (int n = 0; n < 2; ++n) { const f32x4 bs = *(const f32x4*)(base + off + bj * HALF + n * 16); acc[ai][bj][m][n] = bs + (acc[ai][bj][m][n] - sr.x) * sr.y; }
                asm volatile("" : "+v"(acc[ai][0][m][0]), "+v"(acc[ai][0][m][1]), "+v"(acc[ai][1][m][0]), "+v"(acc[ai][1][m][1]));
                if (m & 1) asm volatile("" ::: "memory"); }
        const bool bad1 = bad;
        bad = st2.run(acc, u, wr, wc, fr, fq, lds, wid, lane) || bad;
#pragma unroll
        for (int ai = 0; ai < 2; ++ai)
#pragma unroll
            for (int m = 0; m < 4; ++m) { const int r = ai * HALF + wr * 64 + m * 16 + fr; const f32x2v sr = S[r]; const size_t off = (size_t)(u.pm * BM + r) * ldc + col0;
#pragma unroll
                for (int bj = 0; bj < 2; ++bj)
#pragma unroll
                    for (int n = 0; n < 2; ++n) { const f32x4 x1 = acc[ai][bj][m][n]; *(f32x4*)(out + off + bj * HALF + n * 16) = bad1 ? (f32x4){qnan, qnan, qnan, qnan} : x1;
                        const f32x4 o = (x1 - sr.x) * sr.y; u32x2v w; w.x = cvt_pk_bf16(o[0], o[1]); w.y = cvt_pk_bf16(o[2], o[3]);
                        if (bad) { w.x = 0x7fc07fc0u; w.y = 0x7fc07fc0u; } *(u32x2v*)(xn + off + bj * HALF + n * 16) = w; }
                asm volatile("" ::: "memory"); }
    }
};

template <class Epi, class Sched, bool ALIGN_EPI = false, bool SP2 = false>
__device__ __forceinline__ void gemm_phase(PG8_LAS unsigned char* lds, const Gemm g, const Sched& S, const Epi& E) {
    int tid_ = threadIdx.x; asm volatile("" : "+v"(tid_));
    const int tid = tid_, wid = __builtin_amdgcn_readfirstlane(tid >> 6), lane = tid & 63, wr = wid >> 2, wc = wid & 3, fr = lane & 15, fq = lane >> 4;
    int K_ = g.K; asm volatile("" : "+s"(K_)); const int K = K_, nt = K / BK;
    unsigned voffA[2], voffB[2];
#pragma unroll
    for (int i = 0; i < 2; ++i) { int R, C; stage_rc(tid * 16 + i * 8192, R, C); const int Rb = Epi::PERM ? ((R & ~31) + perm32(R & 31)) : R;
        voffA[i] = (unsigned)(R * K + C) * 2u; voffB[i] = (unsigned)(Rb * K + C) * 2u; }
    const size_t kstep = (size_t)(BK * 2);
    const size_t hstep = (size_t)HALF * K * 2;
    const size_t tstep = 2 * hstep;
    const unsigned ldsw = (unsigned)wid * 1024u;
    const int aoff = lds_byte(wr * 64 + fr, fq * 8), boff = lds_byte(wc * 32 + fr, fq * 8);
#define PG8_SA(b, h) (((b) * 2 + (h)) * HTB)
#define PG8_SB(b, h) ((4 + (b) * 2 + (h)) * HTB)
#define PG8_STAGE(bufoff, gbase, voff) do { _Pragma("unroll") for (int _i = 0; _i < 2; ++_i) \
        __builtin_amdgcn_global_load_lds((const unsigned*)((const char*)(gbase) + (voff)[_i]), (PG8_LAS unsigned*)(lds + (bufoff) + ldsw + _i * 8192), 16, 0, 0); } while (0)
#define PG8_LDA(dst, b, h) do { _Pragma("unroll") for (int m = 0; m < 4; ++m) _Pragma("unroll") for (int k = 0; k < 2; ++k) dst[m][k] = *(const PG8_LAS bf16x8*)(lds + PG8_SA(b, h) + aoff + m * 2048 + k * 1024); } while (0)
#define PG8_LDB(dst, b, h) do { _Pragma("unroll") for (int n = 0; n < 2; ++n) _Pragma("unroll") for (int k = 0; k < 2; ++k) dst[n][k] = *(const PG8_LAS bf16x8*)(lds + PG8_SB(b, h) + boff + n * 2048 + k * 1024); } while (0)
#define PG8_MMA(ai, bj, At, Bt) do { __builtin_amdgcn_s_setprio(1); _Pragma("unroll") for (int m = 0; m < 4; ++m) _Pragma("unroll") for (int n = 0; n < 2; ++n) _Pragma("unroll") for (int k = 0; k < 2; ++k) \
        acc[ai][bj][m][n] = __builtin_amdgcn_mfma_f32_16x16x32_bf16(Bt[n][k], At[m][k], acc[ai][bj][m][n], 0, 0, 0); __builtin_amdgcn_s_setprio(0); } while (0)
#define PG8_WAIT_V(n) asm volatile("s_waitcnt vmcnt(" #n ")" ::: "memory")
#define PG8_WAIT_L(n) asm volatile("s_waitcnt lgkmcnt(" #n ")" ::: "memory")
#define PG8_BAR __builtin_amdgcn_s_barrier()
#define PG8_SCHED __builtin_amdgcn_sched_barrier(0)
    Unit cur, nxt; int ui = 0;
    if (!S.next(0, cur)) return;
    f32x4 acc[2][2][4][2];
#pragma unroll
    for (int a = 0; a < 2; ++a)
#pragma unroll
        for (int b = 0; b < 2; ++b)
#pragma unroll
            for (int m = 0; m < 4; ++m)
#pragma unroll
                for (int n = 0; n < 2; ++n) acc[a][b][m][n] = (f32x4){0.f, 0.f, 0.f, 0.f};
    bf16x8 At[4][2], B0[2][2], B1[2][2];
    const char* cA = (const char*)g.A + (size_t)cur.pm * tstep; const char* cB = (const char*)g.Bt + (size_t)cur.pn * tstep;
    S.a_ready(cur);
    if constexpr (SP2) {
        PG8_STAGE(PG8_SB(0, 0), cB, voffB); PG8_STAGE(PG8_SB(0, 1), cB + hstep, voffB); PG8_STAGE(PG8_SA(0, 0), cA, voffA); PG8_STAGE(PG8_SA(0, 1), cA + hstep, voffA);
        if (wr == 1) PG8_BAR;
        PG8_WAIT_V(2); PG8_BAR;
        PG8_STAGE(PG8_SB(1, 0), cB + kstep, voffB); PG8_STAGE(PG8_SA(1, 0), cA + kstep, voffA); PG8_STAGE(PG8_SB(1, 1), cB + hstep + kstep, voffB);
        PG8_WAIT_V(6); PG8_BAR;
    } else {
        PG8_STAGE(PG8_SB(0, 0), cB, voffB); PG8_STAGE(PG8_SA(0, 0), cA, voffA); PG8_STAGE(PG8_SB(0, 1), cB + hstep, voffB); PG8_STAGE(PG8_SA(0, 1), cA + hstep, voffA);
        if (wr == 1) PG8_BAR;
        PG8_WAIT_V(4); PG8_BAR;
        PG8_STAGE(PG8_SB(1, 0), cB + kstep, voffB); PG8_STAGE(PG8_SA(1, 0), cA + kstep, voffA); PG8_STAGE(PG8_SB(1, 1), cB + hstep + kstep, voffB);
        PG8_WAIT_V(6); PG8_BAR;
    }
    for (;;) {
        const bool has_next = S.next(ui + 1, nxt);
        const char* nA = has_next ? (const char*)g.A + (size_t)nxt.pm * tstep : cA; const char* nB = has_next ? (const char*)g.Bt + (size_t)nxt.pn * tstep : cB;
        for (int t = 0; t < nt; t += 2) {
            const bool last = (t == nt - 2);
            const char* a1 = cA + (size_t)(t + 1) * kstep;
            const char* a2 = last ? nA : cA + (size_t)(t + 2) * kstep; const char* b2 = last ? nB : cB + (size_t)(t + 2) * kstep;
            const char* a3 = a2 + kstep; const char* b3 = b2 + kstep;
            if (last && has_next) S.a_ready(nxt);
            if constexpr (SP2) {
            PG8_LDB(B0, 0, 0); PG8_LDB(B1, 0, 1); PG8_SCHED; PG8_LDA(At, 0, 0); PG8_STAGE(PG8_SA(1, 1), a1 + hstep, voffA);
            PG8_WAIT_V(8); PG8_WAIT_L(0); PG8_BAR; PG8_MMA(0, 0, At, B0); PG8_MMA(0, 1, At, B1); PG8_BAR; PG8_SCHED;
            PG8_LDA(At, 0, 1); PG8_STAGE(PG8_SB(0, 0), b2, voffB); PG8_STAGE(PG8_SB(0, 1), b2 + hstep, voffB); PG8_STAGE(PG8_SA(0, 0), a2, voffA);
            PG8_WAIT_V(8); PG8_WAIT_L(0); PG8_BAR; PG8_MMA(1, 0, At, B0); PG8_MMA(1, 1, At, B1); PG8_BAR; PG8_SCHED;
            PG8_LDB(B0, 1, 0); PG8_LDB(B1, 1, 1); PG8_SCHED; PG8_LDA(At, 1, 0); PG8_STAGE(PG8_SA(0, 1), a2 + hstep, voffA);
            PG8_WAIT_V(8); PG8_WAIT_L(0); PG8_BAR; PG8_MMA(0, 0, At, B0); PG8_MMA(0, 1, At, B1); PG8_BAR; PG8_SCHED;
            PG8_LDA(At, 1, 1); PG8_STAGE(PG8_SB(1, 0), b3, voffB); PG8_STAGE(PG8_SB(1, 1), b3 + hstep, voffB); PG8_STAGE(PG8_SA(1, 0), a3, voffA);
            PG8_WAIT_V(8); PG8_WAIT_L(0); PG8_BAR; PG8_MMA(1, 0, At, B0); PG8_MMA(1, 1, At, B1); PG8_BAR; PG8_SCHED;
            } else {
            PG8_LDB(B0, 0, 0); PG8_SCHED; PG8_LDA(At, 0, 0); PG8_STAGE(PG8_SA(1, 1), a1 + hstep, voffA);
            PG8_WAIT_L(8); PG8_BAR; PG8_WAIT_L(0); PG8_MMA(0, 0, At, B0); PG8_BAR; PG8_SCHED;
            PG8_LDB(B1, 0, 1); PG8_STAGE(PG8_SB(0, 0), b2, voffB);
            PG8_BAR; PG8_WAIT_L(0); PG8_MMA(0, 1, At, B1); PG8_BAR;
            PG8_LDA(At, 0, 1); PG8_STAGE(PG8_SA(0, 0), a2, voffA);
            PG8_BAR; PG8_WAIT_L(0); PG8_MMA(1, 0, At, B0); PG8_BAR; PG8_SCHED;
            PG8_STAGE(PG8_SB(0, 1), b2 + hstep, voffB);
            PG8_WAIT_V(6); PG8_BAR; PG8_MMA(1, 1, At, B1); PG8_BAR;
            PG8_LDB(B0, 1, 0); PG8_SCHED; PG8_LDA(At, 1, 0); PG8_STAGE(PG8_SA(0, 1), a2 + hstep, voffA);
            PG8_WAIT_L(8); PG8_BAR; PG8_WAIT_L(0); PG8_MMA(0, 0, At, B0); PG8_BAR; PG8_SCHED;
            PG8_LDB(B1, 1, 1); PG8_STAGE(PG8_SB(1, 0), b3, voffB);
            PG8_BAR; PG8_WAIT_L(0); PG8_MMA(0, 1, At, B1); PG8_BAR;
            PG8_LDA(At, 1, 1); PG8_STAGE(PG8_SA(1, 0), a3, voffA);
            PG8_BAR; PG8_WAIT_L(0); PG8_MMA(1, 0, At, B0); PG8_BAR; PG8_SCHED;
            PG8_STAGE(PG8_SB(1, 1), b3 + hstep, voffB);
            PG8_WAIT_V(6); PG8_BAR; PG8_MMA(1, 1, At, B1); PG8_BAR;
            }
        }
        if constexpr (ALIGN_EPI) { if (wr == 0) PG8_BAR; }
        if constexpr (!Epi::AFTER_DRAIN) { E(acc, cur, wr, wc, fr, fq); S.done(cur); }
        if (!has_next) break;
#pragma unroll
        for (int a = 0; a < 2; ++a)
#pragma unroll
            for (int b = 0; b < 2; ++b)
#pragma unroll
                for (int m = 0; m < 4; ++m)
#pragma unroll
                    for (int n = 0; n < 2; ++n) acc[a][b][m][n] = (f32x4){0.f, 0.f, 0.f, 0.f};
        cur = nxt; cA = nA; cB = nB; ++ui;
        if constexpr (ALIGN_EPI) { if (wr == 1) PG8_BAR; }
    }
    PG8_WAIT_V(0);
    if constexpr (!ALIGN_EPI) { if (wr == 0) PG8_BAR; }
    PG8_BAR;
    if constexpr (Epi::AFTER_DRAIN) { E.fused(acc, cur, wr, wc, fr, fq, lds, wid, lane); S.done(cur); }
#undef PG8_SA
#undef PG8_SB
#undef PG8_STAGE
#undef PG8_LDA
#undef PG8_LDB
#undef PG8_MMA
#undef PG8_WAIT_V
#undef PG8_WAIT_L
#undef PG8_BAR
#undef PG8_SCHED
}
}

#ifndef PG8_SP2
#define PG8_SP2 true
#endif
#ifndef PG8_ALIGN
#define PG8_ALIGN true
#endif

namespace mk {
using pg8::bf16_t; using pg8::f32x4; using pg8::u32x4; using pg8::Unit; using pg8::BM; using pg8::HALF; using pg8::bf16x8;
#define LAS __attribute__((address_space(3)))
typedef unsigned u32x2 __attribute__((ext_vector_type(2)));
typedef float f32x2 __attribute__((ext_vector_type(2)));
typedef float f32x16 __attribute__((ext_vector_type(16)));

constexpr int M = 32768, D = 1024, FF = 2816, NGU = 5632, DIN = 1952, DINP = 2048, SEQ = 4096;
constexpr float EPS = 1e-6f;
constexpr float LOG2E = 1.4426950408889634f;
constexpr float QSCALE = 0.10206207261596577f * 1.4426950408889634f;

constexpr size_t MiB = 1u << 20;
constexpr size_t WS_CS = 0;
constexpr size_t WS_WGU1 = 1 * MiB, WS_WD1 = 12 * MiB, WS_WIN = 18 * MiB, WS_WUQ = 22 * MiB, WS_WUKV = 22 * MiB + 512 * 1024,
                 WS_WOUT = 23 * MiB, WS_WGU2 = 25 * MiB, WS_WD2 = 36 * MiB;
constexpr size_t WS_XN = 49 * MiB;
constexpr size_t WS_F = 113 * MiB;
constexpr size_t WS_H = 177 * MiB;
constexpr size_t WS_QM = 305 * MiB;
constexpr size_t WS_KM = 353 * MiB;
constexpr size_t WS_VM = 401 * MiB;
constexpr size_t WS_CQN = 433 * MiB;
constexpr size_t WS_CKVN = 449 * MiB;
constexpr size_t WS_END = 457 * MiB;

constexpr int LDS_BYTES = 147456;

__device__ __forceinline__ float bf_lo(unsigned w) { return __uint_as_float(w << 16); }
__device__ __forceinline__ float bf_hi(unsigned w) { return __uint_as_float(w & 0xffff0000u); }
__device__ __forceinline__ unsigned pk(float lo, float hi) { return pg8::cvt_pk_bf16(lo, hi); }
__device__ __forceinline__ float wave_sum(float v) {
#pragma unroll
    for (int o = 1; o < 64; o <<= 1) v += __shfl_xor(v, o);
    return v;
}
__device__ __forceinline__ float dot4(f32x4 a) { return (a[0] * a[0] + a[1] * a[1]) + (a[2] * a[2] + a[3] * a[3]); }

struct EpiSwiGLU {
    static constexpr bool PERM = true, AFTER_DRAIN = false;
    bf16_t* O; int ldc;
    __device__ __forceinline__ void operator()(const f32x4 (&acc)[2][2][4][2], const Unit& u, int wr, int wc, int fr, int fq) const {
        const int row0 = u.pm * BM + wr * 64 + fr; const int col0 = u.pn * 128 + wc * 32 + 8 * fq;
#pragma unroll
        for (int ai = 0; ai < 2; ++ai)
#pragma unroll
            for (int m = 0; m < 4; ++m) {
                bf16_t* rowp = O + (size_t)(row0 + ai * HALF + m * 16) * ldc + col0;
                float r[8];
#pragma unroll
                for (int n = 0; n < 2; ++n)
#pragma unroll
                    for (int j = 0; j < 4; ++j) { const float g = acc[ai][0][m][n][j], up = acc[ai][1][m][n][j];
                        const float e = __builtin_amdgcn_exp2f(-g * LOG2E); r[4 * n + j] = g * __builtin_amdgcn_rcpf(1.0f + e) * up; }
                u32x4 w; w.x = pk(r[0], r[1]); w.y = pk(r[2], r[3]); w.z = pk(r[4], r[5]); w.w = pk(r[6], r[7]);
                *(u32x4*)rowp = w;
            }
    }
};
struct EpiKV {
    static constexpr bool PERM = true, AFTER_DRAIN = false;
    bf16_t* Km; bf16_t* Vm;
    __device__ __forceinline__ void operator()(const f32x4 (&acc)[2][2][4][2], const Unit& u, int wr, int wc, int fr, int fq) const {
        const int row0 = u.pm * BM + wr * 64 + fr;
#pragma unroll
        for (int bj = 0; bj < 2; ++bj) {
            const int colt = u.pn * BM + bj * HALF + wc * 32 + 8 * fq;
            bf16_t* base; int ld;
            if (colt < 512) { base = Km + 96 * (colt >> 6) + (colt & 63); ld = 768; } else { base = Vm + (colt - 512); ld = 512; }
#pragma unroll
            for (int ai = 0; ai < 2; ++ai)
#pragma unroll
                for (int m = 0; m < 4; ++m) { const f32x4 v0 = acc[ai][bj][m][0], v1 = acc[ai][bj][m][1];
                    u32x4 w; w.x = pk(v0[0], v0[1]); w.y = pk(v0[2], v0[3]); w.z = pk(v1[0], v1[1]); w.w = pk(v1[2], v1[3]);
                    *(u32x4*)(base + (size_t)(row0 + ai * HALF + m * 16) * ld) = w; }
        }
    }
};
struct EpiQ {
    static constexpr bool PERM = false, AFTER_DRAIN = false;
    bf16_t* O; const f32x2* cs;
    __device__ __forceinline__ void operator()(const f32x4 (&acc)[2][2][4][2], const Unit& u, int wr, int wc, int fr, int fq) const {
        const int row0 = u.pm * BM + wr * 64 + fr;
#pragma unroll
        for (int bj = 0; bj < 2; ++bj) {
            const int g32 = u.pn * 8 + bj * 4 + wc; const bool rot = (g32 % 3) == 2; const int cbase = g32 * 32 + 4 * fq;
#pragma unroll
            for (int ai = 0; ai < 2; ++ai)
#pragma unroll
                for (int m = 0; m < 4; ++m) {
                    const int row = row0 + ai * HALF + m * 16;
                    f32x4 x0 = acc[ai][bj][m][0], x1 = acc[ai][bj][m][1];
                    if (rot) { const int t = row & (SEQ - 1); const int pos = (fq < 2) ? (t >> 6) : (t & 63); const f32x2* cp = cs + pos * 8 + 4 * (fq & 1);
                        f32x4 y0, y1;
#pragma unroll
                        for (int j = 0; j < 4; ++j) { const f32x2 c = cp[j]; y0[j] = x0[j] * c.x - x1[j] * c.y; y1[j] = x1[j] * c.x + x0[j] * c.y; }
                        x0 = y0; x1 = y1; }
                    x0 = x0 * QSCALE; x1 = x1 * QSCALE;
                    bf16_t* p = O + (size_t)row * 768 + cbase;
                    u32x2 w0; w0.x = pk(x0[0], x0[1]); w0.y = pk(x0[2], x0[3]); u32x2 w1; w1.x = pk(x1[0], x1[1]); w1.y = pk(x1[2], x1[3]);
                    *(u32x2*)p = w0; *(u32x2*)(p + 16) = w1;
                    asm volatile("" ::: "memory");
                }
        }
    }
};

__device__ __forceinline__ void row_norm_to_bf16(const float* xrow, const float* g, bf16_t* orow, int lane) {
    const f32x4* xr = (const f32x4*)xrow + lane; const f32x4* gr = (const f32x4*)g + lane;
    f32x4 v[4]; float s = 0.f;
#pragma unroll
    for (int j = 0; j < 4; ++j) { v[j] = xr[64 * j]; s += dot4(v[j]); }
    const float rstd = 1.0f / sqrtf(wave_sum(s) * (1.0f / D) + EPS);
#pragma unroll
    for (int j = 0; j < 4; ++j) { const f32x4 o = v[j] * rstd * gr[64 * j]; u32x2 w; w.x = pk(o[0], o[1]); w.y = pk(o[2], o[3]); ((u32x2*)orow)[lane + 64 * j] = w; }
}
template <bool WRITE_XN>
__device__ __forceinline__ void row_mid(const bf16_t* frow, const float* resrow, float* outrow, const float* gpost, float coef, const float* gpre, bf16_t* xnrow, int lane) {
    f32x4 f[4]; float s = 0.f;
#pragma unroll
    for (int j = 0; j < 4; ++j) { const u32x2 w = ((const u32x2*)frow)[lane + 64 * j]; f[j] = (f32x4){bf_lo(w.x), bf_hi(w.x), bf_lo(w.y), bf_hi(w.y)}; s += dot4(f[j]); }
    const float rstd = 1.0f / sqrtf(wave_sum(s) * (1.0f / D) + EPS) * coef;
    float s2 = 0.f;
#pragma unroll
    for (int j = 0; j < 4; ++j) { const f32x4 gp = ((const f32x4*)gpost)[lane + 64 * j]; const f32x4 r = ((const f32x4*)resrow)[lane + 64 * j];
        f[j] = r + f[j] * rstd * gp; ((f32x4*)outrow)[lane + 64 * j] = f[j]; s2 += dot4(f[j]); }
    if (WRITE_XN) {
        const float rstd2 = 1.0f / sqrtf(wave_sum(s2) * (1.0f / D) + EPS);
#pragma unroll
        for (int j = 0; j < 4; ++j) { const f32x4 o = f[j] * rstd2 * ((const f32x4*)gpre)[lane + 64 * j]; u32x2 w; w.x = pk(o[0], o[1]); w.y = pk(o[2], o[3]); ((u32x2*)xnrow)[lane + 64 * j] = w; }
    }
}
__device__ __forceinline__ void row_onorm(bf16_t* orow, const float* gna, const float* gmla, int lane) {
    f32x4 f[4]; float sa = 0.f, sb = 0.f;
#pragma unroll
    for (int j = 0; j < 4; ++j) { const u32x2 w = ((const u32x2*)orow)[lane + 64 * j]; f[j] = (f32x4){bf_lo(w.x), bf_hi(w.x), bf_lo(w.y), bf_hi(w.y)}; if (j < 2) sa += dot4(f[j]); else sb += dot4(f[j]); }
    const float ra = 1.0f / sqrtf(wave_sum(sa) * (1.0f / 512.0f) + EPS), rb = 1.0f / sqrtf(wave_sum(sb) * (1.0f / 512.0f) + EPS);
#pragma unroll
    for (int j = 0; j < 4; ++j) { const f32x4 g = (j < 2) ? ((const f32x4*)gna)[lane + 64 * j] : ((const f32x4*)gmla)[lane + 64 * (j - 2)];
        const f32x4 o = f[j] * ((j < 2) ? ra : rb) * g; u32x2 w; w.x = pk(o[0], o[1]); w.y = pk(o[2], o[3]); ((u32x2*)orow)[lane + 64 * j] = w; }
}
__device__ __forceinline__ void mla_prep_row(const bf16_t* zrow, int row, const float* gq, const float* gkv, const f32x2* cs, bf16_t* cqn, bf16_t* ckvn, bf16_t* km, int lane) {
    const u32x2 wq = ((const u32x2*)(zrow + 1536))[lane];
    const float q0 = bf_lo(wq.x), q1 = bf_hi(wq.x), q2 = bf_lo(wq.y), q3 = bf_hi(wq.y);
    const float rq = 1.0f / sqrtf(wave_sum((q0 * q0 + q1 * q1) + (q2 * q2 + q3 * q3)) * (1.0f / 256.0f) + EPS);
    const unsigned wk = ((const unsigned*)(zrow + 1792))[lane];
    const float k0 = bf_lo(wk), k1 = bf_hi(wk);
    const float rk = 1.0f / sqrtf(wave_sum(k0 * k0 + k1 * k1) * (1.0f / 128.0f) + EPS);
    const f32x4 g = ((const f32x4*)gq)[lane];
    u32x2 o; o.x = pk(q0 * rq * g[0], q1 * rq * g[1]); o.y = pk(q2 * rq * g[2], q3 * rq * g[3]);
    ((u32x2*)(cqn + (size_t)row * 256))[lane] = o;
    const f32x2 g2 = ((const f32x2*)gkv)[lane];
    ((unsigned*)(ckvn + (size_t)row * 128))[lane] = pk(k0 * rk * g2.x, k1 * rk * g2.y);
    if (lane < 16) {
        const int i = lane; const float x1 = bf_lo((unsigned)zrow[1920 + i]), x2 = bf_lo((unsigned)zrow[1936 + i]);
        const int t = row & (SEQ - 1); const int pos = (i < 8) ? (t >> 6) : (t & 63); const f32x2 c = cs[pos * 8 + (i & 7)];
        const unsigned y = pk(x1 * c.x - x2 * c.y, x2 * c.x + x1 * c.y);
        bf16_t* kp = km + (size_t)row * 768 + 64 + i;
#pragma unroll
        for (int h = 0; h < 8; ++h) { kp[96 * h] = (bf16_t)(y & 0xffffu); kp[96 * h + 16] = (bf16_t)(y >> 16); }
    }
}

__device__ __forceinline__ void transpose_item(const float* W, int K, int N, bf16_t* WT, int k0, int n0, int n0_out, LAS float* scr, int lane) {
#pragma unroll 8
    for (int i = 0; i < 32; ++i) { const int kk = 2 * i + (lane >> 5); scr[kk * 33 + (lane & 31)] = W[(size_t)(k0 + kk) * N + n0 + (lane & 31)]; }
    asm volatile("s_waitcnt lgkmcnt(0)" ::: "memory");
    const int c = lane & 7;
#pragma unroll
    for (int j = 0; j < 4; ++j) { const int n = (lane >> 3) + 8 * j; const LAS float* s = scr + (8 * c) * 33 + n;
        u32x4 o; o.x = pk(s[0 * 33], s[1 * 33]); o.y = pk(s[2 * 33], s[3 * 33]); o.z = pk(s[4 * 33], s[5 * 33]); o.w = pk(s[6 * 33], s[7 * 33]);
        *(u32x4*)(WT + (size_t)(n0_out + n) * K + k0 + 8 * c) = o; }
    asm volatile("s_waitcnt lgkmcnt(0)" ::: "memory");
}
__device__ __forceinline__ int remap_gu(int n0) { if (n0 < FF) return 256 * (n0 >> 7) + (n0 & 127); const int m = n0 - FF; return 256 * (m >> 7) + 128 + (m & 127); }
__device__ __forceinline__ int remap_kv(int n0) { const int h = n0 >> 7, j = n0 & 127; return (j < 64) ? (64 * h + j) : (512 + 64 * h + (j - 64)); }

#define UNPK8(dst, off, w) do { dst[(off) + 0] = bf_lo(w.x); dst[(off) + 1] = bf_hi(w.x); dst[(off) + 2] = bf_lo(w.y); dst[(off) + 3] = bf_hi(w.y); \
    dst[(off) + 4] = bf_lo(w.z); dst[(off) + 5] = bf_hi(w.z); dst[(off) + 6] = bf_lo(w.w); dst[(off) + 7] = bf_hi(w.w); } while (0)
__device__ __forceinline__ float dot8(const float* q, u32x4 w) {
    return (q[0] * bf_lo(w.x) + q[1] * bf_hi(w.x)) + (q[2] * bf_lo(w.y) + q[3] * bf_hi(w.y)) + (q[4] * bf_lo(w.z) + q[5] * bf_hi(w.z)) + (q[6] * bf_lo(w.w) + q[7] * bf_hi(w.w));
}
__device__ __forceinline__ void mla_naive(LAS unsigned char* lds, const bf16_t* Qm, const bf16_t* Km, const bf16_t* Vm, bf16_t* O, int unit) {
    int tid = threadIdx.x; asm volatile("" : "+v"(tid)); const int b = unit >> 6, h = (unit >> 3) & 7, qb = unit & 7;
    const size_t row = (size_t)b * SEQ + qb * 512 + tid;
    float q[96];
    { const u32x4* qp = (const u32x4*)(Qm + row * 768 + 96 * h);
#pragma unroll
      for (int c = 0; c < 12; ++c) { const u32x4 w = qp[c]; UNPK8(q, 8 * c, w); } }
    float o[64];
#pragma unroll
    for (int d = 0; d < 64; ++d) o[d] = 0.f;
    float mx = -1e30f, l = 0.f;
    LAS bf16_t* LK = (LAS bf16_t*)lds; LAS bf16_t* LV = (LAS bf16_t*)(lds + 12288);
#pragma unroll 1
    for (int kt = 0; kt < 64; ++kt) {
        __syncthreads();
        const size_t krow0 = (size_t)b * SEQ + kt * 64;
        for (int c = tid; c < 768; c += 512) { const int key = c / 12, ch = c % 12; *(LAS u32x4*)(LK + key * 96 + ch * 8) = *(const u32x4*)(Km + (krow0 + key) * 768 + 96 * h + ch * 8); }
        { const int key = tid >> 3, ch = tid & 7; *(LAS u32x4*)(LV + key * 64 + ch * 8) = *(const u32x4*)(Vm + (krow0 + key) * 512 + 64 * h + ch * 8); }
        __syncthreads();
#pragma unroll 1
        for (int key = 0; key < 64; ++key) {
            float s = 0.f;
#pragma unroll
            for (int c = 0; c < 12; ++c) { const u32x4 w = *(const LAS u32x4*)(LK + key * 96 + c * 8); s += dot8(q + 8 * c, w); }
            if (s > mx) { const float al = __builtin_amdgcn_exp2f(mx - s); l *= al;
#pragma unroll
                for (int d = 0; d < 64; ++d) o[d] *= al;
                mx = s; }
            const float p = __builtin_amdgcn_exp2f(s - mx); l += p;
#pragma unroll
            for (int c = 0; c < 8; ++c) { const u32x4 w = *(const LAS u32x4*)(LV + key * 64 + c * 8);
                o[8 * c + 0] += p * bf_lo(w.x); o[8 * c + 1] += p * bf_hi(w.x); o[8 * c + 2] += p * bf_lo(w.y); o[8 * c + 3] += p * bf_hi(w.y);
                o[8 * c + 4] += p * bf_lo(w.z); o[8 * c + 5] += p * bf_hi(w.z); o[8 * c + 6] += p * bf_lo(w.w); o[8 * c + 7] += p * bf_hi(w.w); }
        }
    }
    const float inv = 1.0f / l;
    u32x4* op = (u32x4*)(O + row * 1024 + 512 + 64 * h);
#pragma unroll
    for (int c = 0; c < 8; ++c) { u32x4 w; w.x = pk(o[8 * c] * inv, o[8 * c + 1] * inv); w.y = pk(o[8 * c + 2] * inv, o[8 * c + 3] * inv); w.z = pk(o[8 * c + 4] * inv, o[8 * c + 5] * inv); w.w = pk(o[8 * c + 6] * inv, o[8 * c + 7] * inv); op[c] = w; }
    __syncthreads();
}
__device__ __forceinline__ void na_naive(const bf16_t* Z, const float* rpb, bf16_t* O, int unit) {
    int tid = threadIdx.x; asm volatile("" : "+v"(tid)); const int h = tid >> 6, c = tid & 63; const int b = unit >> 6, r = unit & 63;
    const size_t tok = (size_t)b * SEQ + r * 64 + c;
    float q[64];
    { const u32x4* qp = (const u32x4*)(Z + tok * 2048 + 64 * h);
#pragma unroll
      for (int i = 0; i < 8; ++i) { const u32x4 w = qp[i]; UNPK8(q, 8 * i, w); } }
    const int rs = min(max(r - 4, 0), 56), ws = min(max(c - 8, 0), 48);
    float o[64];
#pragma unroll
    for (int d = 0; d < 64; ++d) o[d] = 0.f;
    float mx = -1e30f, l = 0.f;
#pragma unroll 1
    for (int kk = 0; kk < 128; ++kk) {
        const int kr = rs + (kk >> 4), kc = ws + (kk & 15);
        const size_t ktok = (size_t)b * SEQ + kr * 64 + kc;
        const u32x4* kp = (const u32x4*)(Z + ktok * 2048 + 512 + 64 * h);
        float s = 0.f;
#pragma unroll
        for (int i = 0; i < 8; ++i) s += dot8(q + 8 * i, kp[i]);
        s = (s * 0.125f + rpb[(h * 15 + (kr - r + 7)) * 31 + (kc - c + 15)]) * LOG2E;
        if (s > mx) { const float al = __builtin_amdgcn_exp2f(mx - s); l *= al;
#pragma unroll
            for (int d = 0; d < 64; ++d) o[d] *= al;
            mx = s; }
        const float p = __builtin_amdgcn_exp2f(s - mx); l += p;
        const u32x4* vp = (const u32x4*)(Z + ktok * 2048 + 1024 + 64 * h);
#pragma unroll
        for (int i = 0; i < 8; ++i) { const u32x4 w = vp[i];
            o[8 * i + 0] += p * bf_lo(w.x); o[8 * i + 1] += p * bf_hi(w.x); o[8 * i + 2] += p * bf_lo(w.y); o[8 * i + 3] += p * bf_hi(w.y);
            o[8 * i + 4] += p * bf_lo(w.z); o[8 * i + 5] += p * bf_hi(w.z); o[8 * i + 6] += p * bf_lo(w.w); o[8 * i + 7] += p * bf_hi(w.w); }
    }
    const float inv = 1.0f / l;
    u32x4* op = (u32x4*)(O + tok * 1024 + 64 * h);
#pragma unroll
    for (int i = 0; i < 8; ++i) { u32x4 w; w.x = pk(o[8 * i] * inv, o[8 * i + 1] * inv); w.y = pk(o[8 * i + 2] * inv, o[8 * i + 3] * inv); w.z = pk(o[8 * i + 4] * inv, o[8 * i + 5] * inv); w.w = pk(o[8 * i + 6] * inv, o[8 * i + 7] * inv); op[i] = w; }
}

constexpr int NPHASE = 14;
struct Args { const float* in[20]; float* out; unsigned char* ws; int ph_lo, ph_hi; };

__global__ void __launch_bounds__(512, 2) mk_fwd(Args a) {
    extern __shared__ __attribute__((aligned(16))) unsigned char lds_raw[];
    LAS unsigned char* lds = (LAS unsigned char*)lds_raw;
    cg::grid_group grid = cg::this_grid();
    const int G = gridDim.x, bx = blockIdx.x, NGW = G * 8;
#define TIDS int tid = threadIdx.x; asm volatile("" : "+v"(tid)); const int lane = tid & 63, wave = __builtin_amdgcn_readfirstlane(tid >> 6), gw = bx * 8 + wave; (void)lane; (void)gw
#define PTRS unsigned char* ws = a.ws; asm volatile("" : "+s"(ws)); const float* x = a.in[0]; float* out = a.out; f32x2* cs = (f32x2*)(ws + WS_CS); bf16_t* Wgu1 = (bf16_t*)(ws + WS_WGU1); bf16_t* Wd1 = (bf16_t*)(ws + WS_WD1); bf16_t* Win = (bf16_t*)(ws + WS_WIN); bf16_t* Wuq = (bf16_t*)(ws + WS_WUQ); bf16_t* Wukv = (bf16_t*)(ws + WS_WUKV); bf16_t* Wout = (bf16_t*)(ws + WS_WOUT); bf16_t* Wgu2 = (bf16_t*)(ws + WS_WGU2); bf16_t* Wd2 = (bf16_t*)(ws + WS_WD2); bf16_t* XN = (bf16_t*)(ws + WS_XN); bf16_t* Fb = (bf16_t*)(ws + WS_F); bf16_t* Hb = (bf16_t*)(ws + WS_H); bf16_t* Zb = (bf16_t*)(ws + WS_H); bf16_t* Qm = (bf16_t*)(ws + WS_QM); bf16_t* Km = (bf16_t*)(ws + WS_KM); bf16_t* Vm = (bf16_t*)(ws + WS_VM); bf16_t* CQN = (bf16_t*)(ws + WS_CQN); bf16_t* CKVN = (bf16_t*)(ws + WS_CKVN); (void)x; (void)out; (void)cs; (void)Wgu1; (void)Wd1; (void)Win; (void)Wuq; (void)Wukv; (void)Wout; (void)Wgu2; (void)Wd2; (void)XN; (void)Fb; (void)Hb; (void)Zb; (void)Qm; (void)Km; (void)Vm; (void)CQN; (void)CKVN
    const int lo = a.ph_lo, hi = a.ph_hi;
#ifndef PH_MASK
#define PH_MASK 0x3fff
#endif
#define IN(k) ((((PH_MASK) >> (k)) & 1) && lo <= (k) && (k) < hi)
#define SEAM(k) do { if (IN(k) && IN((k) + 1)) grid.sync(); } while (0)
    using SO = pg8::StaticOrder;

    if (IN(0)) { TIDS; PTRS;
        if (bx == 0) {
            const int pos = tid >> 3, f = tid & 7;
            const float inv = 1.0f / powf(10000.0f, (float)f * 0.125f);
            const float ang = (float)pos * inv;
            const float k = rintf(ang * 0.15915494309189535f);
            float r = fmaf(-k, 6.2831854820251465f, ang); r = fmaf(-k, -1.7484555e-7f, r);
            cs[tid] = (f32x2){__cosf(r), __sinf(r)};
        }
        LAS float* scr = (LAS float*)(lds + wave * 16384);
        constexpr int I_GU = 16 * 176, I_D = 44 * 32, I_IN = 16 * 61, I_UQ = 4 * 24, I_UKV = 2 * 32, I_OUT = 16 * 32;
        constexpr int NITEMS = 2 * I_GU + 2 * I_D + I_IN + I_UQ + I_UKV + I_OUT;
        for (int it = gw; it < NITEMS; it += NGW) {
            int r = it;
            if (r < I_GU) { const int kb = r / 176, nb = r % 176; transpose_item(a.in[2], D, NGU, Wgu1, 64 * kb, 32 * nb, remap_gu(32 * nb), scr, lane); continue; } r -= I_GU;
            if (r < I_GU) { const int kb = r / 176, nb = r % 176; transpose_item(a.in[17], D, NGU, Wgu2, 64 * kb, 32 * nb, remap_gu(32 * nb), scr, lane); continue; } r -= I_GU;
            if (r < I_D) { const int kb = r / 32, nb = r % 32; transpose_item(a.in[3], FF, D, Wd1, 64 * kb, 32 * nb, 32 * nb, scr, lane); continue; } r -= I_D;
            if (r < I_D) { const int kb = r / 32, nb = r % 32; transpose_item(a.in[18], FF, D, Wd2, 64 * kb, 32 * nb, 32 * nb, scr, lane); continue; } r -= I_D;
            if (r < I_IN) { const int kb = r / 61, nb = r % 61; transpose_item(a.in[6], D, DIN, Win, 64 * kb, 32 * nb, 32 * nb, scr, lane); continue; } r -= I_IN;
            if (r < I_UQ) { const int kb = r / 24, nb = r % 24; transpose_item(a.in[9], 256, 768, Wuq, 64 * kb, 32 * nb, 32 * nb, scr, lane); continue; } r -= I_UQ;
            if (r < I_UKV) { const int kb = r / 32, nb = r % 32; transpose_item(a.in[11], 128, 1024, Wukv, 64 * kb, 32 * nb, remap_kv(32 * nb), scr, lane); continue; } r -= I_UKV;
            { const int kb = r / 32, nb = r % 32; transpose_item(a.in[14], D, D, Wout, 64 * kb, 32 * nb, 32 * nb, scr, lane); }
        }
        for (int i = bx * 512 + tid; i < (DINP - DIN) * D / 8; i += G * 512) ((u32x4*)(Win + (size_t)DIN * D))[i] = (u32x4){0u, 0u, 0u, 0u};
        for (int m = gw; m < M; m += NGW) row_norm_to_bf16(x + (size_t)m * D, a.in[1], XN + (size_t)m * D, lane);
    }
    SEAM(0);
    if (IN(1)) { PTRS; pg8::Gemm g{XN, Wgu1, M, NGU, D}; SO S; S.init(M, NGU, G, bx); EpiSwiGLU E{Hb, FF};
        pg8::gemm_phase<EpiSwiGLU, SO, true, true>(lds, g, S, E); }
    SEAM(1);
    if (IN(2)) { PTRS; pg8::Gemm g{Hb, Wd1, M, D, FF}; SO S; S.init(M, D, G, bx); pg8::EpiBf16<0> E{Fb, D, nullptr, 0, 0, 1.f};
        pg8::gemm_phase<pg8::EpiBf16<0>, SO, true, true>(lds, g, S, E); }
    SEAM(2);
    if (IN(3)) { TIDS; PTRS; for (int m = gw; m < M; m += NGW) row_mid<true>(Fb + (size_t)m * D, x + (size_t)m * D, out + (size_t)m * D, a.in[4], 0.5f, a.in[5], XN + (size_t)m * D, lane); }
    SEAM(3);
    if (IN(4)) { PTRS; pg8::Gemm g{XN, Win, M, DINP, D}; SO S; S.init(M, DINP, G, bx); pg8::EpiBf16<0> E{Zb, DINP, nullptr, 0, 0, 1.f};
        pg8::gemm_phase<pg8::EpiBf16<0>, SO, true, true>(lds, g, S, E); }
    SEAM(4);
    if (IN(5)) { TIDS; PTRS; for (int m = gw; m < M; m += NGW) mla_prep_row(Zb + (size_t)m * DINP, m, a.in[8], a.in[10], cs, CQN, CKVN, Km, lane); }
    SEAM(5);
    if (IN(6)) { PTRS;
        { pg8::Gemm g{CQN, Wuq, M, 768, 256}; SO S; S.init(M, 768, G, bx); EpiQ E{Qm, cs}; pg8::gemm_phase<EpiQ, SO, true, true>(lds, g, S, E); }
        { pg8::Gemm g{CKVN, Wukv, M, 1024, 128}; SO S; S.init(M, 1024, G, bx); EpiKV E{Km, Vm}; pg8::gemm_phase<EpiKV, SO, true, true>(lds, g, S, E); }
    }
    SEAM(6);
    if (IN(7)) { PTRS;
        for (int u = bx; u < 512; u += G) na_naive(Zb, a.in[7], XN, u);
        for (int u = bx; u < 512; u += G) mla_naive(lds, Qm, Km, Vm, XN, u);
    }
    SEAM(7);
    if (IN(8)) { TIDS; PTRS; for (int m = gw; m < M; m += NGW) row_onorm(XN + (size_t)m * D, a.in[12], a.in[13], lane); }
    SEAM(8);
    if (IN(9)) { PTRS; pg8::Gemm g{XN, Wout, M, D, D}; SO S; S.init(M, D, G, bx); pg8::EpiBf16<0> E{Fb, D, nullptr, 0, 0, 1.f};
        pg8::gemm_phase<pg8::EpiBf16<0>, SO, true, true>(lds, g, S, E); }
    SEAM(9);
    if (IN(10)) { TIDS; PTRS; for (int m = gw; m < M; m += NGW) row_mid<true>(Fb + (size_t)m * D, out + (size_t)m * D, out + (size_t)m * D, a.in[15], 1.0f, a.in[16], XN + (size_t)m * D, lane); }
    SEAM(10);
    if (IN(11)) { PTRS; pg8::Gemm g{XN, Wgu2, M, NGU, D}; SO S; S.init(M, NGU, G, bx); EpiSwiGLU E{Hb, FF};
        pg8::gemm_phase<EpiSwiGLU, SO, true, true>(lds, g, S, E); }
    SEAM(11);
    if (IN(12)) { PTRS; pg8::Gemm g{Hb, Wd2, M, D, FF}; SO S; S.init(M, D, G, bx); pg8::EpiBf16<0> E{Fb, D, nullptr, 0, 0, 1.f};
        pg8::gemm_phase<pg8::EpiBf16<0>, SO, true, true>(lds, g, S, E); }
    SEAM(12);
    if (IN(13)) { TIDS; PTRS; for (int m = gw; m < M; m += NGW) row_mid<false>(Fb + (size_t)m * D, out + (size_t)m * D, out + (size_t)m * D, a.in[19], 0.5f, nullptr, nullptr, lane); }
#undef IN
#undef SEAM
}
}

#ifndef MK_MULTI
#define MK_MULTI 0
#endif
extern "C" void kernel_launch(void* const* d_in, const int* in_sizes, int n_in, void* d_out, int out_size, void* d_ws, size_t ws_size, hipStream_t stream) {
    static int grid = 0;
    if (grid == 0) {
        if (n_in != 20 || out_size != mk::M * mk::D || ws_size < mk::WS_END) { fprintf(stderr, "kernel_launch: unexpected shapes (n_in %d out %d ws %zu)\n", n_in, out_size, ws_size); grid = -1; return; }
        int dev = 0, cus = 0, per_cu = 0;
        (void)hipGetDevice(&dev); (void)hipDeviceGetAttribute(&cus, hipDeviceAttributeMultiprocessorCount, dev);
        if (hipFuncSetAttribute((const void*)mk::mk_fwd, hipFuncAttributeMaxDynamicSharedMemorySize, mk::LDS_BYTES) != hipSuccess) { fprintf(stderr, "kernel_launch: hipFuncSetAttribute failed\n"); grid = -1; return; }
        if (hipOccupancyMaxActiveBlocksPerMultiprocessor(&per_cu, (const void*)mk::mk_fwd, 512, mk::LDS_BYTES) != hipSuccess || per_cu < 1) { fprintf(stderr, "kernel_launch: occupancy query says %d\n", per_cu); grid = -1; (void)hipGetLastError(); return; }
        grid = cus;
    }
    if (grid < 0) return;
    mk::Args a{};
    for (int i = 0; i < 20; ++i) a.in[i] = (const float*)d_in[i];
    a.out = (float*)d_out; a.ws = (unsigned char*)d_ws;
#if MK_MULTI
    for (int ph = 0; ph < mk::NPHASE; ++ph) { a.ph_lo = ph; a.ph_hi = ph + 1; hipLaunchKernelGGL(mk::mk_fwd, dim3(grid), dim3(512), mk::LDS_BYTES, stream, a); }
#else
    a.ph_lo = 0; a.ph_hi = mk::NPHASE;
    void* args[] = {&a};
    hipError_t e = hipLaunchCooperativeKernel((const void*)mk::mk_fwd, dim3(grid), dim3(512), args, mk::LDS_BYTES, stream);
    if (e != hipSuccess) fprintf(stderr, "kernel_launch: cooperative launch failed: %s\n", hipGetErrorString(e));
#endif
}
```

```cpp
#include <hip/hip_runtime.h>
#include <hip/hip_cooperative_groups.h>
#include <cstdio>
namespace cg = cooperative_groups;
#include <cstdint>
namespace pg8 {
#define PG8_LAS __attribute__((address_space(3)))
typedef unsigned short bf16_t;
typedef short bf16x8 __attribute__((ext_vector_type(8)));
typedef float f32x4 __attribute__((ext_vector_type(4)));
typedef unsigned u32x4 __attribute__((ext_vector_type(4)));
constexpr int BM = 256, BK = 64, HALF = 128, HTB = HALF * BK * 2  , STAGE_BYTES = 8 * HTB, NXCD = 8, WGM = 8;

__host__ __device__ __forceinline__ int lds_byte(int r, int c) { const int st = (r >> 4) * 2 + (c >> 5), rr = r & 15, cc = c & 31, ob = rr * 64 + cc * 2; return st * 1024 + (ob ^ (((ob >> 9) & 1) << 5)); }
__host__ __device__ __forceinline__ void stage_rc(int b, int& R, int& C) { const int st = b / 1024, sb = b % 1024, swz = sb ^ (((sb >> 9) & 1) << 5); R = (st >> 1) * 16 + swz / 64; C = (st & 1) * 32 + (swz % 64) / 2; }
__host__ __device__ __forceinline__ int perm32(int rho) { const int n = rho >> 4, i = rho & 15; return 8 * (i >> 2) + 4 * n + (i & 3); }

struct Unit { int pm, pn; };
struct Gemm { const bf16_t* A; const bf16_t* Bt; int M, N, K; };

struct StaticOrder {
    int nM, nN, nwg, G, c;
    __host__ __device__ void init(int M, int N, int G_, int c_) { nM = M / BM; nN = N / BM; nwg = nM * nN; G = G_; c = c_; }
    __host__ __device__ bool next(int i, Unit& u) const {
        const long L = (long)i * G + c; if (L >= nwg) return false;
        int wgid = (int)L; { const int q = nwg / NXCD, r = nwg % NXCD, xcd = wgid % NXCD, off = wgid / NXCD; wgid = (xcd < r ? xcd * (q + 1) : r * (q + 1) + (xcd - r) * q) + off; }
        const int nig = WGM * nN, gid = wgid / nig, fm = gid * WGM, gsz = (nM - fm) < WGM ? (nM - fm) : WGM;
        u.pm = fm + ((wgid % nig) % gsz); u.pn = (wgid % nig) / gsz; return true;
    }
    __device__ __forceinline__ void a_ready(const Unit&) const {}
    __device__ __forceinline__ void done(const Unit&) const {}
};

__device__ __forceinline__ unsigned cvt_pk_bf16(float lo, float hi) { unsigned r; asm volatile("v_cvt_pk_bf16_f32 %0, %1, %2" : "=v"(r) : "v"(lo), "v"(hi)); return r; }
typedef float f32x2 __attribute__((ext_vector_type(2)));
__device__ __forceinline__ f32x2 gelu_pk(f32x2 v) {
    const f32x2 av = __builtin_elementwise_abs(v), d = av * 0.2316418882f + 1.0f;
    f32x2 t; t.x = __builtin_amdgcn_rcpf(d.x); t.y = __builtin_amdgcn_rcpf(d.y);
    f32x2 q = t * 0.5307027145f + (-0.7265760135f); q = q * t + 0.7107068705f; q = q * t + (-0.142248368f); q = q * t + 0.127414796f; q = q * t;
    const f32x2 s = (v * v) * (-0.72134752044f);
    f32x2 e; e.x = __builtin_amdgcn_exp2f(s.x); e.y = __builtin_amdgcn_exp2f(s.y);
    const f32x2 m = v * (q * e), r = v - m;
    f32x2 o; o.x = v.x < 0.f ? m.x : r.x; o.y = v.y < 0.f ? m.y : r.y; return o;
}

template <int ACT  > struct EpiBf16 {
    static constexpr bool PERM = true, AFTER_DRAIN = false; static_assert(ACT == 0 || ACT == 1, "EpiBf16: ACT is 0 (none) or 1 (gelu_pk)");
    bf16_t* O; int ldc; const float* bias; int split_cols; size_t split_stride; float scale0;
    __device__ __forceinline__ void operator()(const f32x4 (&acc)[2][2][4][2], const Unit& u, int wr, int wc, int fr, int fq) const {
        const int row0 = u.pm * BM + wr * 64 + fr; int colt = u.pn * BM; bf16_t* base = O;
        float sc = 1.f; if (split_cols) { const int t = colt / split_cols; base += (size_t)t * split_stride; colt -= t * split_cols; if (t == 0) sc = scale0; }
        const int col0 = colt + wc * 32 + 8 * fq, bcol0 = u.pn * BM + wc * 32 + 8 * fq;
        f32x4 bv[2][2];
#pragma unroll
        for (int bj = 0; bj < 2; ++bj)
#pragma unroll
            for (int n = 0; n < 2; ++n) bv[bj][n] = bias ? *(const f32x4*)(bias + bcol0 + bj * HALF + 4 * n) : (f32x4){0.f, 0.f, 0.f, 0.f};
#pragma unroll
        for (int ai = 0; ai < 2; ++ai)
#pragma unroll
            for (int m = 0; m < 4; ++m) { bf16_t* rowp = base + (size_t)(row0 + ai * HALF + m * 16) * ldc + col0;
#pragma unroll
                for (int bj = 0; bj < 2; ++bj) { f32x4 v0 = acc[ai][bj][m][0] + bv[bj][0], v1 = acc[ai][bj][m][1] + bv[bj][1];
                    if (ACT == 1) { f32x2 a = gelu_pk((f32x2){v0[0], v0[1]}), b = gelu_pk((f32x2){v0[2], v0[3]}), c = gelu_pk((f32x2){v1[0], v1[1]}), d = gelu_pk((f32x2){v1[2], v1[3]});
                        v0 = (f32x4){a.x, a.y, b.x, b.y}; v1 = (f32x4){c.x, c.y, d.x, d.y}; }
                    v0 = v0 * sc; v1 = v1 * sc; u32x4 w; w.x = cvt_pk_bf16(v0[0], v0[1]); w.y = cvt_pk_bf16(v0[2], v0[3]); w.z = cvt_pk_bf16(v1[0], v1[1]); w.w = cvt_pk_bf16(v1[2], v1[3]);
                    *(u32x4*)(rowp + bj * HALF) = w; } }
    }
};

struct PanelStats {
    unsigned* xbuf;
    unsigned* cnt;
    unsigned* tmo;
    int ntn; float eps;
    unsigned code;
    __device__ __forceinline__ bool run(const f32x4 (&v)[2][2][4][2], const Unit& u, int wr, int wc, int fr, int fq, PG8_LAS unsigned char* lds, int wid, int lane) const {
        typedef float f32x2v __attribute__((ext_vector_type(2)));
        PG8_LAS f32x2v* P = (PG8_LAS f32x2v*)lds;
        PG8_LAS f32x2v* S = (PG8_LAS f32x2v*)(lds + 8192);
        PG8_LAS unsigned* flag = (PG8_LAS unsigned*)(lds + 8192 + 2048);
#pragma unroll
        for (int ai = 0; ai < 2; ++ai)
#pragma unroll
            for (int m = 0; m < 4; ++m) {
                float s = 0.f;
#pragma unroll
                for (int bj = 0; bj < 2; ++bj)
#pragma unroll
                    for (int n = 0; n < 2; ++n) { const f32x4 x = v[ai][bj][m][n]; s += (x[0] + x[1]) + (x[2] + x[3]); }
                s += __shfl_xor(s, 16); s += __shfl_xor(s, 32);
                const float mw = s * (1.0f / 64.0f); float q = 0.f;
#pragma unroll
                for (int bj = 0; bj < 2; ++bj)
#pragma unroll
                    for (int n = 0; n < 2; ++n) { const f32x4 d = v[ai][bj][m][n] - mw; q += (d[0] * d[0] + d[1] * d[1]) + (d[2] * d[2] + d[3] * d[3]); }
                q += __shfl_xor(q, 16); q += __shfl_xor(q, 32);
                if (fq == 0) P[(ai * HALF + wr * 64 + m * 16 + fr) * 4 + wc] = (f32x2v){mw, q};
            }
        asm volatile("s_waitcnt lgkmcnt(0)" ::: "memory"); __builtin_amdgcn_s_barrier(); asm volatile("" ::: "memory");
#if defined(BROKEN_EXCHANGE_NO_WAIT)
#warning BROKEN CONTROL BUILD: the row-statistics exchange does not wait; results are wrong by design
        if (blockIdx.x >= 64) { const long long t0_ = clock64(); while (clock64() - t0_ < 60000) __builtin_amdgcn_s_sleep(8); }
#endif
        const int row = wid * 32 + (lane & 31);
        if (lane < 32) {
            const f32x2v a = P[row * 4 + 0], b = P[row * 4 + 1], c = P[row * 4 + 2], d = P[row * 4 + 3];
            const float mt = (a.x + b.x + c.x + d.x) * 0.25f;
            const float da = a.x - mt, db = b.x - mt, dc = c.x - mt, dd = d.x - mt;
            const float m2 = (a.y + b.y) + (c.y + d.y) + 64.0f * ((da * da + db * db) + (dc * dc + dd * dd));
            unsigned long long* slot = (unsigned long long*)xbuf + ((size_t)(u.pm * BM + row) * 4 + u.pn);
            __hip_atomic_store(slot, ((unsigned long long)__float_as_uint(m2) << 32) | __float_as_uint(mt), __ATOMIC_RELAXED, __HIP_MEMORY_SCOPE_AGENT);
        }
        asm volatile("s_waitcnt vmcnt(0)" ::: "memory");
        if (lane == 0) __hip_atomic_fetch_add(cnt + 64 * u.pm, 1u, __ATOMIC_RELAXED, __HIP_MEMORY_SCOPE_AGENT);
        if (wid == 0) {
            bool dead = false; const unsigned long long t0 = __builtin_amdgcn_s_memrealtime(); const unsigned want = 8u * (unsigned)ntn;
            for (;;) {
#if defined(BROKEN_EXCHANGE_NO_WAIT)
                break;
#endif
                if ((unsigned)__builtin_amdgcn_readfirstlane(__hip_atomic_load(cnt + 64 * u.pm, __ATOMIC_RELAXED, __HIP_MEMORY_SCOPE_AGENT)) >= want) break;
                if (__builtin_amdgcn_s_memrealtime() - t0 > 2000000ull) {
                    if (lane == 0) { unsigned expect = 0u; __hip_atomic_compare_exchange_strong(tmo + 1, &expect, code | (unsigned)(u.pm & 0xff), __ATOMIC_RELAXED, __ATOMIC_RELAXED, __HIP_MEMORY_SCOPE_AGENT);
                                     __hip_atomic_store(tmo, 1u, __ATOMIC_RELAXED, __HIP_MEMORY_SCOPE_AGENT); }
                    dead = true; break; }
                __builtin_amdgcn_s_sleep(2);
            }
            __builtin_amdgcn_fence(__ATOMIC_ACQUIRE, "agent");
            if (lane == 0) flag[0] = dead ? 1u : 0u;
        }
        asm volatile("s_waitcnt vmcnt(0) lgkmcnt(0)" ::: "memory"); __builtin_amdgcn_s_barrier(); asm volatile("" ::: "memory");
        const bool bad = flag[0] != 0u;
        if (lane < 32) {
            const unsigned long long* slot = (const unsigned long long*)xbuf + (size_t)(u.pm * BM + row) * 4; float mt[4], m2[4]; float ms = 0.f;
#pragma unroll
            for (int t = 0; t < 4; ++t) { if (t < ntn) { const unsigned long long w = __hip_atomic_load(slot + t, __ATOMIC_RELAXED, __HIP_MEMORY_SCOPE_AGENT); mt[t] = __uint_as_float((unsigned)w); m2[t] = __uint_as_float((unsigned)(w >> 32)); } else { mt[t] = 0.f; m2[t] = 0.f; } ms += mt[t]; }
            const float mean = ms / (float)ntn; float q = 0.f;
#pragma unroll
            for (int t = 0; t < 4; ++t) if (t < ntn) { const float dm = mt[t] - mean; q += m2[t] + 256.0f * dm * dm; }
            S[row] = (f32x2v){mean, 1.0f / sqrtf(q / (256.0f * (float)ntn) + eps)};
        }
        asm volatile("s_waitcnt lgkmcnt(0)" ::: "memory"); __builtin_amdgcn_s_barrier(); asm volatile("" ::: "memory");
        return bad;
    }
};
struct EpiLnRes {
    static constexpr bool PERM = false, AFTER_DRAIN = true;
    const float* base; float* out; int ldc; const float* bias; PanelStats st; unsigned poison;
    __device__ __forceinline__ void fused(f32x4 (&acc)[2][2][4][2], const Unit& u, int wr, int wc, int fr, int fq, PG8_LAS unsigned char* lds, int wid, int lane) const {
        typedef float f32x2v __attribute__((ext_vector_type(2)));
        const PG8_LAS f32x2v* S = (const PG8_LAS f32x2v*)(lds + 8192);
        const int col0 = u.pn * BM + wc * 32 + 4 * fq;
#pragma unroll
        for (int bj = 0; bj < 2; ++bj)
#pragma unroll
            for (int n = 0; n < 2; ++n) { const f32x4 bv = bias ? *(const f32x4*)(bias + col0 + bj * HALF + n * 16) : (f32x4){0.f, 0.f, 0.f, 0.f};
#pragma unroll
                for (int ai = 0; ai < 2; ++ai)
#pragma unroll
                    for (int m = 0; m < 4; ++m) acc[ai][bj][m][n] += bv; }
        f32x4 pre[4][2][2];
#pragma unroll
        for (int m = 0; m < 4; ++m) { const size_t off = (size_t)(u.pm * BM + wr * 64 + m * 16 + fr) * ldc + col0;
#pragma unroll
            for (int bj = 0; bj < 2; ++bj)
#pragma unroll
                for (int n = 0; n < 2; ++n) pre[m][bj][n] = *(const f32x4*)(base + off + bj * HALF + n * 16); }
        const bool bad = st.run(acc, u, wr, wc, fr, fq, lds, wid, lane) || poison != 0u;
        const float qnan = __builtin_nanf("");
#pragma unroll
        for (int ai = 0; ai < 2; ++ai)
#pragma unroll
            for (int m = 0; m < 4; ++m) { const int r = ai * HALF + wr * 64 + m * 16 + fr; const f32x2v sr = S[r]; const size_t off = (size_t)(u.pm * BM + r) * ldc + col0;
#pragma unroll
                for (int bj = 0; bj < 2; ++bj)
#pragma unroll
                    for (int n = 0; n < 2; ++n) { const f32x4 bs = ai == 0 ? pre[m][bj][n] : *(const f32x4*)(base + off + bj * HALF + n * 16); f32x4 o = bs + (acc[ai][bj][m][n] - sr.x) * sr.y;
                        if (bad) o = (f32x4){qnan, qnan, qnan, qnan}; *(f32x4*)(out + off + bj * HALF + n * 16) = o; }
                if (m & 1) asm volatile("" ::: "memory"); }
    }
};
struct EpiLnResLn {
    static constexpr bool PERM = false, AFTER_DRAIN = true;
    const float* base; float* out; bf16_t* xn; int ldc; const float* bias; PanelStats st1, st2; unsigned poison;
    __device__ __forceinline__ void fused(f32x4 (&acc)[2][2][4][2], const Unit& u, int wr, int wc, int fr, int fq, PG8_LAS unsigned char* lds, int wid, int lane) const {
        typedef float f32x2v __attribute__((ext_vector_type(2))); typedef unsigned u32x2v __attribute__((ext_vector_type(2)));
        const PG8_LAS f32x2v* S = (const PG8_LAS f32x2v*)(lds + 8192);
        const int col0 = u.pn * BM + wc * 32 + 4 * fq;
#pragma unroll
        for (int bj = 0; bj < 2; ++bj)
#pragma unroll
            for (int n = 0; n < 2; ++n) { const f32x4 bv = bias ? *(const f32x4*)(bias + col0 + bj * HALF + n * 16) : (f32x4){0.f, 0.f, 0.f, 0.f};
#pragma unroll
                for (int ai = 0; ai < 2; ++ai)
#pragma unroll
                    for (int m = 0; m < 4; ++m) acc[ai][bj][m][n] += bv; }
        bool bad = st1.run(acc, u, wr, wc, fr, fq, lds, wid, lane) || poison != 0u;
        const float qnan = __builtin_nanf("");
#pragma unroll
        for (int ai = 0; ai < 2; ++ai)
#pragma unroll
            for (int m = 0; m < 4; ++m) { const int r = ai * HALF + wr * 64 + m * 16 + fr; const f32x2v sr = S[r]; const size_t off = (size_t)(u.pm * BM + r) * ldc + col0;
#pragma unroll
                for (int bj = 0; bj < 2; ++bj)
#pragma unroll
                    for (int n = 0; n < 2; ++n) { const f32x4 bs = *(const f32x4*)(base + off + bj * HALF + n * 16); acc[ai][bj][m][n] = bs + (acc[ai][bj][m][n] - sr.x) * sr.y; }
                asm volatile("" : "+v"(acc[ai][0][m][0]), "+v"(acc[ai][0][m][1]), "+v"(acc[ai][1][m][0]), "+v"(acc[ai][1][m][1]));
                if (m & 1) asm volatile("" ::: "memory"); }
        const bool bad1 = bad;
        bad = st2.run(acc, u, wr, wc, fr, fq, lds, wid, lane) || bad;
#pragma unroll
        for (int ai = 0; ai < 2; ++ai)
#pragma unroll
            for (int m = 0; m < 4; ++m) { const int r = ai * HALF + wr * 64 + m * 16 + fr; const f32x2v sr = S[r]; const size_t off = (size_t)(u.pm * BM + r) * ldc + col0;
#pragma unroll
                for (int bj = 0; bj < 2; ++bj)
#pragma unroll
                    for (int n = 0; n < 2; ++n) { const f32x4 x1 = acc[ai][bj][m][n]; *(f32x4*)(out + off + bj * HALF + n * 16) = bad1 ? (f32x4){qnan, qnan, qnan, qnan} : x1;
                        const f32x4 o = (x1 - sr.x) * sr.y; u32x2v w; w.x = cvt_pk_bf16(o[0], o[1]); w.y = cvt_pk_bf16(o[2], o[3]);
                        if (bad) { w.x = 0x7fc07fc0u; w.y = 0x7fc07fc0u; } *(u32x2v*)(xn + off + bj * HALF + n * 16) = w; }
                asm volatile("" ::: "memory"); }
    }
};

template <class Epi, class Sched, bool ALIGN_EPI = false, bool SP2 = false>
__device__ __forceinline__ void gemm_phase(PG8_LAS unsigned char* lds, const Gemm g, const Sched& S, const Epi& E) {
    int tid_ = threadIdx.x; asm volatile("" : "+v"(tid_));
    const int tid = tid_, wid = __builtin_amdgcn_readfirstlane(tid >> 6), lane = tid & 63, wr = wid >> 2, wc = wid & 3, fr = lane & 15, fq = lane >> 4;
    int K_ = g.K; asm volatile("" : "+s"(K_)); const int K = K_, nt = K / BK;
    unsigned voffA[2], voffB[2];
#pragma unroll
    for (int i = 0; i < 2; ++i) { int R, C; stage_rc(tid * 16 + i * 8192, R, C); const int Rb = Epi::PERM ? ((R & ~31) + perm32(R & 31)) : R;
        voffA[i] = (unsigned)(R * K + C) * 2u; voffB[i] = (unsigned)(Rb * K + C) * 2u; }
    const size_t kstep = (size_t)(BK * 2);
    const size_t hstep = (size_t)HALF * K * 2;
    const size_t tstep = 2 * hstep;
    const unsigned ldsw = (unsigned)wid * 1024u;
    const int aoff = lds_byte(wr * 64 + fr, fq * 8), boff = lds_byte(wc * 32 + fr, fq * 8);
#define PG8_SA(b, h) (((b) * 2 + (h)) * HTB)
#define PG8_SB(b, h) ((4 + (b) * 2 + (h)) * HTB)
#define PG8_STAGE(bufoff, gbase, voff) do { _Pragma("unroll") for (int _i = 0; _i < 2; ++_i) \
        __builtin_amdgcn_global_load_lds((const unsigned*)((const char*)(gbase) + (voff)[_i]), (PG8_LAS unsigned*)(lds + (bufoff) + ldsw + _i * 8192), 16, 0, 0); } while (0)
#define PG8_LDA(dst, b, h) do { _Pragma("unroll") for (int m = 0; m < 4; ++m) _Pragma("unroll") for (int k = 0; k < 2; ++k) dst[m][k] = *(const PG8_LAS bf16x8*)(lds + PG8_SA(b, h) + aoff + m * 2048 + k * 1024); } while (0)
#define PG8_LDB(dst, b, h) do { _Pragma("unroll") for (int n = 0; n < 2; ++n) _Pragma("unroll") for (int k = 0; k < 2; ++k) dst[n][k] = *(const PG8_LAS bf16x8*)(lds + PG8_SB(b, h) + boff + n * 2048 + k * 1024); } while (0)
#define PG8_MMA(ai, bj, At, Bt) do { __builtin_amdgcn_s_setprio(1); _Pragma("unroll") for (int m = 0; m < 4; ++m) _Pragma("unroll") for (int n = 0; n < 2; ++n) _Pragma("unroll") for (int k = 0; k < 2; ++k) \
        acc[ai][bj][m][n] = __builtin_amdgcn_mfma_f32_16x16x32_bf16(Bt[n][k], At[m][k], acc[ai][bj][m][n], 0, 0, 0); __builtin_amdgcn_s_setprio(0); } while (0)
#define PG8_WAIT_V(n) asm volatile("s_waitcnt vmcnt(" #n ")" ::: "memory")
#define PG8_WAIT_L(n) asm volatile("s_waitcnt lgkmcnt(" #n ")" ::: "memory")
#define PG8_BAR __builtin_amdgcn_s_barrier()
#define PG8_SCHED __builtin_amdgcn_sched_barrier(0)
    Unit cur, nxt; int ui = 0;
    if (!S.next(0, cur)) return;
    f32x4 acc[2][2][4][2];
#pragma unroll
    for (int a = 0; a < 2; ++a)
#pragma unroll
        for (int b = 0; b < 2; ++b)
#pragma unroll
            for (int m = 0; m < 4; ++m)
#pragma unroll
                for (int n = 0; n < 2; ++n) acc[a][b][m][n] = (f32x4){0.f, 0.f, 0.f, 0.f};
    bf16x8 At[4][2], B0[2][2], B1[2][2];
    const char* cA = (const char*)g.A + (size_t)cur.pm * tstep; const char* cB = (const char*)g.Bt + (size_t)cur.pn * tstep;
    S.a_ready(cur);
    if constexpr (SP2) {
        PG8_STAGE(PG8_SB(0, 0), cB, voffB); PG8_STAGE(PG8_SB(0, 1), cB + hstep, voffB); PG8_STAGE(PG8_SA(0, 0), cA, voffA); PG8_STAGE(PG8_SA(0, 1), cA + hstep, voffA);
        if (wr == 1) PG8_BAR;
        PG8_WAIT_V(2); PG8_BAR;
        PG8_STAGE(PG8_SB(1, 0), cB + kstep, voffB); PG8_STAGE(PG8_SA(1, 0), cA + kstep, voffA); PG8_STAGE(PG8_SB(1, 1), cB + hstep + kstep, voffB);
        PG8_WAIT_V(6); PG8_BAR;
    } else {
        PG8_STAGE(PG8_SB(0, 0), cB, voffB); PG8_STAGE(PG8_SA(0, 0), cA, voffA); PG8_STAGE(PG8_SB(0, 1), cB + hstep, voffB); PG8_STAGE(PG8_SA(0, 1), cA + hstep, voffA);
        if (wr == 1) PG8_BAR;
        PG8_WAIT_V(4); PG8_BAR;
        PG8_STAGE(PG8_SB(1, 0), cB + kstep, voffB); PG8_STAGE(PG8_SA(1, 0), cA + kstep, voffA); PG8_STAGE(PG8_SB(1, 1), cB + hstep + kstep, voffB);
        PG8_WAIT_V(6); PG8_BAR;
    }
    for (;;) {
        const bool has_next = S.next(ui + 1, nxt);
        const char* nA = has_next ? (const char*)g.A + (size_t)nxt.pm * tstep : cA; const char* nB = has_next ? (const char*)g.Bt + (size_t)nxt.pn * tstep : cB;
        for (int t = 0; t < nt; t += 2) {
            const bool last = (t == nt - 2);
            const char* a1 = cA + (size_t)(t + 1) * kstep;
            const char* a2 = last ? nA : cA + (size_t)(t + 2) * kstep; const char* b2 = last ? nB : cB + (size_t)(t + 2) * kstep;
            const char* a3 = a2 + kstep; const char* b3 = b2 + kstep;
            if (last && has_next) S.a_ready(nxt);
            if constexpr (SP2) {
            PG8_LDB(B0, 0, 0); PG8_LDB(B1, 0, 1); PG8_SCHED; PG8_LDA(At, 0, 0); PG8_STAGE(PG8_SA(1, 1), a1 + hstep, voffA);
            PG8_WAIT_V(8); PG8_WAIT_L(0); PG8_BAR; PG8_MMA(0, 0, At, B0); PG8_MMA(0, 1, At, B1); PG8_BAR; PG8_SCHED;
            PG8_LDA(At, 0, 1); PG8_STAGE(PG8_SB(0, 0), b2, voffB); PG8_STAGE(PG8_SB(0, 1), b2 + hstep, voffB); PG8_STAGE(PG8_SA(0, 0), a2, voffA);
            PG8_WAIT_V(8); PG8_WAIT_L(0); PG8_BAR; PG8_MMA(1, 0, At, B0); PG8_MMA(1, 1, At, B1); PG8_BAR; PG8_SCHED;
            PG8_LDB(B0, 1, 0); PG8_LDB(B1, 1, 1); PG8_SCHED; PG8_LDA(At, 1, 0); PG8_STAGE(PG8_SA(0, 1), a2 + hstep, voffA);
            PG8_WAIT_V(8); PG8_WAIT_L(0); PG8_BAR; PG8_MMA(0, 0, At, B0); PG8_MMA(0, 1, At, B1); PG8_BAR; PG8_SCHED;
            PG8_LDA(At, 1, 1); PG8_STAGE(PG8_SB(1, 0), b3, voffB); PG8_STAGE(PG8_SB(1, 1), b3 + hstep, voffB); PG8_STAGE(PG8_SA(1, 0), a3, voffA);
            PG8_WAIT_V(8); PG8_WAIT_L(0); PG8_BAR; PG8_MMA(1, 0, At, B0); PG8_MMA(1, 1, At, B1); PG8_BAR; PG8_SCHED;
            } else {
            PG8_LDB(B0, 0, 0); PG8_SCHED; PG8_LDA(At, 0, 0); PG8_STAGE(PG8_SA(1, 1), a1 + hstep, voffA);
            PG8_WAIT_L(8); PG8_BAR; PG8_WAIT_L(0); PG8_MMA(0, 0, At, B0); PG8_BAR; PG8_SCHED;
            PG8_LDB(B1, 0, 1); PG8_STAGE(PG8_SB(0, 0), b2, voffB);
            PG8_BAR; PG8_WAIT_L(0); PG8_MMA(0, 1, At, B1); PG8_BAR;
            PG8_LDA(At, 0, 1); PG8_STAGE(PG8_SA(0, 0), a2, voffA);
            PG8_BAR; PG8_WAIT_L(0); PG8_MMA(1, 0, At, B0); PG8_BAR; PG8_SCHED;
            PG8_STAGE(PG8_SB(0, 1), b2 + hstep, voffB);
            PG8_WAIT_V(6); PG8_BAR; PG8_MMA(1, 1, At, B1); PG8_BAR;
            PG8_LDB(B0, 1, 0); PG8_SCHED; PG8_LDA(At, 1, 0); PG8_STAGE(PG8_SA(0, 1), a2 + hstep, voffA);
            PG8_WAIT_L(8); PG8_BAR; PG8_WAIT_L(0); PG8_MMA(0, 0, At, B0); PG8_BAR; PG8_SCHED;
            PG8_LDB(B1, 1, 1); PG8_STAGE(PG8_SB(1, 0), b3, voffB);
            PG8_BAR; PG8_WAIT_L(0); PG8_MMA(0, 1, At, B1); PG8_BAR;
            PG8_LDA(At, 1, 1); PG8_STAGE(PG8_SA(1, 0), a3, voffA);
            PG8_BAR; PG8_WAIT_L(0); PG8_MMA(1, 0, At, B0); PG8_BAR; PG8_SCHED;
            PG8_STAGE(PG8_SB(1, 1), b3 + hstep, voffB);
            PG8_WAIT_V(6); PG8_BAR; PG8_MMA(1, 1, At, B1); PG8_BAR;
            }
        }
        if constexpr (ALIGN_EPI) { if (wr == 0) PG8_BAR; }
        if constexpr (!Epi::AFTER_DRAIN) { E(acc, cur, wr, wc, fr, fq); S.done(cur); }
        if (!has_next) break;
#pragma unroll
        for (int a = 0; a < 2; ++a)
#pragma unroll
            for (int b = 0; b < 2; ++b)
#pragma unroll
                for (int m = 0; m < 4; ++m)
#pragma unroll
                    for (int n = 0; n < 2; ++n) acc[a][b][m][n] = (f32x4){0.f, 0.f, 0.f, 0.f};
        cur = nxt; cA = nA; cB = nB; ++ui;
        if constexpr (ALIGN_EPI) { if (wr == 1) PG8_BAR; }
    }
    PG8_WAIT_V(0);
    if constexpr (!ALIGN_EPI) { if (wr == 0) PG8_BAR; }
    PG8_BAR;
    if constexpr (Epi::AFTER_DRAIN) { E.fused(acc, cur, wr, wc, fr, fq, lds, wid, lane); S.done(cur); }
#undef PG8_SA
#undef PG8_SB
#undef PG8_STAGE
#undef PG8_LDA
#undef PG8_LDB
#undef PG8_MMA
#undef PG8_WAIT_V
#undef PG8_WAIT_L
#undef PG8_BAR
#undef PG8_SCHED
}
}

#ifndef PG8_SP2
#define PG8_SP2 true
#endif
#ifndef PG8_ALIGN
#define PG8_ALIGN true
#endif

namespace mk {
using pg8::bf16_t; using pg8::f32x4; using pg8::u32x4; using pg8::Unit; using pg8::BM; using pg8::HALF; using pg8::bf16x8;
#define LAS __attribute__((address_space(3)))
typedef unsigned u32x2 __attribute__((ext_vector_type(2)));
typedef float f32x2 __attribute__((ext_vector_type(2)));
typedef float f32x16 __attribute__((ext_vector_type(16)));

constexpr int M = 32768, D = 1024, FF = 2816, NGU = 5632, DIN = 1952, DINP = 2048, SEQ = 4096;
constexpr float EPS = 1e-6f;
constexpr float LOG2E = 1.4426950408889634f;
constexpr float QSCALE = 0.10206207261596577f * 1.4426950408889634f;

constexpr size_t MiB = 1u << 20;
constexpr size_t WS_CS = 0;
constexpr size_t WS_WGU1 = 1 * MiB, WS_WD1 = 12 * MiB, WS_WIN = 18 * MiB, WS_WUQ = 22 * MiB, WS_WUKV = 22 * MiB + 512 * 1024,
                 WS_WOUT = 23 * MiB, WS_WGU2 = 25 * MiB, WS_WD2 = 36 * MiB;
constexpr size_t WS_XN = 49 * MiB;
constexpr size_t WS_F = 113 * MiB;
constexpr size_t WS_H = 177 * MiB;
constexpr size_t WS_QM = 305 * MiB;
constexpr size_t WS_KM = 353 * MiB;
constexpr size_t WS_VM = 401 * MiB;
constexpr size_t WS_CQN = 433 * MiB;
constexpr size_t WS_CKVN = 449 * MiB;
constexpr size_t WS_END = 457 * MiB;

constexpr int LDS_BYTES = 147456;

__device__ __forceinline__ float bf_lo(unsigned w) { return __uint_as_float(w << 16); }
__device__ __forceinline__ float bf_hi(unsigned w) { return __uint_as_float(w & 0xffff0000u); }
__device__ __forceinline__ unsigned pk(float lo, float hi) { return pg8::cvt_pk_bf16(lo, hi); }
__device__ __forceinline__ float wave_sum(float v) {
#pragma unroll
    for (int o = 1; o < 64; o <<= 1) v += __shfl_xor(v, o);
    return v;
}
__device__ __forceinline__ float dot4(f32x4 a) { return (a[0] * a[0] + a[1] * a[1]) + (a[2] * a[2] + a[3] * a[3]); }

struct EpiSwiGLU {
    static constexpr bool PERM = true, AFTER_DRAIN = false;
    bf16_t* O; int ldc;
    __device__ __forceinline__ void operator()(const f32x4 (&acc)[2][2][4][2], const Unit& u, int wr, int wc, int fr, int fq) const {
        const int row0 = u.pm * BM + wr * 64 + fr; const int col0 = u.pn * 128 + wc * 32 + 8 * fq;
#pragma unroll
        for (int ai = 0; ai < 2; ++ai)
#pragma unroll
            for (int m = 0; m < 4; ++m) {
                bf16_t* rowp = O + (size_t)(row0 + ai * HALF + m * 16) * ldc + col0;
                float r[8];
#pragma unroll
                for (int n = 0; n < 2; ++n)
#pragma unroll
                    for (int j = 0; j < 4; ++j) { const float g = acc[ai][0][m][n][j], up = acc[ai][1][m][n][j];
                        const float e = __builtin_amdgcn_exp2f(-g * LOG2E); r[4 * n + j] = g * __builtin_amdgcn_rcpf(1.0f + e) * up; }
                u32x4 w; w.x = pk(r[0], r[1]); w.y = pk(r[2], r[3]); w.z = pk(r[4], r[5]); w.w = pk(r[6], r[7]);
                *(u32x4*)rowp = w;
            }
    }
};
struct EpiKV {
    static constexpr bool PERM = true, AFTER_DRAIN = false;
    bf16_t* Km; bf16_t* Vm;
    __device__ __forceinline__ void operator()(const f32x4 (&acc)[2][2][4][2], const Unit& u, int wr, int wc, int fr, int fq) const {
        const int row0 = u.pm * BM + wr * 64 + fr;
#pragma unroll
        for (int bj = 0; bj < 2; ++bj) {
            const int colt = u.pn * BM + bj * HALF + wc * 32 + 8 * fq;
            bf16_t* base; int ld;
            if (colt < 512) { base = Km + 96 * (colt >> 6) + (colt & 63); ld = 768; } else { base = Vm + (colt - 512); ld = 512; }
#pragma unroll
            for (int ai = 0; ai < 2; ++ai)
#pragma unroll
                for (int m = 0; m < 4; ++m) { const f32x4 v0 = acc[ai][bj][m][0], v1 = acc[ai][bj][m][1];
                    u32x4 w; w.x = pk(v0[0], v0[1]); w.y = pk(v0[2], v0[3]); w.z = pk(v1[0], v1[1]); w.w = pk(v1[2], v1[3]);
                    *(u32x4*)(base + (size_t)(row0 + ai * HALF + m * 16) * ld) = w; }
        }
    }
};
struct EpiQ {
    static constexpr bool PERM = false, AFTER_DRAIN = false;
    bf16_t* O; const f32x2* cs;
    __device__ __forceinline__ void operator()(const f32x4 (&acc)[2][2][4][2], const Unit& u, int wr, int wc, int fr, int fq) const {
        const int row0 = u.pm * BM + wr * 64 + fr;
#pragma unroll
        for (int bj = 0; bj < 2; ++bj) {
            const int g32 = u.pn * 8 + bj * 4 + wc; const bool rot = (g32 % 3) == 2; const int cbase = g32 * 32 + 4 * fq;
#pragma unroll
            for (int ai = 0; ai < 2; ++ai)
#pragma unroll
                for (int m = 0; m < 4; ++m) {
                    const int row = row0 + ai * HALF + m * 16;
                    f32x4 x0 = acc[ai][bj][m][0], x1 = acc[ai][bj][m][1];
                    if (rot) { const int t = row & (SEQ - 1); const int pos = (fq < 2) ? (t >> 6) : (t & 63); const f32x2* cp = cs + pos * 8 + 4 * (fq & 1);
                        f32x4 y0, y1;
#pragma unroll
                        for (int j = 0; j < 4; ++j) { const f32x2 c = cp[j]; y0[j] = x0[j] * c.x - x1[j] * c.y; y1[j] = x1[j] * c.x + x0[j] * c.y; }
                        x0 = y0; x1 = y1; }
                    x0 = x0 * QSCALE; x1 = x1 * QSCALE;
                    bf16_t* p = O + (size_t)row * 768 + cbase;
                    u32x2 w0; w0.x = pk(x0[0], x0[1]); w0.y = pk(x0[2], x0[3]); u32x2 w1; w1.x = pk(x1[0], x1[1]); w1.y = pk(x1[2], x1[3]);
                    *(u32x2*)p = w0; *(u32x2*)(p + 16) = w1;
                    asm volatile("" ::: "memory");
                }
        }
    }
};

__device__ __forceinline__ void row_norm_to_bf16(const float* xrow, const float* g, bf16_t* orow, int lane) {
    const f32x4* xr = (const f32x4*)xrow + lane; const f32x4* gr = (const f32x4*)g + lane;
    f32x4 v[4]; float s = 0.f;
#pragma unroll
    for (int j = 0; j < 4; ++j) { v[j] = xr[64 * j]; s += dot4(v[j]); }
    const float rstd = 1.0f / sqrtf(wave_sum(s) * (1.0f / D) + EPS);
#pragma unroll
    for (int j = 0; j < 4; ++j) { const f32x4 o = v[j] * rstd * gr[64 * j]; u32x2 w; w.x = pk(o[0], o[1]); w.y = pk(o[2], o[3]); ((u32x2*)orow)[lane + 64 * j] = w; }
}
template <bool WRITE_XN>
__device__ __forceinline__ void row_mid(const bf16_t* frow, const float* resrow, float* outrow, const float* gpost, float coef, const float* gpre, bf16_t* xnrow, int lane) {
    f32x4 f[4]; float s = 0.f;
#pragma unroll
    for (int j = 0; j < 4; ++j) { const u32x2 w = ((const u32x2*)frow)[lane + 64 * j]; f[j] = (f32x4){bf_lo(w.x), bf_hi(w.x), bf_lo(w.y), bf_hi(w.y)}; s += dot4(f[j]); }
    const float rstd = 1.0f / sqrtf(wave_sum(s) * (1.0f / D) + EPS) * coef;
    float s2 = 0.f;
#pragma unroll
    for (int j = 0; j < 4; ++j) { const f32x4 gp = ((const f32x4*)gpost)[lane + 64 * j]; const f32x4 r = ((const f32x4*)resrow)[lane + 64 * j];
        f[j] = r + f[j] * rstd * gp; ((f32x4*)outrow)[lane + 64 * j] = f[j]; s2 += dot4(f[j]); }
    if (WRITE_XN) {
        const float rstd2 = 1.0f / sqrtf(wave_sum(s2) * (1.0f / D) + EPS);
#pragma unroll
        for (int j = 0; j < 4; ++j) { const f32x4 o = f[j] * rstd2 * ((const f32x4*)gpre)[lane + 64 * j]; u32x2 w; w.x = pk(o[0], o[1]); w.y = pk(o[2], o[3]); ((u32x2*)xnrow)[lane + 64 * j] = w; }
    }
}
__device__ __forceinline__ void row_onorm(bf16_t* orow, const float* gna, const float* gmla, int lane) {
    f32x4 f[4]; float sa = 0.f, sb = 0.f;
#pragma unroll
    for (int j = 0; j < 4; ++j) { const u32x2 w = ((const u32x2*)orow)[lane + 64 * j]; f[j] = (f32x4){bf_lo(w.x), bf_hi(w.x), bf_lo(w.y), bf_hi(w.y)}; if (j < 2) sa += dot4(f[j]); else sb += dot4(f[j]); }
    const float ra = 1.0f / sqrtf(wave_sum(sa) * (1.0f / 512.0f) + EPS), rb = 1.0f / sqrtf(wave_sum(sb) * (1.0f / 512.0f) + EPS);
#pragma unroll
    for (int j = 0; j < 4; ++j) { const f32x4 g = (j < 2) ? ((const f32x4*)gna)[lane + 64 * j] : ((const f32x4*)gmla)[lane + 64 * (j - 2)];
        const f32x4 o = f[j] * ((j < 2) ? ra : rb) * g; u32x2 w; w.x = pk(o[0], o[1]); w.y = pk(o[2], o[3]); ((u32x2*)orow)[lane + 64 * j] = w; }
}
__device__ __forceinline__ void mla_prep_row(const bf16_t* zrow, int row, const float* gq, const float* gkv, const f32x2* cs, bf16_t* cqn, bf16_t* ckvn, bf16_t* km, int lane) {
    const u32x2 wq = ((const u32x2*)(zrow + 1536))[lane];
    const float q0 = bf_lo(wq.x), q1 = bf_hi(wq.x), q2 = bf_lo(wq.y), q3 = bf_hi(wq.y);
    const float rq = 1.0f / sqrtf(wave_sum((q0 * q0 + q1 * q1) + (q2 * q2 + q3 * q3)) * (1.0f / 256.0f) + EPS);
    const unsigned wk = ((const unsigned*)(zrow + 1792))[lane];
    const float k0 = bf_lo(wk), k1 = bf_hi(wk);
    const float rk = 1.0f / sqrtf(wave_sum(k0 * k0 + k1 * k1) * (1.0f / 128.0f) + EPS);
    const f32x4 g = ((const f32x4*)gq)[lane];
    u32x2 o; o.x = pk(q0 * rq * g[0], q1 * rq * g[1]); o.y = pk(q2 * rq * g[2], q3 * rq * g[3]);
    ((u32x2*)(cqn + (size_t)row * 256))[lane] = o;
    const f32x2 g2 = ((const f32x2*)gkv)[lane];
    ((unsigned*)(ckvn + (size_t)row * 128))[lane] = pk(k0 * rk * g2.x, k1 * rk * g2.y);
    if (lane < 16) {
        const int i = lane; const float x1 = bf_lo((unsigned)zrow[1920 + i]), x2 = bf_lo((unsigned)zrow[1936 + i]);
        const int t = row & (SEQ - 1); const int pos = (i < 8) ? (t >> 6) : (t & 63); const f32x2 c = cs[pos * 8 + (i & 7)];
        const unsigned y = pk(x1 * c.x - x2 * c.y, x2 * c.x + x1 * c.y);
        bf16_t* kp = km + (size_t)row * 768 + 64 + i;
#pragma unroll
        for (int h = 0; h < 8; ++h) { kp[96 * h] = (bf16_t)(y & 0xffffu); kp[96 * h + 16] = (bf16_t)(y >> 16); }
    }
}

__device__ __forceinline__ void transpose_item(const float* W, int K, int N, bf16_t* WT, int k0, int n0, int n0_out, LAS float* scr, int lane) {
#pragma unroll 8
    for (int i = 0; i < 32; ++i) { const int kk = 2 * i + (lane >> 5); scr[kk * 33 + (lane & 31)] = W[(size_t)(k0 + kk) * N + n0 + (lane & 31)]; }
    asm volatile("s_waitcnt lgkmcnt(0)" ::: "memory");
    const int c = lane & 7;
#pragma unroll
    for (int j = 0; j < 4; ++j) { const int n = (lane >> 3) + 8 * j; const LAS float* s = scr + (8 * c) * 33 + n;
        u32x4 o; o.x = pk(s[0 * 33], s[1 * 33]); o.y = pk(s[2 * 33], s[3 * 33]); o.z = pk(s[4 * 33], s[5 * 33]); o.w = pk(s[6 * 33], s[7 * 33]);
        *(u32x4*)(WT + (size_t)(n0_out + n) * K + k0 + 8 * c) = o; }
    asm volatile("s_waitcnt lgkmcnt(0)" ::: "memory");
}
__device__ __forceinline__ int remap_gu(int n0) { if (n0 < FF) return 256 * (n0 >> 7) + (n0 & 127); const int m = n0 - FF; return 256 * (m >> 7) + 128 + (m & 127); }
__device__ __forceinline__ int remap_kv(int n0) { const int h = n0 >> 7, j = n0 & 127; return (j < 64) ? (64 * h + j) : (512 + 64 * h + (j - 64)); }

typedef unsigned short u16_t;
__device__ __forceinline__ int iclamp(int v, int lo, int hi) { return min(max(v, lo), hi); }
template <bool NA>
__device__ __forceinline__ void attn_unit(LAS unsigned char* lds, const bf16_t* Qsrc, const bf16_t* Ksrc, const bf16_t* Vsrc, const float* rpb, bf16_t* O, int b, int h, int ub) {
    constexpr int DK = NA ? 64 : 96, ND0 = DK / 16, KP = NA ? 144 : 208, VP = 144;
    constexpr int QPITCH = NA ? 2048 : 768, KPITCH = NA ? 2048 : 768, VPITCH = NA ? 2048 : 512;
    constexpr int KB_BYTES = 13312, ABUF = 22528, BIAS_OFF = 2 * ABUF;
    constexpr float THR = 8.0f;
    int tid = threadIdx.x; asm volatile("" : "+v"(tid));
    const int lane = tid & 63, wave = __builtin_amdgcn_readfirstlane(tid >> 6), r32 = lane & 31, hi = lane >> 5;
    const size_t tok0 = (size_t)b * SEQ;
    int qgr = 0, qc = 0, rs_w = 0, t_lo = 0, t_hi = 64; size_t qtok;
    if (NA) { const int r0 = ub * 4; qgr = r0 + (wave >> 1); qc = 32 * (wave & 1) + r32; qtok = tok0 + qgr * 64 + qc;
        rs_w = iclamp(qgr - 4, 0, 56); t_lo = iclamp(r0 - 4, 0, 56); t_hi = iclamp(r0 - 1, 0, 56) + 8; }
    else { qtok = tok0 + ub * 256 + wave * 32 + r32; }
    bf16x8 qr[ND0];
    { const bf16_t* qp = Qsrc + qtok * QPITCH + (NA ? 64 * h : 96 * h) + 8 * hi;
#pragma unroll
      for (int d0 = 0; d0 < ND0; ++d0) qr[d0] = *(const bf16x8*)(qp + 16 * d0); }
    const bf16_t* kg0; const bf16_t* kg1 = nullptr; int lk0, lk1 = 0;
    if (NA) { const int key = tid >> 3, ch = tid & 7; kg0 = Ksrc + (tok0 + key) * KPITCH + 512 + 64 * h + 8 * ch; lk0 = key * KP + 16 * ch; }
    else { const int key0 = tid / 12, ch0 = tid % 12; kg0 = Ksrc + (tok0 + key0) * KPITCH + 96 * h + 8 * ch0; lk0 = key0 * KP + 16 * ch0;
        const int c1 = 512 + (tid & 255), key1 = c1 / 12, ch1 = c1 % 12; kg1 = Ksrc + (tok0 + key1) * KPITCH + 96 * h + 8 * ch1; lk1 = key1 * KP + 16 * ch1; }
    const bool two = !NA && tid < 256;
    const bf16_t* vg = Vsrc + (tok0 + lane) * VPITCH + (NA ? 1024 + 64 * h : 64 * h) + 8 * wave;
    const int pos = (lane & ~12) | ((lane & 4) << 1) | ((lane & 8) >> 1);
    const int lv = KB_BYTES + (8 * wave) * VP + pos * 2;
    const int ka = r32 * KP + 16 * hi, va = KB_BYTES + r32 * VP + 16 * hi;
    if (NA) { if (tid < 465) ((LAS float*)(lds + BIAS_OFF))[tid] = rpb[h * 465 + tid] * LOG2E; }
    u32x4 rk0, rk1 = (u32x4){0u, 0u, 0u, 0u}, rv;
#define AT_LOAD(t) do { rk0 = *(const u32x4*)(kg0 + (size_t)(t) * 64 * KPITCH); if (two) rk1 = *(const u32x4*)(kg1 + (size_t)(t) * 64 * KPITCH); rv = *(const u32x4*)(vg + (size_t)(t) * 64 * VPITCH); } while (0)
#define AT_STORE(buf) do { LAS unsigned char* B_ = lds + (buf) * ABUF; *(LAS u32x4*)(B_ + lk0) = rk0; if (two) *(LAS u32x4*)(B_ + lk1) = rk1; \
        LAS unsigned char* V_ = B_ + lv; \
        *(LAS u16_t*)(V_ + 0 * VP) = (u16_t)(rv.x & 0xffffu); *(LAS u16_t*)(V_ + 1 * VP) = (u16_t)(rv.x >> 16); *(LAS u16_t*)(V_ + 2 * VP) = (u16_t)(rv.y & 0xffffu); *(LAS u16_t*)(V_ + 3 * VP) = (u16_t)(rv.y >> 16); \
        *(LAS u16_t*)(V_ + 4 * VP) = (u16_t)(rv.z & 0xffffu); *(LAS u16_t*)(V_ + 5 * VP) = (u16_t)(rv.z >> 16); *(LAS u16_t*)(V_ + 6 * VP) = (u16_t)(rv.w & 0xffffu); *(LAS u16_t*)(V_ + 7 * VP) = (u16_t)(rv.w >> 16); } while (0)
    float mx = -1e30f, l = 0.f; f32x16 o0, o1;
#pragma unroll
    for (int r = 0; r < 16; ++r) { o0[r] = 0.f; o1[r] = 0.f; }
    AT_LOAD(t_lo); AT_STORE(0);
    __syncthreads();
#pragma unroll 1
    for (int t = t_lo; t < t_hi; ++t) {
        const int buf = (t - t_lo) & 1;
        if (t + 1 < t_hi) AT_LOAD(t + 1);
        const bool active = NA ? (t >= rs_w && t < rs_w + 8) : true;
        if (active) {
            LAS unsigned char* B = lds + buf * ABUF;
            f32x16 p0, p1;
#pragma unroll
            for (int r = 0; r < 16; ++r) { p0[r] = 0.f; p1[r] = 0.f; }
#pragma unroll
            for (int d0 = 0; d0 < ND0; ++d0) { const bf16x8 a0 = *(const LAS bf16x8*)(B + ka + 32 * d0), a1 = *(const LAS bf16x8*)(B + ka + 32 * KP + 32 * d0);
                p0 = __builtin_amdgcn_mfma_f32_32x32x16_bf16(a0, qr[d0], p0, 0, 0, 0); p1 = __builtin_amdgcn_mfma_f32_32x32x16_bf16(a1, qr[d0], p1, 0, 0, 0); }
            if (NA) {
                const int ws = iclamp(qc - 8, 0, 48); const LAS float* bt = (const LAS float*)(lds + BIAS_OFF) + (t - qgr + 7) * 31;
                constexpr float C = 0.125f * LOG2E;
#pragma unroll
                for (int r = 0; r < 16; ++r) { const int kc0 = (r & 3) + 8 * (r >> 2) + 4 * hi, kc1 = kc0 + 32;
                    const int d0_ = kc0 - qc + 15, d1_ = kc1 - qc + 15;
                    const bool v0 = (kc0 >= ws) && (kc0 < ws + 16), v1 = (kc1 >= ws) && (kc1 < ws + 16);
                    const float b0 = bt[iclamp(d0_, 0, 30)], b1 = bt[iclamp(d1_, 0, 30)];
                    p0[r] = v0 ? fmaf(p0[r], C, b0) : -1e30f; p1[r] = v1 ? fmaf(p1[r], C, b1) : -1e30f; }
            }
            float mt = fmaxf(p0[0], p1[0]);
#pragma unroll
            for (int r = 1; r < 16; ++r) mt = fmaxf(mt, fmaxf(p0[r], p1[r]));
            mt = fmaxf(mt, __shfl_xor(mt, 32));
            if (__any(mt > mx + THR)) { const float mn = fmaxf(mx, mt); const float al = __builtin_amdgcn_exp2f(mx - mn); mx = mn; l *= al;
#pragma unroll
                for (int r = 0; r < 16; ++r) { o0[r] *= al; o1[r] *= al; } }
            float ls = 0.f;
#pragma unroll
            for (int r = 0; r < 16; ++r) { p0[r] = __builtin_amdgcn_exp2f(p0[r] - mx); p1[r] = __builtin_amdgcn_exp2f(p1[r] - mx); ls += p0[r] + p1[r]; }
            l += ls;
            u32x4 pf[4];
#pragma unroll
            for (int s = 0; s < 2; ++s) {
                pf[s] = (u32x4){pk(p0[8 * s], p0[8 * s + 1]), pk(p0[8 * s + 2], p0[8 * s + 3]), pk(p0[8 * s + 4], p0[8 * s + 5]), pk(p0[8 * s + 6], p0[8 * s + 7])};
                pf[2 + s] = (u32x4){pk(p1[8 * s], p1[8 * s + 1]), pk(p1[8 * s + 2], p1[8 * s + 3]), pk(p1[8 * s + 4], p1[8 * s + 5]), pk(p1[8 * s + 6], p1[8 * s + 7])};
            }
#pragma unroll
            for (int ks = 0; ks < 4; ++ks) {
                const bf16x8 pb = __builtin_bit_cast(bf16x8, pf[ks]);
                const bf16x8 v0 = *(const LAS bf16x8*)(B + va + 32 * ks), v1 = *(const LAS bf16x8*)(B + va + 32 * VP + 32 * ks);
                o0 = __builtin_amdgcn_mfma_f32_32x32x16_bf16(v0, pb, o0, 0, 0, 0); o1 = __builtin_amdgcn_mfma_f32_32x32x16_bf16(v1, pb, o1, 0, 0, 0);
            }
        }
        if (t + 1 < t_hi) AT_STORE(buf ^ 1);
        __syncthreads();
    }
#undef AT_LOAD
#undef AT_STORE
    l += __shfl_xor(l, 32);
    const float inv = 1.0f / l;
    bf16_t* op = O + qtok * 1024 + (NA ? 64 * h : 512 + 64 * h) + 4 * hi;
#pragma unroll
    for (int g = 0; g < 4; ++g) {
        u32x2 w0; w0.x = pk(o0[4 * g] * inv, o0[4 * g + 1] * inv); w0.y = pk(o0[4 * g + 2] * inv, o0[4 * g + 3] * inv);
        u32x2 w1; w1.x = pk(o1[4 * g] * inv, o1[4 * g + 1] * inv); w1.y = pk(o1[4 * g + 2] * inv, o1[4 * g + 3] * inv);
        *(u32x2*)(op + 8 * g) = w0; *(u32x2*)(op + 32 + 8 * g) = w1;
    }
}

constexpr int NPHASE = 14;
struct Args { const float* in[20]; float* out; unsigned char* ws; int ph_lo, ph_hi; };

__global__ void __launch_bounds__(512, 2) mk_fwd(Args a) {
    extern __shared__ __attribute__((aligned(16))) unsigned char lds_raw[];
    LAS unsigned char* lds = (LAS unsigned char*)lds_raw;
    cg::grid_group grid = cg::this_grid();
    const int G = gridDim.x, bx = blockIdx.x, NGW = G * 8;
#define TIDS int tid = threadIdx.x; asm volatile("" : "+v"(tid)); const int lane = tid & 63, wave = __builtin_amdgcn_readfirstlane(tid >> 6), gw = bx * 8 + wave; (void)lane; (void)gw
#define PTRS unsigned char* ws = a.ws; asm volatile("" : "+s"(ws)); const float* x = a.in[0]; float* out = a.out; f32x2* cs = (f32x2*)(ws + WS_CS); bf16_t* Wgu1 = (bf16_t*)(ws + WS_WGU1); bf16_t* Wd1 = (bf16_t*)(ws + WS_WD1); bf16_t* Win = (bf16_t*)(ws + WS_WIN); bf16_t* Wuq = (bf16_t*)(ws + WS_WUQ); bf16_t* Wukv = (bf16_t*)(ws + WS_WUKV); bf16_t* Wout = (bf16_t*)(ws + WS_WOUT); bf16_t* Wgu2 = (bf16_t*)(ws + WS_WGU2); bf16_t* Wd2 = (bf16_t*)(ws + WS_WD2); bf16_t* XN = (bf16_t*)(ws + WS_XN); bf16_t* Fb = (bf16_t*)(ws + WS_F); bf16_t* Hb = (bf16_t*)(ws + WS_H); bf16_t* Zb = (bf16_t*)(ws + WS_H); bf16_t* Qm = (bf16_t*)(ws + WS_QM); bf16_t* Km = (bf16_t*)(ws + WS_KM); bf16_t* Vm = (bf16_t*)(ws + WS_VM); bf16_t* CQN = (bf16_t*)(ws + WS_CQN); bf16_t* CKVN = (bf16_t*)(ws + WS_CKVN); (void)x; (void)out; (void)cs; (void)Wgu1; (void)Wd1; (void)Win; (void)Wuq; (void)Wukv; (void)Wout; (void)Wgu2; (void)Wd2; (void)XN; (void)Fb; (void)Hb; (void)Zb; (void)Qm; (void)Km; (void)Vm; (void)CQN; (void)CKVN
    const int lo = a.ph_lo, hi = a.ph_hi;
#ifndef PH_MASK
#define PH_MASK 0x3fff
#endif
#define IN(k) ((((PH_MASK) >> (k)) & 1) && lo <= (k) && (k) < hi)
#define SEAM(k) do { if (IN(k) && IN((k) + 1)) grid.sync(); } while (0)
    using SO = pg8::StaticOrder;

    if (IN(0)) { TIDS; PTRS;
        if (bx == 0) {
            const int pos = tid >> 3, f = tid & 7;
            const float inv = 1.0f / powf(10000.0f, (float)f * 0.125f);
            const float ang = (float)pos * inv;
            const float k = rintf(ang * 0.15915494309189535f);
            float r = fmaf(-k, 6.2831854820251465f, ang); r = fmaf(-k, -1.7484555e-7f, r);
            cs[tid] = (f32x2){__cosf(r), __sinf(r)};
        }
        LAS float* scr = (LAS float*)(lds + wave * 16384);
        constexpr int I_GU = 16 * 176, I_D = 44 * 32, I_IN = 16 * 61, I_UQ = 4 * 24, I_UKV = 2 * 32, I_OUT = 16 * 32;
        constexpr int NITEMS = 2 * I_GU + 2 * I_D + I_IN + I_UQ + I_UKV + I_OUT;
        for (int it = gw; it < NITEMS; it += NGW) {
            int r = it;
            if (r < I_GU) { const int kb = r / 176, nb = r % 176; transpose_item(a.in[2], D, NGU, Wgu1, 64 * kb, 32 * nb, remap_gu(32 * nb), scr, lane); continue; } r -= I_GU;
            if (r < I_GU) { const int kb = r / 176, nb = r % 176; transpose_item(a.in[17], D, NGU, Wgu2, 64 * kb, 32 * nb, remap_gu(32 * nb), scr, lane); continue; } r -= I_GU;
            if (r < I_D) { const int kb = r / 32, nb = r % 32; transpose_item(a.in[3], FF, D, Wd1, 64 * kb, 32 * nb, 32 * nb, scr, lane); continue; } r -= I_D;
            if (r < I_D) { const int kb = r / 32, nb = r % 32; transpose_item(a.in[18], FF, D, Wd2, 64 * kb, 32 * nb, 32 * nb, scr, lane); continue; } r -= I_D;
            if (r < I_IN) { const int kb = r / 61, nb = r % 61; transpose_item(a.in[6], D, DIN, Win, 64 * kb, 32 * nb, 32 * nb, scr, lane); continue; } r -= I_IN;
            if (r < I_UQ) { const int kb = r / 24, nb = r % 24; transpose_item(a.in[9], 256, 768, Wuq, 64 * kb, 32 * nb, 32 * nb, scr, lane); continue; } r -= I_UQ;
            if (r < I_UKV) { const int kb = r / 32, nb = r % 32; transpose_item(a.in[11], 128, 1024, Wukv, 64 * kb, 32 * nb, remap_kv(32 * nb), scr, lane); continue; } r -= I_UKV;
            { const int kb = r / 32, nb = r % 32; transpose_item(a.in[14], D, D, Wout, 64 * kb, 32 * nb, 32 * nb, scr, lane); }
        }
        for (int i = bx * 512 + tid; i < (DINP - DIN) * D / 8; i += G * 512) ((u32x4*)(Win + (size_t)DIN * D))[i] = (u32x4){0u, 0u, 0u, 0u};
        for (int m = gw; m < M; m += NGW) row_norm_to_bf16(x + (size_t)m * D, a.in[1], XN + (size_t)m * D, lane);
    }
    SEAM(0);
    if (IN(1)) { PTRS; pg8::Gemm g{XN, Wgu1, M, NGU, D}; SO S; S.init(M, NGU, G, bx); EpiSwiGLU E{Hb, FF};
        pg8::gemm_phase<EpiSwiGLU, SO, true, true>(lds, g, S, E); }
    SEAM(1);
    if (IN(2)) { PTRS; pg8::Gemm g{Hb, Wd1, M, D, FF}; SO S; S.init(M, D, G, bx); pg8::EpiBf16<0> E{Fb, D, nullptr, 0, 0, 1.f};
        pg8::gemm_phase<pg8::EpiBf16<0>, SO, true, true>(lds, g, S, E); }
    SEAM(2);
    if (IN(3)) { TIDS; PTRS; for (int m = gw; m < M; m += NGW) row_mid<true>(Fb + (size_t)m * D, x + (size_t)m * D, out + (size_t)m * D, a.in[4], 0.5f, a.in[5], XN + (size_t)m * D, lane); }
    SEAM(3);
    if (IN(4)) { PTRS; pg8::Gemm g{XN, Win, M, DINP, D}; SO S; S.init(M, DINP, G, bx); pg8::EpiBf16<0> E{Zb, DINP, nullptr, 0, 0, 1.f};
        pg8::gemm_phase<pg8::EpiBf16<0>, SO, true, true>(lds, g, S, E); }
    SEAM(4);
    if (IN(5)) { TIDS; PTRS; for (int m = gw; m < M; m += NGW) mla_prep_row(Zb + (size_t)m * DINP, m, a.in[8], a.in[10], cs, CQN, CKVN, Km, lane); }
    SEAM(5);
    if (IN(6)) { PTRS;
        { pg8::Gemm g{CQN, Wuq, M, 768, 256}; SO S; S.init(M, 768, G, bx); EpiQ E{Qm, cs}; pg8::gemm_phase<EpiQ, SO, true, true>(lds, g, S, E); }
        { pg8::Gemm g{CKVN, Wukv, M, 1024, 128}; SO S; S.init(M, 1024, G, bx); EpiKV E{Km, Vm}; pg8::gemm_phase<EpiKV, SO, true, true>(lds, g, S, E); }
    }
    SEAM(6);
    if (IN(7)) { PTRS;
#ifndef NA_NAIVE
#define NA_NAIVE 0
#endif
#ifndef MLA_NAIVE
#define MLA_NAIVE 0
#endif
#if NA_NAIVE
        for (int u = bx; u < 512; u += G) na_naive(Zb, a.in[7], XN, u);
#else
        for (int u = bx; u < 1024; u += G) { const int idx = (u >> 8) * 32 + ((u >> 3) & 31), bh = (u & 7) * 8 + (idx >> 4); attn_unit<true>(lds, Zb, Zb, Zb, a.in[7], XN, bh >> 3, bh & 7, idx & 15); }
#endif
#if MLA_NAIVE
        for (int u = bx; u < 512; u += G) mla_naive(lds, Qm, Km, Vm, XN, u);
#else
        for (int u = bx; u < 1024; u += G) { const int idx = (u >> 8) * 32 + ((u >> 3) & 31), bh = (u & 7) * 8 + (idx >> 4); attn_unit<false>(lds, Qm, Km, Vm, nullptr, XN, bh >> 3, bh & 7, idx & 15); }
#endif
    }
    SEAM(7);
    if (IN(8)) { TIDS; PTRS; for (int m = gw; m < M; m += NGW) row_onorm(XN + (size_t)m * D, a.in[12], a.in[13], lane); }
    SEAM(8);
    if (IN(9)) { PTRS; pg8::Gemm g{XN, Wout, M, D, D}; SO S; S.init(M, D, G, bx); pg8::EpiBf16<0> E{Fb, D, nullptr, 0, 0, 1.f};
        pg8::gemm_phase<pg8::EpiBf16<0>, SO, true, true>(lds, g, S, E); }
    SEAM(9);
    if (IN(10)) { TIDS; PTRS; for (int m = gw; m < M; m += NGW) row_mid<true>(Fb + (size_t)m * D, out + (size_t)m * D, out + (size_t)m * D, a.in[15], 1.0f, a.in[16], XN + (size_t)m * D, lane); }
    SEAM(10);
    if (IN(11)) { PTRS; pg8::Gemm g{XN, Wgu2, M, NGU, D}; SO S; S.init(M, NGU, G, bx); EpiSwiGLU E{Hb, FF};
        pg8::gemm_phase<EpiSwiGLU, SO, true, true>(lds, g, S, E); }
    SEAM(11);
    if (IN(12)) { PTRS; pg8::Gemm g{Hb, Wd2, M, D, FF}; SO S; S.init(M, D, G, bx); pg8::EpiBf16<0> E{Fb, D, nullptr, 0, 0, 1.f};
        pg8::gemm_phase<pg8::EpiBf16<0>, SO, true, true>(lds, g, S, E); }
    SEAM(12);
    if (IN(13)) { TIDS; PTRS; for (int m = gw; m < M; m += NGW) row_mid<false>(Fb + (size_t)m * D, out + (size_t)m * D, out + (size_t)m * D, a.in[19], 0.5f, nullptr, nullptr, lane); }
#undef IN
#undef SEAM
}
}

#ifndef MK_MULTI
#define MK_MULTI 0
#endif
extern "C" void kernel_launch(void* const* d_in, const int* in_sizes, int n_in, void* d_out, int out_size, void* d_ws, size_t ws_size, hipStream_t stream) {
    static int grid = 0;
    if (grid == 0) {
        if (n_in != 20 || out_size != mk::M * mk::D || ws_size < mk::WS_END) { fprintf(stderr, "kernel_launch: unexpected shapes (n_in %d out %d ws %zu)\n", n_in, out_size, ws_size); grid = -1; return; }
        int dev = 0, cus = 0, per_cu = 0;
        (void)hipGetDevice(&dev); (void)hipDeviceGetAttribute(&cus, hipDeviceAttributeMultiprocessorCount, dev);
        if (hipFuncSetAttribute((const void*)mk::mk_fwd, hipFuncAttributeMaxDynamicSharedMemorySize, mk::LDS_BYTES) != hipSuccess) { fprintf(stderr, "kernel_launch: hipFuncSetAttribute failed\n"); grid = -1; return; }
        if (hipOccupancyMaxActiveBlocksPerMultiprocessor(&per_cu, (const void*)mk::mk_fwd, 512, mk::LDS_BYTES) != hipSuccess || per_cu < 1) { fprintf(stderr, "kernel_launch: occupancy query says %d\n", per_cu); grid = -1; (void)hipGetLastError(); return; }
        grid = cus;
    }
    if (grid < 0) return;
    mk::Args a{};
    for (int i = 0; i < 20; ++i) a.in[i] = (const float*)d_in[i];
    a.out = (float*)d_out; a.ws = (unsigned char*)d_ws;
#if MK_MULTI
    for (int ph = 0; ph < mk::NPHASE; ++ph) { a.ph_lo = ph; a.ph_hi = ph + 1; hipLaunchKernelGGL(mk::mk_fwd, dim3(grid), dim3(512), mk::LDS_BYTES, stream, a); }
#else
    a.ph_lo = 0; a.ph_hi = mk::NPHASE;
    void* args[] = {&a};
    hipError_t e = hipLaunchCooperativeKernel((const void*)mk::mk_fwd, dim3(grid), dim3(512), args, mk::LDS_BYTES, stream);
    if (e != hipSuccess) fprintf(stderr, "kernel_launch: cooperative launch failed: %s\n", hipGetErrorString(e));
#endif
}
```

```cpp
#include <hip/hip_runtime.h>
#include <hip/hip_cooperative_groups.h>
#include <cstdio>
namespace cg = cooperative_groups;
#include <cstdint>
namespace pg8 {
#define PG8_LAS __attribute__((address_space(3)))
typedef unsigned short bf16_t;
typedef short bf16x8 __attribute__((ext_vector_type(8)));
typedef float f32x4 __attribute__((ext_vector_type(4)));
typedef unsigned u32x4 __attribute__((ext_vector_type(4)));
constexpr int BM = 256, BK = 64, HALF = 128, HTB = HALF * BK * 2  , STAGE_BYTES = 8 * HTB, NXCD = 8, WGM = 8;

__host__ __device__ __forceinline__ int lds_byte(int r, int c) { const int st = (r >> 4) * 2 + (c >> 5), rr = r & 15, cc = c & 31, ob = rr * 64 + cc * 2; return st * 1024 + (ob ^ (((ob >> 9) & 1) << 5)); }
__host__ __device__ __forceinline__ void stage_rc(int b, int& R, int& C) { const int st = b / 1024, sb = b % 1024, swz = sb ^ (((sb >> 9) & 1) << 5); R = (st >> 1) * 16 + swz / 64; C = (st & 1) * 32 + (swz % 64) / 2; }
__host__ __device__ __forceinline__ int perm32(int rho) { const int n = rho >> 4, i = rho & 15; return 8 * (i >> 2) + 4 * n + (i & 3); }

struct Unit { int pm, pn; };
struct Gemm { const bf16_t* A; const bf16_t* Bt; int M, N, K; };

struct StaticOrder {
    int nM, nN, nwg, G, c;
    __host__ __device__ void init(int M, int N, int G_, int c_) { nM = M / BM; nN = N / BM; nwg = nM * nN; G = G_; c = c_; }
    __host__ __device__ bool next(int i, Unit& u) const {
        const long L = (long)i * G + c; if (L >= nwg) return false;
        int wgid = (int)L; { const int q = nwg / NXCD, r = nwg % NXCD, xcd = wgid % NXCD, off = wgid / NXCD; wgid = (xcd < r ? xcd * (q + 1) : r * (q + 1) + (xcd - r) * q) + off; }
        const int nig = WGM * nN, gid = wgid / nig, fm = gid * WGM, gsz = (nM - fm) < WGM ? (nM - fm) : WGM;
        u.pm = fm + ((wgid % nig) % gsz); u.pn = (wgid % nig) / gsz; return true;
    }
    __device__ __forceinline__ void a_ready(const Unit&) const {}
    __device__ __forceinline__ void done(const Unit&) const {}
};

__device__ __forceinline__ unsigned cvt_pk_bf16(float lo, float hi) { unsigned r; asm volatile("v_cvt_pk_bf16_f32 %0, %1, %2" : "=v"(r) : "v"(lo), "v"(hi)); return r; }
typedef float f32x2 __attribute__((ext_vector_type(2)));
__device__ __forceinline__ f32x2 gelu_pk(f32x2 v) {
    const f32x2 av = __builtin_elementwise_abs(v), d = av * 0.2316418882f + 1.0f;
    f32x2 t; t.x = __builtin_amdgcn_rcpf(d.x); t.y = __builtin_amdgcn_rcpf(d.y);
    f32x2 q = t * 0.5307027145f + (-0.7265760135f); q = q * t + 0.7107068705f; q = q * t + (-0.142248368f); q = q * t + 0.127414796f; q = q * t;
    const f32x2 s = (v * v) * (-0.72134752044f);
    f32x2 e; e.x = __builtin_amdgcn_exp2f(s.x); e.y = __builtin_amdgcn_exp2f(s.y);
    const f32x2 m = v * (q * e), r = v - m;
    f32x2 o; o.x = v.x < 0.f ? m.x : r.x; o.y = v.y < 0.f ? m.y : r.y; return o;
}

template <int ACT  > struct EpiBf16 {
    static constexpr bool PERM = true, AFTER_DRAIN = false; static_assert(ACT == 0 || ACT == 1, "EpiBf16: ACT is 0 (none) or 1 (gelu_pk)");
    bf16_t* O; int ldc; const float* bias; int split_cols; size_t split_stride; float scale0;
    __device__ __forceinline__ void operator()(const f32x4 (&acc)[2][2][4][2], const Unit& u, int wr, int wc, int fr, int fq) const {
        const int row0 = u.pm * BM + wr * 64 + fr; int colt = u.pn * BM; bf16_t* base = O;
        float sc = 1.f; if (split_cols) { const int t = colt / split_cols; base += (size_t)t * split_stride; colt -= t * split_cols; if (t == 0) sc = scale0; }
        const int col0 = colt + wc * 32 + 8 * fq, bcol0 = u.pn * BM + wc * 32 + 8 * fq;
        f32x4 bv[2][2];
#pragma unroll
        for (int bj = 0; bj < 2; ++bj)
#pragma unroll
            for (int n = 0; n < 2; ++n) bv[bj][n] = bias ? *(const f32x4*)(bias + bcol0 + bj * HALF + 4 * n) : (f32x4){0.f, 0.f, 0.f, 0.f};
#pragma unroll
        for (int ai = 0; ai < 2; ++ai)
#pragma unroll
            for (int m = 0; m < 4; ++m) { bf16_t* rowp = base + (size_t)(row0 + ai * HALF + m * 16) * ldc + col0;
#pragma unroll
                for (int bj = 0; bj < 2; ++bj) { f32x4 v0 = acc[ai][bj][m][0] + bv[bj][0], v1 = acc[ai][bj][m][1] + bv[bj][1];
                    if (ACT == 1) { f32x2 a = gelu_pk((f32x2){v0[0], v0[1]}), b = gelu_pk((f32x2){v0[2], v0[3]}), c = gelu_pk((f32x2){v1[0], v1[1]}), d = gelu_pk((f32x2){v1[2], v1[3]});
                        v0 = (f32x4){a.x, a.y, b.x, b.y}; v1 = (f32x4){c.x, c.y, d.x, d.y}; }
                    v0 = v0 * sc; v1 = v1 * sc; u32x4 w; w.x = cvt_pk_bf16(v0[0], v0[1]); w.y = cvt_pk_bf16(v0[2], v0[3]); w.z = cvt_pk_bf16(v1[0], v1[1]); w.w = cvt_pk_bf16(v1[2], v1[3]);
                    *(u32x4*)(rowp + bj * HALF) = w; } }
    }
};

struct PanelStats {
    unsigned* xbuf;
    unsigned* cnt;
    unsigned* tmo;
    int ntn; float eps;
    unsigned code;
    __device__ __forceinline__ bool run(const f32x4 (&v)[2][2][4][2], const Unit& u, int wr, int wc, int fr, int fq, PG8_LAS unsigned char* lds, int wid, int lane) const {
        typedef float f32x2v __attribute__((ext_vector_type(2)));
        PG8_LAS f32x2v* P = (PG8_LAS f32x2v*)lds;
        PG8_LAS f32x2v* S = (PG8_LAS f32x2v*)(lds + 8192);
        PG8_LAS unsigned* flag = (PG8_LAS unsigned*)(lds + 8192 + 2048);
#pragma unroll
        for (int ai = 0; ai < 2; ++ai)
#pragma unroll
            for (int m = 0; m < 4; ++m) {
                float s = 0.f;
#pragma unroll
                for (int bj = 0; bj < 2; ++bj)
#pragma unroll
                    for (int n = 0; n < 2; ++n) { const f32x4 x = v[ai][bj][m][n]; s += (x[0] + x[1]) + (x[2] + x[3]); }
                s += __shfl_xor(s, 16); s += __shfl_xor(s, 32);
                const float mw = s * (1.0f / 64.0f); float q = 0.f;
#pragma unroll
                for (int bj = 0; bj < 2; ++bj)
#pragma unroll
                    for (int n = 0; n < 2; ++n) { const f32x4 d = v[ai][bj][m][n] - mw; q += (d[0] * d[0] + d[1] * d[1]) + (d[2] * d[2] + d[3] * d[3]); }
                q += __shfl_xor(q, 16); q += __shfl_xor(q, 32);
                if (fq == 0) P[(ai * HALF + wr * 64 + m * 16 + fr) * 4 + wc] = (f32x2v){mw, q};
            }
        asm volatile("s_waitcnt lgkmcnt(0)" ::: "memory"); __builtin_amdgcn_s_barrier(); asm volatile("" ::: "memory");
#if defined(BROKEN_EXCHANGE_NO_WAIT)
#warning BROKEN CONTROL BUILD: the row-statistics exchange does not wait; results are wrong by design
        if (blockIdx.x >= 64) { const long long t0_ = clock64(); while (clock64() - t0_ < 60000) __builtin_amdgcn_s_sleep(8); }
#endif
        const int row = wid * 32 + (lane & 31);
        if (lane < 32) {
            const f32x2v a = P[row * 4 + 0], b = P[row * 4 + 1], c = P[row * 4 + 2], d = P[row * 4 + 3];
            const float mt = (a.x + b.x + c.x + d.x) * 0.25f;
            const float da = a.x - mt, db = b.x - mt, dc = c.x - mt, dd = d.x - mt;
            const float m2 = (a.y + b.y) + (c.y + d.y) + 64.0f * ((da * da + db * db) + (dc * dc + dd * dd));
            unsigned long long* slot = (unsigned long long*)xbuf + ((size_t)(u.pm * BM + row) * 4 + u.pn);
            __hip_atomic_store(slot, ((unsigned long long)__float_as_uint(m2) << 32) | __float_as_uint(mt), __ATOMIC_RELAXED, __HIP_MEMORY_SCOPE_AGENT);
        }
        asm volatile("s_waitcnt vmcnt(0)" ::: "memory");
        if (lane == 0) __hip_atomic_fetch_add(cnt + 64 * u.pm, 1u, __ATOMIC_RELAXED, __HIP_MEMORY_SCOPE_AGENT);
        if (wid == 0) {
            bool dead = false; const unsigned long long t0 = __builtin_amdgcn_s_memrealtime(); const unsigned want = 8u * (unsigned)ntn;
            for (;;) {
#if defined(BROKEN_EXCHANGE_NO_WAIT)
                break;
#endif
                if ((unsigned)__builtin_amdgcn_readfirstlane(__hip_atomic_load(cnt + 64 * u.pm, __ATOMIC_RELAXED, __HIP_MEMORY_SCOPE_AGENT)) >= want) break;
                if (__builtin_amdgcn_s_memrealtime() - t0 > 2000000ull) {
                    if (lane == 0) { unsigned expect = 0u; __hip_atomic_compare_exchange_strong(tmo + 1, &expect, code | (unsigned)(u.pm & 0xff), __ATOMIC_RELAXED, __ATOMIC_RELAXED, __HIP_MEMORY_SCOPE_AGENT);
                                     __hip_atomic_store(tmo, 1u, __ATOMIC_RELAXED, __HIP_MEMORY_SCOPE_AGENT); }
                    dead = true; break; }
                __builtin_amdgcn_s_sleep(2);
            }
            __builtin_amdgcn_fence(__ATOMIC_ACQUIRE, "agent");
            if (lane == 0) flag[0] = dead ? 1u : 0u;
        }
        asm volatile("s_waitcnt vmcnt(0) lgkmcnt(0)" ::: "memory"); __builtin_amdgcn_s_barrier(); asm volatile("" ::: "memory");
        const bool bad = flag[0] != 0u;
        if (lane < 32) {
            const unsigned long long* slot = (const unsigned long long*)xbuf + (size_t)(u.pm * BM + row) * 4; float mt[4], m2[4]; float ms = 0.f;
#pragma unroll
            for (int t = 0; t < 4; ++t) { if (t < ntn) { const unsigned long long w = __hip_atomic_load(slot + t, __ATOMIC_RELAXED, __HIP_MEMORY_SCOPE_AGENT); mt[t] = __uint_as_float((unsigned)w); m2[t] = __uint_as_float((unsigned)(w >> 32)); } else { mt[t] = 0.f; m2[t] = 0.f; } ms += mt[t]; }
            const float mean = ms / (float)ntn; float q = 0.f;
#pragma unroll
            for (int t = 0; t < 4; ++t) if (t < ntn) { const float dm = mt[t] - mean; q += m2[t] + 256.0f * dm * dm; }
            S[row] = (f32x2v){mean, 1.0f / sqrtf(q / (256.0f * (float)ntn) + eps)};
        }
        asm volatile("s_waitcnt lgkmcnt(0)" ::: "memory"); __builtin_amdgcn_s_barrier(); asm volatile("" ::: "memory");
        return bad;
    }
};
struct EpiLnRes {
    static constexpr bool PERM = false, AFTER_DRAIN = true;
    const float* base; float* out; int ldc; const float* bias; PanelStats st; unsigned poison;
    __device__ __forceinline__ void fused(f32x4 (&acc)[2][2][4][2], const Unit& u, int wr, int wc, int fr, int fq, PG8_LAS unsigned char* lds, int wid, int lane) const {
        typedef float f32x2v __attribute__((ext_vector_type(2)));
        const PG8_LAS f32x2v* S = (const PG8_LAS f32x2v*)(lds + 8192);
        const int col0 = u.pn * BM + wc * 32 + 4 * fq;
#pragma unroll
        for (int bj = 0; bj < 2; ++bj)
#pragma unroll
            for (int n = 0; n < 2; ++n) { const f32x4 bv = bias ? *(const f32x4*)(bias + col0 + bj * HALF + n * 16) : (f32x4){0.f, 0.f, 0.f, 0.f};
#pragma unroll
                for (int ai = 0; ai < 2; ++ai)
#pragma unroll
                    for (int m = 0; m < 4; ++m) acc[ai][bj][m][n] += bv; }
        f32x4 pre[4][2][2];
#pragma unroll
        for (int m = 0; m < 4; ++m) { const size_t off = (size_t)(u.pm * BM + wr * 64 + m * 16 + fr) * ldc + col0;
#pragma unroll
            for (int bj = 0; bj < 2; ++bj)
#pragma unroll
                for (int n = 0; n < 2; ++n) pre[m][bj][n] = *(const f32x4*)(base + off + bj * HALF + n * 16); }
        const bool bad = st.run(acc, u, wr, wc, fr, fq, lds, wid, lane) || poison != 0u;
        const float qnan = __builtin_nanf("");
#pragma unroll
        for (int ai = 0; ai < 2; ++ai)
#pragma unroll
            for (int m = 0; m < 4; ++m) { const int r = ai * HALF + wr * 64 + m * 16 + fr; const f32x2v sr = S[r]; const size_t off = (size_t)(u.pm * BM + r) * ldc + col0;
#pragma unroll
                for (int bj = 0; bj < 2; ++bj)
#pragma unroll
                    for (int n = 0; n < 2; ++n) { const f32x4 bs = ai == 0 ? pre[m][bj][n] : *(const f32x4*)(base + off + bj * HALF + n * 16); f32x4 o = bs + (acc[ai][bj][m][n] - sr.x) * sr.y;
                        if (bad) o = (f32x4){qnan, qnan, qnan, qnan}; *(f32x4*)(out + off + bj * HALF + n * 16) = o; }
                if (m & 1) asm volatile("" ::: "memory"); }
    }
};
struct EpiLnResLn {
    static constexpr bool PERM = false, AFTER_DRAIN = true;
    const float* base; float* out; bf16_t* xn; int ldc; const float* bias; PanelStats st1, st2; unsigned poison;
    __device__ __forceinline__ void fused(f32x4 (&acc)[2][2][4][2], const Unit& u, int wr, int wc, int fr, int fq, PG8_LAS unsigned char* lds, int wid, int lane) const {
        typedef float f32x2v __attribute__((ext_vector_type(2))); typedef unsigned u32x2v __attribute__((ext_vector_type(2)));
        const PG8_LAS f32x2v* S = (const PG8_LAS f32x2v*)(lds + 8192);
        const int col0 = u.pn * BM + wc * 32 + 4 * fq;
#pragma unroll
        for (int bj = 0; bj < 2; ++bj)
#pragma unroll
            for (int n = 0; n < 2; ++n) { const f32x4 bv = bias ? *(const f32x4*)(bias + col0 + bj * HALF + n * 16) : (f32x4){0.f, 0.f, 0.f, 0.f};
#pragma unroll
                for (int ai = 0; ai < 2; ++ai)
#pragma unroll
                    for (int m = 0; m < 4; ++m) acc[ai][bj][m][n] += bv; }
        bool bad = st1.run(acc, u, wr, wc, fr, fq, lds, wid, lane) || poison != 0u;
        const float qnan = __builtin_nanf("");
#pragma unroll
        for (int ai = 0; ai < 2; ++ai)
#pragma unroll
            for (int m = 0; m < 4; ++m) { const int r = ai * HALF + wr * 64 + m * 16 + fr; const f32x2v sr = S[r]; const size_t off = (size_t)(u.pm * BM + r) * ldc + col0;
#pragma unroll
                for (int bj = 0; bj < 2; ++bj)
#pragma unroll
                    for (int n = 0; n < 2; ++n) { const f32x4 bs = *(const f32x4*)(base + off + bj * HALF + n * 16); acc[ai][bj][m][n] = bs + (acc[ai][bj][m][n] - sr.x) * sr.y; }
                asm volatile("" : "+v"(acc[ai][0][m][0]), "+v"(acc[ai][0][m][1]), "+v"(acc[ai][1][m][0]), "+v"(acc[ai][1][m][1]));
                if (m & 1) asm volatile("" ::: "memory"); }
        const bool bad1 = bad;
        bad = st2.run(acc, u, wr, wc, fr, fq, lds, wid, lane) || bad;
#pragma unroll
        for (int ai = 0; ai < 2; ++ai)
#pragma unroll
            for (int m = 0; m < 4; ++m) { const int r = ai * HALF + wr * 64 + m * 16 + fr; const f32x2v sr = S[r]; const size_t off = (size_t)(u.pm * BM + r) * ldc + col0;
#pragma unroll
                for (int bj = 0; bj < 2; ++bj)
#pragma unroll
                    for (int n = 0; n < 2; ++n) { const f32x4 x1 = acc[ai][bj][m][n]; *(f32x4*)(out + off + bj * HALF + n * 16) = bad1 ? (f32x4){qnan, qnan, qnan, qnan} : x1;
                        const f32x4 o = (x1 - sr.x) * sr.y; u32x2v w; w.x = cvt_pk_bf16(o[0], o[1]); w.y = cvt_pk_bf16(o[2], o[3]);
                        if (bad) { w.x = 0x7fc07fc0u; w.y = 0x7fc07fc0u; } *(u32x2v*)(xn + off + bj * HALF + n * 16) = w; }
                asm volatile("" ::: "memory"); }
    }
};

template <class Epi, class Sched, bool ALIGN_EPI = false, bool SP2 = false>
__device__ __forceinline__ void gemm_phase(PG8_LAS unsigned char* lds, const Gemm g, const Sched& S, const Epi& E) {
    int tid_ = threadIdx.x; asm volatile("" : "+v"(tid_));
    const int tid = tid_, wid = __builtin_amdgcn_readfirstlane(tid >> 6), lane = tid & 63, wr = wid >> 2, wc = wid & 3, fr = lane & 15, fq = lane >> 4;
    int K_ = g.K; asm volatile("" : "+s"(K_)); const int K = K_, nt = K / BK;
    unsigned voffA[2], voffB[2];
#pragma unroll
    for (int i = 0; i < 2; ++i) { int R, C; stage_rc(tid * 16 + i * 8192, R, C); const int Rb = Epi::PERM ? ((R & ~31) + perm32(R & 31)) : R;
        voffA[i] = (unsigned)(R * K + C) * 2u; voffB[i] = (unsigned)(Rb * K + C) * 2u; }
    const size_t kstep = (size_t)(BK * 2);
    const size_t hstep = (size_t)HALF * K * 2;
    const size_t tstep = 2 * hstep;
    const unsigned ldsw = (unsigned)wid * 1024u;
    const int aoff = lds_byte(wr * 64 + fr, fq * 8), boff = lds_byte(wc * 32 + fr, fq * 8);
#define PG8_SA(b, h) (((b) * 2 + (h)) * HTB)
#define PG8_SB(b, h) ((4 + (b) * 2 + (h)) * HTB)
#define PG8_STAGE(bufoff, gbase, voff) do { _Pragma("unroll") for (int _i = 0; _i < 2; ++_i) \
        __builtin_amdgcn_global_load_lds((const unsigned*)((const char*)(gbase) + (voff)[_i]), (PG8_LAS unsigned*)(lds + (bufoff) + ldsw + _i * 8192), 16, 0, 0); } while (0)
#define PG8_LDA(dst, b, h) do { _Pragma("unroll") for (int m = 0; m < 4; ++m) _Pragma("unroll") for (int k = 0; k < 2; ++k) dst[m][k] = *(const PG8_LAS bf16x8*)(lds + PG8_SA(b, h) + aoff + m * 2048 + k * 1024); } while (0)
#define PG8_LDB(dst, b, h) do { _Pragma("unroll") for (int n = 0; n < 2; ++n) _Pragma("unroll") for (int k = 0; k < 2; ++k) dst[n][k] = *(const PG8_LAS bf16x8*)(lds + PG8_SB(b, h) + boff + n * 2048 + k * 1024); } while (0)
#define PG8_MMA(ai, bj, At, Bt) do { __builtin_amdgcn_s_setprio(1); _Pragma("unroll") for (int m = 0; m < 4; ++m) _Pragma("unroll") for (int n = 0; n < 2; ++n) _Pragma("unroll") for (int k = 0; k < 2; ++k) \
        acc[ai][bj][m][n] = __builtin_amdgcn_mfma_f32_16x16x32_bf16(Bt[n][k], At[m][k], acc[ai][bj][m][n], 0, 0, 0); __builtin_amdgcn_s_setprio(0); } while (0)
#define PG8_WAIT_V(n) asm volatile("s_waitcnt vmcnt(" #n ")" ::: "memory")
#define PG8_WAIT_L(n) asm volatile("s_waitcnt lgkmcnt(" #n ")" ::: "memory")
#define PG8_BAR __builtin_amdgcn_s_barrier()
#define PG8_SCHED __builtin_amdgcn_sched_barrier(0)
    Unit cur, nxt; int ui = 0;
    if (!S.next(0, cur)) return;
    f32x4 acc[2][2][4][2];
#pragma unroll
    for (int a = 0; a < 2; ++a)
#pragma unroll
        for (int b = 0; b < 2; ++b)
#pragma unroll
            for (int m = 0; m < 4; ++m)
#pragma unroll
                for (int n = 0; n < 2; ++n) acc[a][b][m][n] = (f32x4){0.f, 0.f, 0.f, 0.f};
    bf16x8 At[4][2], B0[2][2], B1[2][2];
    const char* cA = (const char*)g.A + (size_t)cur.pm * tstep; const char* cB = (const char*)g.Bt + (size_t)cur.pn * tstep;
    S.a_ready(cur);
    if constexpr (SP2) {
        PG8_STAGE(PG8_SB(0, 0), cB, voffB); PG8_STAGE(PG8_SB(0, 1), cB + hstep, voffB); PG8_STAGE(PG8_SA(0, 0), cA, voffA); PG8_STAGE(PG8_SA(0, 1), cA + hstep, voffA);
        if (wr == 1) PG8_BAR;
        PG8_WAIT_V(2); PG8_BAR;
        PG8_STAGE(PG8_SB(1, 0), cB + kstep, voffB); PG8_STAGE(PG8_SA(1, 0), cA + kstep, voffA); PG8_STAGE(PG8_SB(1, 1), cB + hstep + kstep, voffB);
        PG8_WAIT_V(6); PG8_BAR;
    } else {
        PG8_STAGE(PG8_SB(0, 0), cB, voffB); PG8_STAGE(PG8_SA(0, 0), cA, voffA); PG8_STAGE(PG8_SB(0, 1), cB + hstep, voffB); PG8_STAGE(PG8_SA(0, 1), cA + hstep, voffA);
        if (wr == 1) PG8_BAR;
        PG8_WAIT_V(4); PG8_BAR;
        PG8_STAGE(PG8_SB(1, 0), cB + kstep, voffB); PG8_STAGE(PG8_SA(1, 0), cA + kstep, voffA); PG8_STAGE(PG8_SB(1, 1), cB + hstep + kstep, voffB);
        PG8_WAIT_V(6); PG8_BAR;
    }
    for (;;) {
        const bool has_next = S.next(ui + 1, nxt);
        const char* nA = has_next ? (const char*)g.A + (size_t)nxt.pm * tstep : cA; const char* nB = has_next ? (const char*)g.Bt + (size_t)nxt.pn * tstep : cB;
        for (int t = 0; t < nt; t += 2) {
            const bool last = (t == nt - 2);
            const char* a1 = cA + (size_t)(t + 1) * kstep;
            const char* a2 = last ? nA : cA + (size_t)(t + 2) * kstep; const char* b2 = last ? nB : cB + (size_t)(t + 2) * kstep;
            const char* a3 = a2 + kstep; const char* b3 = b2 + kstep;
            if (last && has_next) S.a_ready(nxt);
            if constexpr (SP2) {
            PG8_LDB(B0, 0, 0); PG8_LDB(B1, 0, 1); PG8_SCHED; PG8_LDA(At, 0, 0); PG8_STAGE(PG8_SA(1, 1), a1 + hstep, voffA);
            PG8_WAIT_V(8); PG8_WAIT_L(0); PG8_BAR; PG8_MMA(0, 0, At, B0); PG8_MMA(0, 1, At, B1); PG8_BAR; PG8_SCHED;
            PG8_LDA(At, 0, 1); PG8_STAGE(PG8_SB(0, 0), b2, voffB); PG8_STAGE(PG8_SB(0, 1), b2 + hstep, voffB); PG8_STAGE(PG8_SA(0, 0), a2, voffA);
            PG8_WAIT_V(8); PG8_WAIT_L(0); PG8_BAR; PG8_MMA(1, 0, At, B0); PG8_MMA(1, 1, At, B1); PG8_BAR; PG8_SCHED;
            PG8_LDB(B0, 1, 0); PG8_LDB(B1, 1, 1); PG8_SCHED; PG8_LDA(At, 1, 0); PG8_STAGE(PG8_SA(0, 1), a2 + hstep, voffA);
            PG8_WAIT_V(8); PG8_WAIT_L(0); PG8_BAR; PG8_MMA(0, 0, At, B0); PG8_MMA(0, 1, At, B1); PG8_BAR; PG8_SCHED;
            PG8_LDA(At, 1, 1); PG8_STAGE(PG8_SB(1, 0), b3, voffB); PG8_STAGE(PG8_SB(1, 1), b3 + hstep, voffB); PG8_STAGE(PG8_SA(1, 0), a3, voffA);
            PG8_WAIT_V(8); PG8_WAIT_L(0); PG8_BAR; PG8_MMA(1, 0, At, B0); PG8_MMA(1, 1, At, B1); PG8_BAR; PG8_SCHED;
            } else {
            PG8_LDB(B0, 0, 0); PG8_SCHED; PG8_LDA(At, 0, 0); PG8_STAGE(PG8_SA(1, 1), a1 + hstep, voffA);
            PG8_WAIT_L(8); PG8_BAR; PG8_WAIT_L(0); PG8_MMA(0, 0, At, B0); PG8_BAR; PG8_SCHED;
            PG8_LDB(B1, 0, 1); PG8_STAGE(PG8_SB(0, 0), b2, voffB);
            PG8_BAR; PG8_WAIT_L(0); PG8_MMA(0, 1, At, B1); PG8_BAR;
            PG8_LDA(At, 0, 1); PG8_STAGE(PG8_SA(0, 0), a2, voffA);
            PG8_BAR; PG8_WAIT_L(0); PG8_MMA(1, 0, At, B0); PG8_BAR; PG8_SCHED;
            PG8_STAGE(PG8_SB(0, 1), b2 + hstep, voffB);
            PG8_WAIT_V(6); PG8_BAR; PG8_MMA(1, 1, At, B1); PG8_BAR;
            PG8_LDB(B0, 1, 0); PG8_SCHED; PG8_LDA(At, 1, 0); PG8_STAGE(PG8_SA(0, 1), a2 + hstep, voffA);
            PG8_WAIT_L(8); PG8_BAR; PG8_WAIT_L(0); PG8_MMA(0, 0, At, B0); PG8_BAR; PG8_SCHED;
            PG8_LDB(B1, 1, 1); PG8_STAGE(PG8_SB(1, 0), b3, voffB);
            PG8_BAR; PG8_WAIT_L(0); PG8_MMA(0, 1, At, B1); PG8_BAR;
            PG8_LDA(At, 1, 1); PG8_STAGE(PG8_SA(1, 0), a3, voffA);
            PG8_BAR; PG8_WAIT_L(0); PG8_MMA(1, 0, At, B0); PG8_BAR; PG8_SCHED;
            PG8_STAGE(PG8_SB(1, 1), b3 + hstep, voffB);
            PG8_WAIT_V(6); PG8_BAR; PG8_MMA(1, 1, At, B1); PG8_BAR;
            }
        }
        if constexpr (ALIGN_EPI) { if (wr == 0) PG8_BAR; }
        if constexpr (!Epi::AFTER_DRAIN) { E(acc, cur, wr, wc, fr, fq); S.done(cur); }
        if (!has_next) break;
#pragma unroll
        for (int a = 0; a < 2; ++a)
#pragma unroll
            for (int b = 0; b < 2; ++b)
#pragma unroll
                for (int m = 0; m < 4; ++m)
#pragma unroll
                    for (int n = 0; n < 2; ++n) acc[a][b][m][n] = (f32x4){0.f, 0.f, 0.f, 0.f};
        cur = nxt; cA = nA; cB = nB; ++ui;
        if constexpr (ALIGN_EPI) { if (wr == 1) PG8_BAR; }
    }
    PG8_WAIT_V(0);
    if constexpr (!ALIGN_EPI) { if (wr == 0) PG8_BAR; }
    PG8_BAR;
    if constexpr (Epi::AFTER_DRAIN) { E.fused(acc, cur, wr, wc, fr, fq, lds, wid, lane); S.done(cur); }
#undef PG8_SA
#undef PG8_SB
#undef PG8_STAGE
#undef PG8_LDA
#undef PG8_LDB
#undef PG8_MMA
#undef PG8_WAIT_V
#undef PG8_WAIT_L
#undef PG8_BAR
#undef PG8_SCHED
}
}

#ifndef PG8_SP2
#define PG8_SP2 true
#endif
#ifndef PG8_ALIGN
#define PG8_ALIGN true
#endif

namespace mk {
using pg8::bf16_t; using pg8::f32x4; using pg8::u32x4; using pg8::Unit; using pg8::BM; using pg8::HALF; using pg8::bf16x8;
#define LAS __attribute__((address_space(3)))
typedef unsigned u32x2 __attribute__((ext_vector_type(2)));
typedef float f32x2 __attribute__((ext_vector_type(2)));
typedef float f32x16 __attribute__((ext_vector_type(16)));

constexpr int M = 32768, D = 1024, FF = 2816, NGU = 5632, DIN = 1952, DINP = 2048, SEQ = 4096;
constexpr float EPS = 1e-6f;
constexpr float LOG2E = 1.4426950408889634f;
constexpr float QSCALE = 0.10206207261596577f * 1.4426950408889634f;

constexpr size_t MiB = 1u << 20;
constexpr size_t WS_CS = 0;
constexpr size_t WS_BAR = 65536;
constexpr size_t WS_WGU1 = 1 * MiB, WS_WD1 = 12 * MiB, WS_WIN = 18 * MiB, WS_WUQ = 22 * MiB, WS_WUKV = 22 * MiB + 512 * 1024,
                 WS_WOUT = 23 * MiB, WS_WGU2 = 25 * MiB, WS_WD2 = 36 * MiB;
constexpr size_t WS_XN = 49 * MiB;
constexpr size_t WS_F = 113 * MiB;
constexpr size_t WS_H = 177 * MiB;
constexpr size_t WS_QM = 305 * MiB;
constexpr size_t WS_KM = 353 * MiB;
constexpr size_t WS_VM = 401 * MiB;
constexpr size_t WS_CQN = 433 * MiB;
constexpr size_t WS_CKVN = 449 * MiB;
constexpr size_t WS_END = 457 * MiB;

constexpr int LDS_BYTES = 147456;

__device__ __forceinline__ float bf_lo(unsigned w) { return __uint_as_float(w << 16); }
__device__ __forceinline__ float bf_hi(unsigned w) { return __uint_as_float(w & 0xffff0000u); }
__device__ __forceinline__ unsigned pk(float lo, float hi) { return pg8::cvt_pk_bf16(lo, hi); }
__device__ __forceinline__ float wave_sum(float v) {
#pragma unroll
    for (int o = 1; o < 64; o <<= 1) v += __shfl_xor(v, o);
    return v;
}
__device__ __forceinline__ float dot4(f32x4 a) { return (a[0] * a[0] + a[1] * a[1]) + (a[2] * a[2] + a[3] * a[3]); }

struct EpiSwiGLU {
    static constexpr bool PERM = true, AFTER_DRAIN = false;
    bf16_t* O; int ldc;
    __device__ __forceinline__ void operator()(const f32x4 (&acc)[2][2][4][2], const Unit& u, int wr, int wc, int fr, int fq) const {
        const int row0 = u.pm * BM + wr * 64 + fr; const int col0 = u.pn * 128 + wc * 32 + 8 * fq;
#pragma unroll
        for (int ai = 0; ai < 2; ++ai)
#pragma unroll
            for (int m = 0; m < 4; ++m) {
                bf16_t* rowp = O + (size_t)(row0 + ai * HALF + m * 16) * ldc + col0;
                float r[8];
#pragma unroll
                for (int n = 0; n < 2; ++n)
#pragma unroll
                    for (int j = 0; j < 4; ++j) { const float g = acc[ai][0][m][n][j], up = acc[ai][1][m][n][j];
                        const float e = __builtin_amdgcn_exp2f(-g * LOG2E); r[4 * n + j] = g * __builtin_amdgcn_rcpf(1.0f + e) * up; }
                u32x4 w; w.x = pk(r[0], r[1]); w.y = pk(r[2], r[3]); w.z = pk(r[4], r[5]); w.w = pk(r[6], r[7]);
                *(u32x4*)rowp = w;
            }
    }
};
struct EpiKV {
    static constexpr bool PERM = true, AFTER_DRAIN = false;
    bf16_t* Km; bf16_t* Vm;
    __device__ __forceinline__ void operator()(const f32x4 (&acc)[2][2][4][2], const Unit& u, int wr, int wc, int fr, int fq) const {
        const int row0 = u.pm * BM + wr * 64 + fr;
#pragma unroll
        for (int bj = 0; bj < 2; ++bj) {
            const int colt = u.pn * BM + bj * HALF + wc * 32 + 8 * fq;
            bf16_t* base; int ld;
            if (colt < 512) { base = Km + 96 * (colt >> 6) + (colt & 63); ld = 768; } else { base = Vm + (colt - 512); ld = 512; }
#pragma unroll
            for (int ai = 0; ai < 2; ++ai)
#pragma unroll
                for (int m = 0; m < 4; ++m) { const f32x4 v0 = acc[ai][bj][m][0], v1 = acc[ai][bj][m][1];
                    u32x4 w; w.x = pk(v0[0], v0[1]); w.y = pk(v0[2], v0[3]); w.z = pk(v1[0], v1[1]); w.w = pk(v1[2], v1[3]);
                    *(u32x4*)(base + (size_t)(row0 + ai * HALF + m * 16) * ld) = w; }
        }
    }
};
struct EpiQ {
    static constexpr bool PERM = false, AFTER_DRAIN = false;
    bf16_t* O; const f32x2* cs;
    __device__ __forceinline__ void operator()(const f32x4 (&acc)[2][2][4][2], const Unit& u, int wr, int wc, int fr, int fq) const {
        const int row0 = u.pm * BM + wr * 64 + fr;
#pragma unroll
        for (int bj = 0; bj < 2; ++bj) {
            const int g32 = u.pn * 8 + bj * 4 + wc; const bool rot = (g32 % 3) == 2; const int cbase = g32 * 32 + 4 * fq;
#pragma unroll
            for (int ai = 0; ai < 2; ++ai)
#pragma unroll
                for (int m = 0; m < 4; ++m) {
                    const int row = row0 + ai * HALF + m * 16;
                    f32x4 x0 = acc[ai][bj][m][0], x1 = acc[ai][bj][m][1];
                    if (rot) { const int t = row & (SEQ - 1); const int pos = (fq < 2) ? (t >> 6) : (t & 63); const f32x2* cp = cs + pos * 8 + 4 * (fq & 1);
                        f32x4 y0, y1;
#pragma unroll
                        for (int j = 0; j < 4; ++j) { const f32x2 c = cp[j]; y0[j] = x0[j] * c.x - x1[j] * c.y; y1[j] = x1[j] * c.x + x0[j] * c.y; }
                        x0 = y0; x1 = y1; }
                    x0 = x0 * QSCALE; x1 = x1 * QSCALE;
                    bf16_t* p = O + (size_t)row * 768 + cbase;
                    u32x2 w0; w0.x = pk(x0[0], x0[1]); w0.y = pk(x0[2], x0[3]); u32x2 w1; w1.x = pk(x1[0], x1[1]); w1.y = pk(x1[2], x1[3]);
                    *(u32x2*)p = w0; *(u32x2*)(p + 16) = w1;
                    asm volatile("" ::: "memory");
                }
        }
    }
};

__device__ __forceinline__ void row_norm_to_bf16(const float* xrow, const float* g, bf16_t* orow, int lane) {
    const f32x4* xr = (const f32x4*)xrow + lane; const f32x4* gr = (const f32x4*)g + lane;
    f32x4 v[4]; float s = 0.f;
#pragma unroll
    for (int j = 0; j < 4; ++j) { v[j] = xr[64 * j]; s += dot4(v[j]); }
    const float rstd = 1.0f / sqrtf(wave_sum(s) * (1.0f / D) + EPS);
#pragma unroll
    for (int j = 0; j < 4; ++j) { const f32x4 o = v[j] * rstd * gr[64 * j]; u32x2 w; w.x = pk(o[0], o[1]); w.y = pk(o[2], o[3]); ((u32x2*)orow)[lane + 64 * j] = w; }
}
template <bool WRITE_XN>
__device__ __forceinline__ void row_mid(const bf16_t* frow, const float* resrow, float* outrow, const float* gpost, float coef, const float* gpre, bf16_t* xnrow, int lane) {
    f32x4 f[4]; float s = 0.f;
#pragma unroll
    for (int j = 0; j < 4; ++j) { const u32x2 w = ((const u32x2*)frow)[lane + 64 * j]; f[j] = (f32x4){bf_lo(w.x), bf_hi(w.x), bf_lo(w.y), bf_hi(w.y)}; s += dot4(f[j]); }
    const float rstd = 1.0f / sqrtf(wave_sum(s) * (1.0f / D) + EPS) * coef;
    float s2 = 0.f;
#pragma unroll
    for (int j = 0; j < 4; ++j) { const f32x4 gp = ((const f32x4*)gpost)[lane + 64 * j]; const f32x4 r = ((const f32x4*)resrow)[lane + 64 * j];
        f[j] = r + f[j] * rstd * gp; ((f32x4*)outrow)[lane + 64 * j] = f[j]; s2 += dot4(f[j]); }
    if (WRITE_XN) {
        const float rstd2 = 1.0f / sqrtf(wave_sum(s2) * (1.0f / D) + EPS);
#pragma unroll
        for (int j = 0; j < 4; ++j) { const f32x4 o = f[j] * rstd2 * ((const f32x4*)gpre)[lane + 64 * j]; u32x2 w; w.x = pk(o[0], o[1]); w.y = pk(o[2], o[3]); ((u32x2*)xnrow)[lane + 64 * j] = w; }
    }
}
__device__ __forceinline__ void row_onorm(bf16_t* orow, const float* gna, const float* gmla, int lane) {
    f32x4 f[4]; float sa = 0.f, sb = 0.f;
#pragma unroll
    for (int j = 0; j < 4; ++j) { const u32x2 w = ((const u32x2*)orow)[lane + 64 * j]; f[j] = (f32x4){bf_lo(w.x), bf_hi(w.x), bf_lo(w.y), bf_hi(w.y)}; if (j < 2) sa += dot4(f[j]); else sb += dot4(f[j]); }
    const float ra = 1.0f / sqrtf(wave_sum(sa) * (1.0f / 512.0f) + EPS), rb = 1.0f / sqrtf(wave_sum(sb) * (1.0f / 512.0f) + EPS);
#pragma unroll
    for (int j = 0; j < 4; ++j) { const f32x4 g = (j < 2) ? ((const f32x4*)gna)[lane + 64 * j] : ((const f32x4*)gmla)[lane + 64 * (j - 2)];
        const f32x4 o = f[j] * ((j < 2) ? ra : rb) * g; u32x2 w; w.x = pk(o[0], o[1]); w.y = pk(o[2], o[3]); ((u32x2*)orow)[lane + 64 * j] = w; }
}
__device__ __forceinline__ void mla_prep_row(const bf16_t* zrow, int row, const float* gq, const float* gkv, const f32x2* cs, bf16_t* cqn, bf16_t* ckvn, bf16_t* km, int lane) {
    const u32x2 wq = ((const u32x2*)(zrow + 1536))[lane];
    const float q0 = bf_lo(wq.x), q1 = bf_hi(wq.x), q2 = bf_lo(wq.y), q3 = bf_hi(wq.y);
    const float rq = 1.0f / sqrtf(wave_sum((q0 * q0 + q1 * q1) + (q2 * q2 + q3 * q3)) * (1.0f / 256.0f) + EPS);
    const unsigned wk = ((const unsigned*)(zrow + 1792))[lane];
    const float k0 = bf_lo(wk), k1 = bf_hi(wk);
    const float rk = 1.0f / sqrtf(wave_sum(k0 * k0 + k1 * k1) * (1.0f / 128.0f) + EPS);
    const f32x4 g = ((const f32x4*)gq)[lane];
    u32x2 o; o.x = pk(q0 * rq * g[0], q1 * rq * g[1]); o.y = pk(q2 * rq * g[2], q3 * rq * g[3]);
    ((u32x2*)(cqn + (size_t)row * 256))[lane] = o;
    const f32x2 g2 = ((const f32x2*)gkv)[lane];
    ((unsigned*)(ckvn + (size_t)row * 128))[lane] = pk(k0 * rk * g2.x, k1 * rk * g2.y);
    if (lane < 16) {
        const int i = lane; const float x1 = bf_lo((unsigned)zrow[1920 + i]), x2 = bf_lo((unsigned)zrow[1936 + i]);
        const int t = row & (SEQ - 1); const int pos = (i < 8) ? (t >> 6) : (t & 63); const f32x2 c = cs[pos * 8 + (i & 7)];
        const unsigned y = pk(x1 * c.x - x2 * c.y, x2 * c.x + x1 * c.y);
        bf16_t* kp = km + (size_t)row * 768 + 64 + i;
#pragma unroll
        for (int h = 0; h < 8; ++h) { kp[96 * h] = (bf16_t)(y & 0xffffu); kp[96 * h + 16] = (bf16_t)(y >> 16); }
    }
}

__device__ __forceinline__ void transpose_item(const float* W, int K, int N, bf16_t* WT, int k0, int n0, int n0_out, LAS float* scr, int lane) {
#pragma unroll 8
    for (int i = 0; i < 32; ++i) { const int kk = 2 * i + (lane >> 5); scr[kk * 33 + (lane & 31)] = W[(size_t)(k0 + kk) * N + n0 + (lane & 31)]; }
    asm volatile("s_waitcnt lgkmcnt(0)" ::: "memory");
    const int c = lane & 7;
#pragma unroll
    for (int j = 0; j < 4; ++j) { const int n = (lane >> 3) + 8 * j; const LAS float* s = scr + (8 * c) * 33 + n;
        u32x4 o; o.x = pk(s[0 * 33], s[1 * 33]); o.y = pk(s[2 * 33], s[3 * 33]); o.z = pk(s[4 * 33], s[5 * 33]); o.w = pk(s[6 * 33], s[7 * 33]);
        *(u32x4*)(WT + (size_t)(n0_out + n) * K + k0 + 8 * c) = o; }
    asm volatile("s_waitcnt lgkmcnt(0)" ::: "memory");
}
__device__ __forceinline__ int remap_gu(int n0) { if (n0 < FF) return 256 * (n0 >> 7) + (n0 & 127); const int m = n0 - FF; return 256 * (m >> 7) + 128 + (m & 127); }
__device__ __forceinline__ int remap_kv(int n0) { const int h = n0 >> 7, j = n0 & 127; return (j < 64) ? (64 * h + j) : (512 + 64 * h + (j - 64)); }
#define XB_TMO      128
#define XB_XCNT(j)  (256  + 64 * (j))
#define XB_XSUB(j)  (1280 + 64 * (j))
#define XB_XGEN(j)  (2304 + 64 * (j))
#define XB_TOP      3328
#define XB_TOPGEN   3392
#define XCD_BAR_WORDS 3456
#define XB_SPIN_CAP (1u << 18)

__device__ __forceinline__ unsigned xb_ld(unsigned* p)              { return __hip_atomic_load(p, __ATOMIC_RELAXED, __HIP_MEMORY_SCOPE_AGENT); }
__device__ __forceinline__ unsigned xb_add(unsigned* p, unsigned v) { return __hip_atomic_fetch_add(p, v, __ATOMIC_RELAXED, __HIP_MEMORY_SCOPE_AGENT); }
__device__ __forceinline__ unsigned xb_xcc_id() { return (unsigned)__builtin_amdgcn_s_getreg((3 << 11) | 20) & 0xFu; }
#define XB_SPIN(cond, bar) do { unsigned _sp = 0; while (cond) { __builtin_amdgcn_s_sleep(1); \
    if ((++_sp & 255u) == 0u) { if (xb_ld(&(bar)[XB_TMO])) break; if (_sp > XB_SPIN_CAP) { atomicAdd(&(bar)[XB_TMO], 1u); break; } } } } while (0)

struct XcdBarrier {
    unsigned* bar; unsigned x;
    volatile LAS unsigned* st;
};

__device__ __forceinline__ XcdBarrier xcd_barrier_post(unsigned* bar, volatile LAS unsigned* st) {
    XcdBarrier b; b.bar = bar; b.x = xb_xcc_id(); b.st = st;
    if (threadIdx.x == 0) (void)xb_add(&bar[XB_XCNT(b.x)], 1u);
    return b;
}
__device__ __forceinline__ void xcd_barrier_complete(unsigned* bar, unsigned x, unsigned& nloc, unsigned& nx) {
    const unsigned G = gridDim.x * gridDim.y * gridDim.z;
    unsigned sum, cnt, mine, sp = 0u;
    for (;;) {
        sum = 0u; cnt = 0u; mine = 0u;
#pragma unroll
        for (unsigned j = 0; j < 16; ++j) { const unsigned c = xb_ld(&bar[XB_XCNT(j)]); sum += c; cnt += (c > 0u) ? 1u : 0u; mine = (j == x) ? c : mine; }
        if (sum == G) break;
        __builtin_amdgcn_s_sleep(1);
        if ((++sp & 255u) == 0u) { if (xb_ld(&bar[XB_TMO])) break; if (sp > XB_SPIN_CAP) { atomicAdd(&bar[XB_TMO], 1u); break; } }
    }
    nloc = mine > 0u ? mine : 1u; nx = cnt > 0u ? cnt : 1u;
}

__device__ __forceinline__ void xcd_barrier(const XcdBarrier& b) {
    asm volatile("s_waitcnt vmcnt(0)" ::: "memory");
    __syncthreads();
    if (threadIdx.x == 0) {
        unsigned* bar = b.bar;
        __builtin_amdgcn_s_waitcnt(0);
        unsigned nloc = b.st[0], nx = b.st[1];
        if (nloc == 0u) { xcd_barrier_complete(bar, b.x, nloc, nx); b.st[0] = nloc; b.st[1] = nx; }
        const unsigned old = xb_add(&bar[XB_XSUB(b.x)], 1u);
        const unsigned gen = old / nloc;
        if (old + 1u == (gen + 1u) * nloc) {
            __builtin_amdgcn_fence(__ATOMIC_RELEASE, "agent");
            asm volatile("s_waitcnt vmcnt(0)" ::: "memory");
            const unsigned og = xb_add(&bar[XB_TOP], 1u);
            const unsigned tg = og / nx;
            if (og + 1u == (tg + 1u) * nx) xb_add(&bar[XB_TOPGEN], 1u);
            else XB_SPIN(xb_ld(&bar[XB_TOPGEN]) == tg, bar);
            __builtin_amdgcn_fence(__ATOMIC_ACQUIRE, "agent");
            xb_add(&bar[XB_XGEN(b.x)], 1u);
            asm volatile("s_waitcnt vmcnt(0)" ::: "memory");
        } else {
            XB_SPIN(xb_ld(&bar[XB_XGEN(b.x)]) == gen, bar);
            __builtin_amdgcn_fence(__ATOMIC_ACQUIRE, "agent");
            asm volatile("s_waitcnt vmcnt(0)" ::: "memory");
        }
    }
    __syncthreads();
}

typedef unsigned short u16_t;
__device__ __forceinline__ int iclamp(int v, int lo, int hi) { return min(max(v, lo), hi); }
template <bool NA>
__device__ __forceinline__ void attn_unit(LAS unsigned char* lds, const bf16_t* Qsrc, const bf16_t* Ksrc, const bf16_t* Vsrc, const float* rpb, bf16_t* O, int b, int h, int ub) {
    constexpr int DK = NA ? 64 : 96, ND0 = DK / 16, KP = NA ? 144 : 208, VP = 144;
    constexpr int QPITCH = NA ? 2048 : 768, KPITCH = NA ? 2048 : 768, VPITCH = NA ? 2048 : 512;
    constexpr int KB_BYTES = 13312, ABUF = 22528, BIAS_OFF = 2 * ABUF;
    constexpr float THR = 8.0f;
    int tid = threadIdx.x; asm volatile("" : "+v"(tid));
    const int lane = tid & 63, wave = __builtin_amdgcn_readfirstlane(tid >> 6), r32 = lane & 31, hi = lane >> 5;
    const size_t tok0 = (size_t)b * SEQ;
    int qgr = 0, qc = 0, rs_w = 0, t_lo = 0, t_hi = 64; size_t qtok;
    if (NA) { const int r0 = ub * 4; qgr = r0 + (wave >> 1); qc = 32 * (wave & 1) + r32; qtok = tok0 + qgr * 64 + qc;
        rs_w = iclamp(qgr - 4, 0, 56); t_lo = iclamp(r0 - 4, 0, 56); t_hi = iclamp(r0 - 1, 0, 56) + 8; }
    else { qtok = tok0 + ub * 256 + wave * 32 + r32; }
    bf16x8 qr[ND0];
    { const bf16_t* qp = Qsrc + qtok * QPITCH + (NA ? 64 * h : 96 * h) + 8 * hi;
#pragma unroll
      for (int d0 = 0; d0 < ND0; ++d0) qr[d0] = *(const bf16x8*)(qp + 16 * d0); }
    const bf16_t* kg0; const bf16_t* kg1 = nullptr; int lk0, lk1 = 0;
    if (NA) { const int key = tid >> 3, ch = tid & 7; kg0 = Ksrc + (tok0 + key) * KPITCH + 512 + 64 * h + 8 * ch; lk0 = key * KP + 16 * ch; }
    else { const int key0 = tid / 12, ch0 = tid % 12; kg0 = Ksrc + (tok0 + key0) * KPITCH + 96 * h + 8 * ch0; lk0 = key0 * KP + 16 * ch0;
        const int c1 = 512 + (tid & 255), key1 = c1 / 12, ch1 = c1 % 12; kg1 = Ksrc + (tok0 + key1) * KPITCH + 96 * h + 8 * ch1; lk1 = key1 * KP + 16 * ch1; }
    const bool two = !NA && tid < 256;
    const bf16_t* vg = Vsrc + (tok0 + lane) * VPITCH + (NA ? 1024 + 64 * h : 64 * h) + 8 * wave;
    const int pos = (lane & ~12) | ((lane & 4) << 1) | ((lane & 8) >> 1);
    const int lv = KB_BYTES + (8 * wave) * VP + pos * 2;
    const int ka = r32 * KP + 16 * hi, va = KB_BYTES + r32 * VP + 16 * hi;
    if (NA) { if (tid < 465) ((LAS float*)(lds + BIAS_OFF))[tid] = rpb[h * 465 + tid] * LOG2E; }
    u32x4 rk0, rk1 = (u32x4){0u, 0u, 0u, 0u}, rv;
#define AT_LOAD(t) do { rk0 = *(const u32x4*)(kg0 + (size_t)(t) * 64 * KPITCH); if (two) rk1 = *(const u32x4*)(kg1 + (size_t)(t) * 64 * KPITCH); rv = *(const u32x4*)(vg + (size_t)(t) * 64 * VPITCH); } while (0)
#define AT_STORE(buf) do { LAS unsigned char* B_ = lds + (buf) * ABUF; *(LAS u32x4*)(B_ + lk0) = rk0; if (two) *(LAS u32x4*)(B_ + lk1) = rk1; \
        LAS unsigned char* V_ = B_ + lv; \
        *(LAS u16_t*)(V_ + 0 * VP) = (u16_t)(rv.x & 0xffffu); *(LAS u16_t*)(V_ + 1 * VP) = (u16_t)(rv.x >> 16); *(LAS u16_t*)(V_ + 2 * VP) = (u16_t)(rv.y & 0xffffu); *(LAS u16_t*)(V_ + 3 * VP) = (u16_t)(rv.y >> 16); \
        *(LAS u16_t*)(V_ + 4 * VP) = (u16_t)(rv.z & 0xffffu); *(LAS u16_t*)(V_ + 5 * VP) = (u16_t)(rv.z >> 16); *(LAS u16_t*)(V_ + 6 * VP) = (u16_t)(rv.w & 0xffffu); *(LAS u16_t*)(V_ + 7 * VP) = (u16_t)(rv.w >> 16); } while (0)
    float mx = -1e30f, l = 0.f; f32x16 o0, o1;
#pragma unroll
    for (int r = 0; r < 16; ++r) { o0[r] = 0.f; o1[r] = 0.f; }
    AT_LOAD(t_lo); AT_STORE(0);
    __syncthreads();
#pragma unroll 1
    for (int t = t_lo; t < t_hi; ++t) {
        const int buf = (t - t_lo) & 1;
        if (t + 1 < t_hi) AT_LOAD(t + 1);
        const bool active = NA ? (t >= rs_w && t < rs_w + 8) : true;
        if (active) {
            LAS unsigned char* B = lds + buf * ABUF;
            f32x16 p0, p1;
#pragma unroll
            for (int r = 0; r < 16; ++r) { p0[r] = 0.f; p1[r] = 0.f; }
#pragma unroll
            for (int d0 = 0; d0 < ND0; ++d0) { const bf16x8 a0 = *(const LAS bf16x8*)(B + ka + 32 * d0), a1 = *(const LAS bf16x8*)(B + ka + 32 * KP + 32 * d0);
                p0 = __builtin_amdgcn_mfma_f32_32x32x16_bf16(a0, qr[d0], p0, 0, 0, 0); p1 = __builtin_amdgcn_mfma_f32_32x32x16_bf16(a1, qr[d0], p1, 0, 0, 0); }
            if (NA) {
                const int ws = iclamp(qc - 8, 0, 48); const LAS float* bt = (const LAS float*)(lds + BIAS_OFF) + (t - qgr + 7) * 31;
                constexpr float C = 0.125f * LOG2E;
#pragma unroll
                for (int r = 0; r < 16; ++r) { const int kc0 = (r & 3) + 8 * (r >> 2) + 4 * hi, kc1 = kc0 + 32;
                    const int d0_ = kc0 - qc + 15, d1_ = kc1 - qc + 15;
                    const bool v0 = (kc0 >= ws) && (kc0 < ws + 16), v1 = (kc1 >= ws) && (kc1 < ws + 16);
                    const float b0 = bt[iclamp(d0_, 0, 30)], b1 = bt[iclamp(d1_, 0, 30)];
                    p0[r] = v0 ? fmaf(p0[r], C, b0) : -1e30f; p1[r] = v1 ? fmaf(p1[r], C, b1) : -1e30f; }
            }
            float mt = fmaxf(p0[0], p1[0]);
#pragma unroll
            for (int r = 1; r < 16; ++r) mt = fmaxf(mt, fmaxf(p0[r], p1[r]));
            mt = fmaxf(mt, __shfl_xor(mt, 32));
            if (__any(mt > mx + THR)) { const float mn = fmaxf(mx, mt); const float al = __builtin_amdgcn_exp2f(mx - mn); mx = mn; l *= al;
#pragma unroll
                for (int r = 0; r < 16; ++r) { o0[r] *= al; o1[r] *= al; } }
            float ls = 0.f;
#pragma unroll
            for (int r = 0; r < 16; ++r) { p0[r] = __builtin_amdgcn_exp2f(p0[r] - mx); p1[r] = __builtin_amdgcn_exp2f(p1[r] - mx); ls += p0[r] + p1[r]; }
            l += ls;
            u32x4 pf[4];
#pragma unroll
            for (int s = 0; s < 2; ++s) {
                pf[s] = (u32x4){pk(p0[8 * s], p0[8 * s + 1]), pk(p0[8 * s + 2], p0[8 * s + 3]), pk(p0[8 * s + 4], p0[8 * s + 5]), pk(p0[8 * s + 6], p0[8 * s + 7])};
                pf[2 + s] = (u32x4){pk(p1[8 * s], p1[8 * s + 1]), pk(p1[8 * s + 2], p1[8 * s + 3]), pk(p1[8 * s + 4], p1[8 * s + 5]), pk(p1[8 * s + 6], p1[8 * s + 7])};
            }
#pragma unroll
            for (int ks = 0; ks < 4; ++ks) {
                const bf16x8 pb = __builtin_bit_cast(bf16x8, pf[ks]);
                const bf16x8 v0 = *(const LAS bf16x8*)(B + va + 32 * ks), v1 = *(const LAS bf16x8*)(B + va + 32 * VP + 32 * ks);
                o0 = __builtin_amdgcn_mfma_f32_32x32x16_bf16(v0, pb, o0, 0, 0, 0); o1 = __builtin_amdgcn_mfma_f32_32x32x16_bf16(v1, pb, o1, 0, 0, 0);
            }
        }
        if (t + 1 < t_hi) AT_STORE(buf ^ 1);
        __syncthreads();
    }
#undef AT_LOAD
#undef AT_STORE
    l += __shfl_xor(l, 32);
    const float inv = 1.0f / l;
    bf16_t* op = O + qtok * 1024 + (NA ? 64 * h : 512 + 64 * h) + 4 * hi;
#pragma unroll
    for (int g = 0; g < 4; ++g) {
        u32x2 w0; w0.x = pk(o0[4 * g] * inv, o0[4 * g + 1] * inv); w0.y = pk(o0[4 * g + 2] * inv, o0[4 * g + 3] * inv);
        u32x2 w1; w1.x = pk(o1[4 * g] * inv, o1[4 * g + 1] * inv); w1.y = pk(o1[4 * g + 2] * inv, o1[4 * g + 3] * inv);
        *(u32x2*)(op + 8 * g) = w0; *(u32x2*)(op + 32 + 8 * g) = w1;
    }
}

constexpr int NPHASE = 14;
struct Args { const float* in[20]; float* out; unsigned char* ws; int ph_lo, ph_hi; };

__global__ void __launch_bounds__(512, 2) mk_fwd(Args a) {
    extern __shared__ __attribute__((aligned(16))) unsigned char lds_raw[];
    LAS unsigned char* lds = (LAS unsigned char*)lds_raw;
    cg::grid_group grid = cg::this_grid();
    const int G = gridDim.x, bx = blockIdx.x, NGW = G * 8;
#define TIDS int tid = threadIdx.x; asm volatile("" : "+v"(tid)); const int lane = tid & 63, wave = __builtin_amdgcn_readfirstlane(tid >> 6), gw = bx * 8 + wave; (void)lane; (void)gw
#define PTRS unsigned char* ws = a.ws; asm volatile("" : "+s"(ws)); const float* x = a.in[0]; float* out = a.out; f32x2* cs = (f32x2*)(ws + WS_CS); bf16_t* Wgu1 = (bf16_t*)(ws + WS_WGU1); bf16_t* Wd1 = (bf16_t*)(ws + WS_WD1); bf16_t* Win = (bf16_t*)(ws + WS_WIN); bf16_t* Wuq = (bf16_t*)(ws + WS_WUQ); bf16_t* Wukv = (bf16_t*)(ws + WS_WUKV); bf16_t* Wout = (bf16_t*)(ws + WS_WOUT); bf16_t* Wgu2 = (bf16_t*)(ws + WS_WGU2); bf16_t* Wd2 = (bf16_t*)(ws + WS_WD2); bf16_t* XN = (bf16_t*)(ws + WS_XN); bf16_t* Fb = (bf16_t*)(ws + WS_F); bf16_t* Hb = (bf16_t*)(ws + WS_H); bf16_t* Zb = (bf16_t*)(ws + WS_H); bf16_t* Qm = (bf16_t*)(ws + WS_QM); bf16_t* Km = (bf16_t*)(ws + WS_KM); bf16_t* Vm = (bf16_t*)(ws + WS_VM); bf16_t* CQN = (bf16_t*)(ws + WS_CQN); bf16_t* CKVN = (bf16_t*)(ws + WS_CKVN); (void)x; (void)out; (void)cs; (void)Wgu1; (void)Wd1; (void)Win; (void)Wuq; (void)Wukv; (void)Wout; (void)Wgu2; (void)Wd2; (void)XN; (void)Fb; (void)Hb; (void)Zb; (void)Qm; (void)Km; (void)Vm; (void)CQN; (void)CKVN
    const int lo = a.ph_lo, hi = a.ph_hi;
#ifndef GEMM_REP
#define GEMM_REP 1
#endif
#ifndef PH_MASK
#define PH_MASK 0x3fff
#endif
#define IN(k) ((((PH_MASK) >> (k)) & 1) && lo <= (k) && (k) < hi)
    volatile LAS unsigned* bst = (volatile LAS unsigned*)(lds + 131072 + 64);
    if (threadIdx.x < 2) bst[threadIdx.x] = 0u;
    __syncthreads();
    unsigned* barw = (unsigned*)(a.ws + WS_BAR);
    XcdBarrier bar; bar.bar = barw; bar.x = 0; bar.st = bst;
#define SEAM(k) do { if (IN(k) && IN((k) + 1)) { if ((k) == 0) { grid.sync(); bar = xcd_barrier_post(barw, bst); } else xcd_barrier(bar); } } while (0)
    using SO = pg8::StaticOrder;

    if (IN(0)) { TIDS; PTRS;
        if (bx == 0) {
            const int pos = tid >> 3, f = tid & 7;
            const float inv = 1.0f / powf(10000.0f, (float)f * 0.125f);
            const float ang = (float)pos * inv;
            const float k = rintf(ang * 0.15915494309189535f);
            float r = fmaf(-k, 6.2831854820251465f, ang); r = fmaf(-k, -1.7484555e-7f, r);
            cs[tid] = (f32x2){__cosf(r), __sinf(r)};
        }
        if (bx == 0) for (int i = tid; i < XCD_BAR_WORDS; i += 512) barw[i] = 0u;
        LAS float* scr = (LAS float*)(lds + wave * 16384);
        constexpr int I_GU = 16 * 176, I_D = 44 * 32, I_IN = 16 * 61, I_UQ = 4 * 24, I_UKV = 2 * 32, I_OUT = 16 * 32;
        constexpr int NITEMS = 2 * I_GU + 2 * I_D + I_IN + I_UQ + I_UKV + I_OUT;
        for (int it = gw; it < NITEMS; it += NGW) {
            int r = it;
            if (r < I_GU) { const int kb = r / 176, nb = r % 176; transpose_item(a.in[2], D, NGU, Wgu1, 64 * kb, 32 * nb, remap_gu(32 * nb), scr, lane); continue; } r -= I_GU;
            if (r < I_GU) { const int kb = r / 176, nb = r % 176; transpose_item(a.in[17], D, NGU, Wgu2, 64 * kb, 32 * nb, remap_gu(32 * nb), scr, lane); continue; } r -= I_GU;
            if (r < I_D) { const int kb = r / 32, nb = r % 32; transpose_item(a.in[3], FF, D, Wd1, 64 * kb, 32 * nb, 32 * nb, scr, lane); continue; } r -= I_D;
            if (r < I_D) { const int kb = r / 32, nb = r % 32; transpose_item(a.in[18], FF, D, Wd2, 64 * kb, 32 * nb, 32 * nb, scr, lane); continue; } r -= I_D;
            if (r < I_IN) { const int kb = r / 61, nb = r % 61; transpose_item(a.in[6], D, DIN, Win, 64 * kb, 32 * nb, 32 * nb, scr, lane); continue; } r -= I_IN;
            if (r < I_UQ) { const int kb = r / 24, nb = r % 24; transpose_item(a.in[9], 256, 768, Wuq, 64 * kb, 32 * nb, 32 * nb, scr, lane); continue; } r -= I_UQ;
            if (r < I_UKV) { const int kb = r / 32, nb = r % 32; transpose_item(a.in[11], 128, 1024, Wukv, 64 * kb, 32 * nb, remap_kv(32 * nb), scr, lane); continue; } r -= I_UKV;
            { const int kb = r / 32, nb = r % 32; transpose_item(a.in[14], D, D, Wout, 64 * kb, 32 * nb, 32 * nb, scr, lane); }
        }
        for (int i = bx * 512 + tid; i < (DINP - DIN) * D / 8; i += G * 512) ((u32x4*)(Win + (size_t)DIN * D))[i] = (u32x4){0u, 0u, 0u, 0u};
        for (int m = gw; m < M; m += NGW) row_norm_to_bf16(x + (size_t)m * D, a.in[1], XN + (size_t)m * D, lane);
    }
    SEAM(0);
    if (IN(1)) { PTRS; pg8::Gemm g{XN, Wgu1, M, NGU, D}; SO S; S.init(M, NGU, G, bx); EpiSwiGLU E{Hb, FF};
        for (int rep_ = 0; rep_ < GEMM_REP; ++rep_) pg8::gemm_phase<EpiSwiGLU, SO, true, true>(lds, g, S, E); }
    SEAM(1);
    if (IN(2)) { PTRS; pg8::Gemm g{Hb, Wd1, M, D, FF}; SO S; S.init(M, D, G, bx); pg8::EpiBf16<0> E{Fb, D, nullptr, 0, 0, 1.f};
        for (int rep_ = 0; rep_ < GEMM_REP; ++rep_) pg8::gemm_phase<pg8::EpiBf16<0>, SO, true, true>(lds, g, S, E); }
    SEAM(2);
    if (IN(3)) { TIDS; PTRS; for (int m = gw; m < M; m += NGW) row_mid<true>(Fb + (size_t)m * D, x + (size_t)m * D, out + (size_t)m * D, a.in[4], 0.5f, a.in[5], XN + (size_t)m * D, lane); }
    SEAM(3);
    if (IN(4)) { PTRS; pg8::Gemm g{XN, Win, M, DINP, D}; SO S; S.init(M, DINP, G, bx); pg8::EpiBf16<0> E{Zb, DINP, nullptr, 0, 0, 1.f};
        for (int rep_ = 0; rep_ < GEMM_REP; ++rep_) pg8::gemm_phase<pg8::EpiBf16<0>, SO, true, true>(lds, g, S, E); }
    SEAM(4);
    if (IN(5)) { TIDS; PTRS; for (int m = gw; m < M; m += NGW) mla_prep_row(Zb + (size_t)m * DINP, m, a.in[8], a.in[10], cs, CQN, CKVN, Km, lane); }
    SEAM(5);
    if (IN(6)) { PTRS;
        { pg8::Gemm g{CQN, Wuq, M, 768, 256}; SO S; S.init(M, 768, G, bx); EpiQ E{Qm, cs}; for (int rep_ = 0; rep_ < GEMM_REP; ++rep_) pg8::gemm_phase<EpiQ, SO, true, true>(lds, g, S, E); }
        { pg8::Gemm g{CKVN, Wukv, M, 1024, 128}; SO S; S.init(M, 1024, G, bx); EpiKV E{Km, Vm}; for (int rep_ = 0; rep_ < GEMM_REP; ++rep_) pg8::gemm_phase<EpiKV, SO, true, true>(lds, g, S, E); }
    }
    SEAM(6);
    if (IN(7)) { PTRS;
#ifndef NA_NAIVE
#define NA_NAIVE 0
#endif
#ifndef MLA_NAIVE
#define MLA_NAIVE 0
#endif
#if NA_NAIVE
        for (int u = bx; u < 512; u += G) na_naive(Zb, a.in[7], XN, u);
#else
#ifndef NA_REP
#define NA_REP 1
#endif
#ifndef MLA_REP
#define MLA_REP 1
#endif
        for (int rep = 0; rep < NA_REP; ++rep) for (int u = bx; u < 1024; u += G) { const int idx = (u >> 8) * 32 + ((u >> 3) & 31), bh = (u & 7) * 8 + (idx >> 4); attn_unit<true>(lds, Zb, Zb, Zb, a.in[7], XN, bh >> 3, bh & 7, idx & 15); }
#endif
#if MLA_NAIVE
        for (int u = bx; u < 512; u += G) mla_naive(lds, Qm, Km, Vm, XN, u);
#else
        for (int rep = 0; rep < MLA_REP; ++rep) for (int u = bx; u < 1024; u += G) { const int idx = (u >> 8) * 32 + ((u >> 3) & 31), bh = (u & 7) * 8 + (idx >> 4); attn_unit<false>(lds, Qm, Km, Vm, nullptr, XN, bh >> 3, bh & 7, idx & 15); }
#endif
    }
    SEAM(7);
    if (IN(8)) { TIDS; PTRS; for (int m = gw; m < M; m += NGW) row_onorm(XN + (size_t)m * D, a.in[12], a.in[13], lane); }
    SEAM(8);
    if (IN(9)) { PTRS; pg8::Gemm g{XN, Wout, M, D, D}; SO S; S.init(M, D, G, bx); pg8::EpiBf16<0> E{Fb, D, nullptr, 0, 0, 1.f};
        for (int rep_ = 0; rep_ < GEMM_REP; ++rep_) pg8::gemm_phase<pg8::EpiBf16<0>, SO, true, true>(lds, g, S, E); }
    SEAM(9);
    if (IN(10)) { TIDS; PTRS; for (int m = gw; m < M; m += NGW) row_mid<true>(Fb + (size_t)m * D, out + (size_t)m * D, out + (size_t)m * D, a.in[15], 1.0f, a.in[16], XN + (size_t)m * D, lane); }
    SEAM(10);
    if (IN(11)) { PTRS; pg8::Gemm g{XN, Wgu2, M, NGU, D}; SO S; S.init(M, NGU, G, bx); EpiSwiGLU E{Hb, FF};
        for (int rep_ = 0; rep_ < GEMM_REP; ++rep_) pg8::gemm_phase<EpiSwiGLU, SO, true, true>(lds, g, S, E); }
    SEAM(11);
    if (IN(12)) { PTRS; pg8::Gemm g{Hb, Wd2, M, D, FF}; SO S; S.init(M, D, G, bx); pg8::EpiBf16<0> E{Fb, D, nullptr, 0, 0, 1.f};
        for (int rep_ = 0; rep_ < GEMM_REP; ++rep_) pg8::gemm_phase<pg8::EpiBf16<0>, SO, true, true>(lds, g, S, E); }
    SEAM(12);
    if (IN(13)) { TIDS; PTRS; for (int m = gw; m < M; m += NGW) row_mid<false>(Fb + (size_t)m * D, out + (size_t)m * D, out + (size_t)m * D, a.in[19], 0.5f, nullptr, nullptr, lane); }
#undef IN
#undef SEAM
}
}

#ifndef MK_MULTI
#define MK_MULTI 0
#endif
extern "C" void kernel_launch(void* const* d_in, const int* in_sizes, int n_in, void* d_out, int out_size, void* d_ws, size_t ws_size, hipStream_t stream) {
    static int grid = 0;
    if (grid == 0) {
        if (n_in != 20 || out_size != mk::M * mk::D || ws_size < mk::WS_END) { fprintf(stderr, "kernel_launch: unexpected shapes (n_in %d out %d ws %zu)\n", n_in, out_size, ws_size); grid = -1; return; }
        int dev = 0, cus = 0, per_cu = 0;
        (void)hipGetDevice(&dev); (void)hipDeviceGetAttribute(&cus, hipDeviceAttributeMultiprocessorCount, dev);
        if (hipFuncSetAttribute((const void*)mk::mk_fwd, hipFuncAttributeMaxDynamicSharedMemorySize, mk::LDS_BYTES) != hipSuccess) { fprintf(stderr, "kernel_launch: hipFuncSetAttribute failed\n"); grid = -1; return; }
        if (hipOccupancyMaxActiveBlocksPerMultiprocessor(&per_cu, (const void*)mk::mk_fwd, 512, mk::LDS_BYTES) != hipSuccess || per_cu < 1) { fprintf(stderr, "kernel_launch: occupancy query says %d\n", per_cu); grid = -1; (void)hipGetLastError(); return; }
        grid = cus;
    }
    if (grid < 0) return;
    mk::Args a{};
    for (int i = 0; i < 20; ++i) a.in[i] = (const float*)d_in[i];
    a.out = (float*)d_out; a.ws = (unsigned char*)d_ws;
#if MK_MULTI
    for (int ph = 0; ph < mk::NPHASE; ++ph) { a.ph_lo = ph; a.ph_hi = ph + 1; hipLaunchKernelGGL(mk::mk_fwd, dim3(grid), dim3(512), mk::LDS_BYTES, stream, a); }
#else
    a.ph_lo = 0; a.ph_hi = mk::NPHASE;
    void* args[] = {&a};
    hipError_t e = hipLaunchCooperativeKernel((const void*)mk::mk_fwd, dim3(grid), dim3(512), args, mk::LDS_BYTES, stream);
    if (e != hipSuccess) fprintf(stderr, "kernel_launch: cooperative launch failed: %s\n", hipGetErrorString(e));
#endif
}
```

```cpp
#include <hip/hip_runtime.h>
#include <hip/hip_cooperative_groups.h>
#include <cstdio>
namespace cg = cooperative_groups;
#include <cstdint>
namespace pg8 {
#define PG8_LAS __attribute__((address_space(3)))
typedef unsigned short bf16_t;
typedef short bf16x8 __attribute__((ext_vector_type(8)));
typedef float f32x4 __attribute__((ext_vector_type(4)));
typedef unsigned u32x4 __attribute__((ext_vector_type(4)));
constexpr int BM = 256, BK = 64, HALF = 128, HTB = HALF * BK * 2  , STAGE_BYTES = 8 * HTB, NXCD = 8, WGM = 8;

__host__ __device__ __forceinline__ int lds_byte(int r, int c) { const int st = (r >> 4) * 2 + (c >> 5), rr = r & 15, cc = c & 31, ob = rr * 64 + cc * 2; return st * 1024 + (ob ^ (((ob >> 9) & 1) << 5)); }
__host__ __device__ __forceinline__ void stage_rc(int b, int& R, int& C) { const int st = b / 1024, sb = b % 1024, swz = sb ^ (((sb >> 9) & 1) << 5); R = (st >> 1) * 16 + swz / 64; C = (st & 1) * 32 + (swz % 64) / 2; }
__host__ __device__ __forceinline__ int perm32(int rho) { const int n = rho >> 4, i = rho & 15; return 8 * (i >> 2) + 4 * n + (i & 3); }

struct Unit { int pm, pn; };
struct Gemm { const bf16_t* A; const bf16_t* Bt; int M, N, K; };

struct StaticOrder {
    int nM, nN, nwg, G, c;
    __host__ __device__ void init(int M, int N, int G_, int c_) { nM = M / BM; nN = N / BM; nwg = nM * nN; G = G_; c = c_; }
    __host__ __device__ bool next(int i, Unit& u) const {
        const long L = (long)i * G + c; if (L >= nwg) return false;
        int wgid = (int)L; { const int q = nwg / NXCD, r = nwg % NXCD, xcd = wgid % NXCD, off = wgid / NXCD; wgid = (xcd < r ? xcd * (q + 1) : r * (q + 1) + (xcd - r) * q) + off; }
        const int nig = WGM * nN, gid = wgid / nig, fm = gid * WGM, gsz = (nM - fm) < WGM ? (nM - fm) : WGM;
        u.pm = fm + ((wgid % nig) % gsz); u.pn = (wgid % nig) / gsz; return true;
    }
    __device__ __forceinline__ void a_ready(const Unit&) const {}
    __device__ __forceinline__ void done(const Unit&) const {}
};

__device__ __forceinline__ unsigned cvt_pk_bf16(float lo, float hi) { unsigned r; asm volatile("v_cvt_pk_bf16_f32 %0, %1, %2" : "=v"(r) : "v"(lo), "v"(hi)); return r; }
typedef float f32x2 __attribute__((ext_vector_type(2)));
__device__ __forceinline__ f32x2 gelu_pk(f32x2 v) {
    const f32x2 av = __builtin_elementwise_abs(v), d = av * 0.2316418882f + 1.0f;
    f32x2 t; t.x = __builtin_amdgcn_rcpf(d.x); t.y = __builtin_amdgcn_rcpf(d.y);
    f32x2 q = t * 0.5307027145f + (-0.7265760135f); q = q * t + 0.7107068705f; q = q * t + (-0.142248368f); q = q * t + 0.127414796f; q = q * t;
    const f32x2 s = (v * v) * (-0.72134752044f);
    f32x2 e; e.x = __builtin_amdgcn_exp2f(s.x); e.y = __builtin_amdgcn_exp2f(s.y);
    const f32x2 m = v * (q * e), r = v - m;
    f32x2 o; o.x = v.x < 0.f ? m.x : r.x; o.y = v.y < 0.f ? m.y : r.y; return o;
}

template <int ACT  > struct EpiBf16 {
    static constexpr bool PERM = true, AFTER_DRAIN = false; static_assert(ACT == 0 || ACT == 1, "EpiBf16: ACT is 0 (none) or 1 (gelu_pk)");
    bf16_t* O; int ldc; const float* bias; int split_cols; size_t split_stride; float scale0;
    __device__ __forceinline__ void operator()(const f32x4 (&acc)[2][2][4][2], const Unit& u, int wr, int wc, int fr, int fq) const {
        const int row0 = u.pm * BM + wr * 64 + fr; int colt = u.pn * BM; bf16_t* base = O;
        float sc = 1.f; if (split_cols) { const int t = colt / split_cols; base += (size_t)t * split_stride; colt -= t * split_cols; if (t == 0) sc = scale0; }
        const int col0 = colt + wc * 32 + 8 * fq, bcol0 = u.pn * BM + wc * 32 + 8 * fq;
        f32x4 bv[2][2];
#pragma unroll
        for (int bj = 0; bj < 2; ++bj)
#pragma unroll
            for (int n = 0; n < 2; ++n) bv[bj][n] = bias ? *(const f32x4*)(bias + bcol0 + bj * HALF + 4 * n) : (f32x4){0.f, 0.f, 0.f, 0.f};
#pragma unroll
        for (int ai = 0; ai < 2; ++ai)
#pragma unroll
            for (int m = 0; m < 4; ++m) { bf16_t* rowp = base + (size_t)(row0 + ai * HALF + m * 16) * ldc + col0;
#pragma unroll
                for (int bj = 0; bj < 2; ++bj) { f32x4 v0 = acc[ai][bj][m][0] + bv[bj][0], v1 = acc[ai][bj][m][1] + bv[bj][1];
                    if (ACT == 1) { f32x2 a = gelu_pk((f32x2){v0[0], v0[1]}), b = gelu_pk((f32x2){v0[2], v0[3]}), c = gelu_pk((f32x2){v1[0], v1[1]}), d = gelu_pk((f32x2){v1[2], v1[3]});
                        v0 = (f32x4){a.x, a.y, b.x, b.y}; v1 = (f32x4){c.x, c.y, d.x, d.y}; }
                    v0 = v0 * sc; v1 = v1 * sc; u32x4 w; w.x = cvt_pk_bf16(v0[0], v0[1]); w.y = cvt_pk_bf16(v0[2], v0[3]); w.z = cvt_pk_bf16(v1[0], v1[1]); w.w = cvt_pk_bf16(v1[2], v1[3]);
                    *(u32x4*)(rowp + bj * HALF) = w; } }
    }
};

struct PanelStats {
    unsigned* xbuf;
    unsigned* cnt;
    unsigned* tmo;
    int ntn; float eps;
    unsigned code;
    __device__ __forceinline__ bool run(const f32x4 (&v)[2][2][4][2], const Unit& u, int wr, int wc, int fr, int fq, PG8_LAS unsigned char* lds, int wid, int lane) const {
        typedef float f32x2v __attribute__((ext_vector_type(2)));
        PG8_LAS f32x2v* P = (PG8_LAS f32x2v*)lds;
        PG8_LAS f32x2v* S = (PG8_LAS f32x2v*)(lds + 8192);
        PG8_LAS unsigned* flag = (PG8_LAS unsigned*)(lds + 8192 + 2048);
#pragma unroll
        for (int ai = 0; ai < 2; ++ai)
#pragma unroll
            for (int m = 0; m < 4; ++m) {
                float s = 0.f;
#pragma unroll
                for (int bj = 0; bj < 2; ++bj)
#pragma unroll
                    for (int n = 0; n < 2; ++n) { const f32x4 x = v[ai][bj][m][n]; s += (x[0] + x[1]) + (x[2] + x[3]); }
                s += __shfl_xor(s, 16); s += __shfl_xor(s, 32);
                const float mw = s * (1.0f / 64.0f); float q = 0.f;
#pragma unroll
                for (int bj = 0; bj < 2; ++bj)
#pragma unroll
                    for (int n = 0; n < 2; ++n) { const f32x4 d = v[ai][bj][m][n] - mw; q += (d[0] * d[0] + d[1] * d[1]) + (d[2] * d[2] + d[3] * d[3]); }
                q += __shfl_xor(q, 16); q += __shfl_xor(q, 32);
                if (fq == 0) P[(ai * HALF + wr * 64 + m * 16 + fr) * 4 + wc] = (f32x2v){mw, q};
            }
        asm volatile("s_waitcnt lgkmcnt(0)" ::: "memory"); __builtin_amdgcn_s_barrier(); asm volatile("" ::: "memory");
#if defined(BROKEN_EXCHANGE_NO_WAIT)
#warning BROKEN CONTROL BUILD: the row-statistics exchange does not wait; results are wrong by design
        if (blockIdx.x >= 64) { const long long t0_ = clock64(); while (clock64() - t0_ < 60000) __builtin_amdgcn_s_sleep(8); }
#endif
        const int row = wid * 32 + (lane & 31);
        if (lane < 32) {
            const f32x2v a = P[row * 4 + 0], b = P[row * 4 + 1], c = P[row * 4 + 2], d = P[row * 4 + 3];
            const float mt = (a.x + b.x + c.x + d.x) * 0.25f;
            const float da = a.x - mt, db = b.x - mt, dc = c.x - mt, dd = d.x - mt;
            const float m2 = (a.y + b.y) + (c.y + d.y) + 64.0f * ((da * da + db * db) + (dc * dc + dd * dd));
            unsigned long long* slot = (unsigned long long*)xbuf + ((size_t)(u.pm * BM + row) * 4 + u.pn);
            __hip_atomic_store(slot, ((unsigned long long)__float_as_uint(m2) << 32) | __float_as_uint(mt), __ATOMIC_RELAXED, __HIP_MEMORY_SCOPE_AGENT);
        }
        asm volatile("s_waitcnt vmcnt(0)" ::: "memory");
        if (lane == 0) __hip_atomic_fetch_add(cnt + 64 * u.pm, 1u, __ATOMIC_RELAXED, __HIP_MEMORY_SCOPE_AGENT);
        if (wid == 0) {
            bool dead = false; const unsigned long long t0 = __builtin_amdgcn_s_memrealtime(); const unsigned want = 8u * (unsigned)ntn;
            for (;;) {
#if defined(BROKEN_EXCHANGE_NO_WAIT)
                break;
#endif
                if ((unsigned)__builtin_amdgcn_readfirstlane(__hip_atomic_load(cnt + 64 * u.pm, __ATOMIC_RELAXED, __HIP_MEMORY_SCOPE_AGENT)) >= want) break;
                if (__builtin_amdgcn_s_memrealtime() - t0 > 2000000ull) {
                    if (lane == 0) { unsigned expect = 0u; __hip_atomic_compare_exchange_strong(tmo + 1, &expect, code | (unsigned)(u.pm & 0xff), __ATOMIC_RELAXED, __ATOMIC_RELAXED, __HIP_MEMORY_SCOPE_AGENT);
                                     __hip_atomic_store(tmo, 1u, __ATOMIC_RELAXED, __HIP_MEMORY_SCOPE_AGENT); }
                    dead = true; break; }
                __builtin_amdgcn_s_sleep(2);
            }
            __builtin_amdgcn_fence(__ATOMIC_ACQUIRE, "agent");
            if (lane == 0) flag[0] = dead ? 1u : 0u;
        }
        asm volatile("s_waitcnt vmcnt(0) lgkmcnt(0)" ::: "memory"); __builtin_amdgcn_s_barrier(); asm volatile("" ::: "memory");
        const bool bad = flag[0] != 0u;
        if (lane < 32) {
            const unsigned long long* slot = (const unsigned long long*)xbuf + (size_t)(u.pm * BM + row) * 4; float mt[4], m2[4]; float ms = 0.f;
#pragma unroll
            for (int t = 0; t < 4; ++t) { if (t < ntn) { const unsigned long long w = __hip_atomic_load(slot + t, __ATOMIC_RELAXED, __HIP_MEMORY_SCOPE_AGENT); mt[t] = __uint_as_float((unsigned)w); m2[t] = __uint_as_float((unsigned)(w >> 32)); } else { mt[t] = 0.f; m2[t] = 0.f; } ms += mt[t]; }
            const float mean = ms / (float)ntn; float q = 0.f;
#pragma unroll
            for (int t = 0; t < 4; ++t) if (t < ntn) { const float dm = mt[t] - mean; q += m2[t] + 256.0f * dm * dm; }
            S[row] = (f32x2v){mean, 1.0f / sqrtf(q / (256.0f * (float)ntn) + eps)};
        }
        asm volatile("s_waitcnt lgkmcnt(0)" ::: "memory"); __builtin_amdgcn_s_barrier(); asm volatile("" ::: "memory");
        return bad;
    }
};
struct EpiLnRes {
    static constexpr bool PERM = false, AFTER_DRAIN = true;
    const float* base; float* out; int ldc; const float* bias; PanelStats st; unsigned poison;
    __device__ __forceinline__ void fused(f32x4 (&acc)[2][2][4][2], const Unit& u, int wr, int wc, int fr, int fq, PG8_LAS unsigned char* lds, int wid, int lane) const {
        typedef float f32x2v __attribute__((ext_vector_type(2)));
        const PG8_LAS f32x2v* S = (const PG8_LAS f32x2v*)(lds + 8192);
        const int col0 = u.pn * BM + wc * 32 + 4 * fq;
#pragma unroll
        for (int bj = 0; bj < 2; ++bj)
#pragma unroll
            for (int n = 0; n < 2; ++n) { const f32x4 bv = bias ? *(const f32x4*)(bias + col0 + bj * HALF + n * 16) : (f32x4){0.f, 0.f, 0.f, 0.f};
#pragma unroll
                for (int ai = 0; ai < 2; ++ai)
#pragma unroll
                    for (int m = 0; m < 4; ++m) acc[ai][bj][m][n] += bv; }
        f32x4 pre[4][2][2];
#pragma unroll
        for (int m = 0; m < 4; ++m) { const size_t off = (size_t)(u.pm * BM + wr * 64 + m * 16 + fr) * ldc + col0;
#pragma unroll
            for (int bj = 0; bj < 2; ++bj)
#pragma unroll
                for (int n = 0; n < 2; ++n) pre[m][bj][n] = *(const f32x4*)(base + off + bj * HALF + n * 16); }
        const bool bad = st.run(acc, u, wr, wc, fr, fq, lds, wid, lane) || poison != 0u;
        const float qnan = __builtin_nanf("");
#pragma unroll
        for (int ai = 0; ai < 2; ++ai)
#pragma unroll
            for (int m = 0; m < 4; ++m) { const int r = ai * HALF + wr * 64 + m * 16 + fr; const f32x2v sr = S[r]; const size_t off = (size_t)(u.pm * BM + r) * ldc + col0;
#pragma unroll
                for (int bj = 0; bj < 2; ++bj)
#pragma unroll
                    for (int n = 0; n < 2; ++n) { const f32x4 bs = ai == 0 ? pre[m][bj][n] : *(const f32x4*)(base + off + bj * HALF + n * 16); f32x4 o = bs + (acc[ai][bj][m][n] - sr.x) * sr.y;
                        if (bad) o = (f32x4){qnan, qnan, qnan, qnan}; *(f32x4*)(out + off + bj * HALF + n * 16) = o; }
                if (m & 1) asm volatile("" ::: "memory"); }
    }
};
struct EpiLnResLn {
    static constexpr bool PERM = false, AFTER_DRAIN = true;
    const float* base; float* out; bf16_t* xn; int ldc; const float* bias; PanelStats st1, st2; unsigned poison;
    __device__ __forceinline__ void fused(f32x4 (&acc)[2][2][4][2], const Unit& u, int wr, int wc, int fr, int fq, PG8_LAS unsigned char* lds, int wid, int lane) const {
        typedef float f32x2v __attribute__((ext_vector_type(2))); typedef unsigned u32x2v __attribute__((ext_vector_type(2)));
        const PG8_LAS f32x2v* S = (const PG8_LAS f32x2v*)(lds + 8192);
        const int col0 = u.pn * BM + wc * 32 + 4 * fq;
#pragma unroll
        for (int bj = 0; bj < 2; ++bj)
#pragma unroll
            for (int n = 0; n < 2; ++n) { const f32x4 bv = bias ? *(const f32x4*)(bias + col0 + bj * HALF + n * 16) : (f32x4){0.f, 0.f, 0.f, 0.f};
#pragma unroll
                for (int ai = 0; ai < 2; ++ai)
#pragma unroll
                    for (int m = 0; m < 4; ++m) acc[ai][bj][m][n] += bv; }
        bool bad = st1.run(acc, u, wr, wc, fr, fq, lds, wid, lane) || poison != 0u;
        const float qnan = __builtin_nanf("");
#pragma unroll
        for (int ai = 0; ai < 2; ++ai)
#pragma unroll
            for (int m = 0; m < 4; ++m) { const int r = ai * HALF + wr * 64 + m * 16 + fr; const f32x2v sr = S[r]; const size_t off = (size_t)(u.pm * BM + r) * ldc + col0;
#pragma unroll
                for (int bj = 0; bj < 2; ++bj)
#pragma unroll
                    for (int n = 0; n < 2; ++n) { const f32x4 bs = *(const f32x4*)(base + off + bj * HALF + n * 16); acc[ai][bj][m][n] = bs + (acc[ai][bj][m][n] - sr.x) * sr.y; }
                asm volatile("" : "+v"(acc[ai][0][m][0]), "+v"(acc[ai][0][m][1]), "+v"(acc[ai][1][m][0]), "+v"(acc[ai][1][m][1]));
                if (m & 1) asm volatile("" ::: "memory"); }
        const bool bad1 = bad;
        bad = st2.run(acc, u, wr, wc, fr, fq, lds, wid, lane) || bad;
#pragma unroll
        for (int ai = 0; ai < 2; ++ai)
#pragma unroll
            for (int m = 0; m < 4; ++m) { const int r = ai * HALF + wr * 64 + m * 16 + fr; const f32x2v sr = S[r]; const size_t off = (size_t)(u.pm * BM + r) * ldc + col0;
#pragma unroll
                for (int bj = 0; bj < 2; ++bj)
#pragma unroll
                    for (int n = 0; n < 2; ++n) { const f32x4 x1 = acc[ai][bj][m][n]; *(f32x4*)(out + off + bj * HALF + n * 16) = bad1 ? (f32x4){qnan, qnan, qnan, qnan} : x1;
                        const f32x4 o = (x1 - sr.x) * sr.y; u32x2v w; w.x = cvt_pk_bf16(o[0], o[1]); w.y = cvt_pk_bf16(o[2], o[3]);
                        if (bad) { w.x = 0x7fc07fc0u; w.y = 0x7fc07fc0u; } *(u32x2v*)(xn + off + bj * HALF + n * 16) = w; }
                asm volatile("" ::: "memory"); }
    }
};

template <class Epi, class Sched, bool ALIGN_EPI = false, bool SP2 = false>
__device__ __forceinline__ void gemm_phase(PG8_LAS unsigned char* lds, const Gemm g, const Sched& S, const Epi& E) {
    int tid_ = threadIdx.x; asm volatile("" : "+v"(tid_));
    const int tid = tid_, wid = __builtin_amdgcn_readfirstlane(tid >> 6), lane = tid & 63, wr = wid >> 2, wc = wid & 3, fr = lane & 15, fq = lane >> 4;
    int K_ = g.K; asm volatile("" : "+s"(K_)); const int K = K_, nt = K / BK;
    unsigned voffA[2], voffB[2];
#pragma unroll
    for (int i = 0; i < 2; ++i) { int R, C; stage_rc(tid * 16 + i * 8192, R, C); const int Rb = Epi::PERM ? ((R & ~31) + perm32(R & 31)) : R;
        voffA[i] = (unsigned)(R * K + C) * 2u; voffB[i] = (unsigned)(Rb * K + C) * 2u; }
    const size_t kstep = (size_t)(BK * 2);
    const size_t hstep = (size_t)HALF * K * 2;
    const size_t tstep = 2 * hstep;
    const unsigned ldsw = (unsigned)wid * 1024u;
    const int aoff = lds_byte(wr * 64 + fr, fq * 8), boff = lds_byte(wc * 32 + fr, fq * 8);
#define PG8_SA(b, h) (((b) * 2 + (h)) * HTB)
#define PG8_SB(b, h) ((4 + (b) * 2 + (h)) * HTB)
#define PG8_STAGE(bufoff, gbase, voff) do { _Pragma("unroll") for (int _i = 0; _i < 2; ++_i) \
        __builtin_amdgcn_global_load_lds((const unsigned*)((const char*)(gbase) + (voff)[_i]), (PG8_LAS unsigned*)(lds + (bufoff) + ldsw + _i * 8192), 16, 0, 0); } while (0)
#define PG8_LDA(dst, b, h) do { _Pragma("unroll") for (int m = 0; m < 4; ++m) _Pragma("unroll") for (int k = 0; k < 2; ++k) dst[m][k] = *(const PG8_LAS bf16x8*)(lds + PG8_SA(b, h) + aoff + m * 2048 + k * 1024); } while (0)
#define PG8_LDB(dst, b, h) do { _Pragma("unroll") for (int n = 0; n < 2; ++n) _Pragma("unroll") for (int k = 0; k < 2; ++k) dst[n][k] = *(const PG8_LAS bf16x8*)(lds + PG8_SB(b, h) + boff + n * 2048 + k * 1024); } while (0)
#define PG8_MMA(ai, bj, At, Bt) do { __builtin_amdgcn_s_setprio(1); _Pragma("unroll") for (int m = 0; m < 4; ++m) _Pragma("unroll") for (int n = 0; n < 2; ++n) _Pragma("unroll") for (int k = 0; k < 2; ++k) \
        acc[ai][bj][m][n] = __builtin_amdgcn_mfma_f32_16x16x32_bf16(Bt[n][k], At[m][k], acc[ai][bj][m][n], 0, 0, 0); __builtin_amdgcn_s_setprio(0); } while (0)
#define PG8_WAIT_V(n) asm volatile("s_waitcnt vmcnt(" #n ")" ::: "memory")
#define PG8_WAIT_L(n) asm volatile("s_waitcnt lgkmcnt(" #n ")" ::: "memory")
#define PG8_BAR __builtin_amdgcn_s_barrier()
#define PG8_SCHED __builtin_amdgcn_sched_barrier(0)
    Unit cur, nxt; int ui = 0;
    if (!S.next(0, cur)) return;
    f32x4 acc[2][2][4][2];
#pragma unroll
    for (int a = 0; a < 2; ++a)
#pragma unroll
        for (int b = 0; b < 2; ++b)
#pragma unroll
            for (int m = 0; m < 4; ++m)
#pragma unroll
                for (int n = 0; n < 2; ++n) acc[a][b][m][n] = (f32x4){0.f, 0.f, 0.f, 0.f};
    bf16x8 At[4][2], B0[2][2], B1[2][2];
    const char* cA = (const char*)g.A + (size_t)cur.pm * tstep; const char* cB = (const char*)g.Bt + (size_t)cur.pn * tstep;
    S.a_ready(cur);
    if constexpr (SP2) {
        PG8_STAGE(PG8_SB(0, 0), cB, voffB); PG8_STAGE(PG8_SB(0, 1), cB + hstep, voffB); PG8_STAGE(PG8_SA(0, 0), cA, voffA); PG8_STAGE(PG8_SA(0, 1), cA + hstep, voffA);
        if (wr == 1) PG8_BAR;
        PG8_WAIT_V(2); PG8_BAR;
        PG8_STAGE(PG8_SB(1, 0), cB + kstep, voffB); PG8_STAGE(PG8_SA(1, 0), cA + kstep, voffA); PG8_STAGE(PG8_SB(1, 1), cB + hstep + kstep, voffB);
        PG8_WAIT_V(6); PG8_BAR;
    } else {
        PG8_STAGE(PG8_SB(0, 0), cB, voffB); PG8_STAGE(PG8_SA(0, 0), cA, voffA); PG8_STAGE(PG8_SB(0, 1), cB + hstep, voffB); PG8_STAGE(PG8_SA(0, 1), cA + hstep, voffA);
        if (wr == 1) PG8_BAR;
        PG8_WAIT_V(4); PG8_BAR;
        PG8_STAGE(PG8_SB(1, 0), cB + kstep, voffB); PG8_STAGE(PG8_SA(1, 0), cA + kstep, voffA); PG8_STAGE(PG8_SB(1, 1), cB + hstep + kstep, voffB);
        PG8_WAIT_V(6); PG8_BAR;
    }
    for (;;) {
        const bool has_next = S.next(ui + 1, nxt);
        const char* nA = has_next ? (const char*)g.A + (size_t)nxt.pm * tstep : cA; const char* nB = has_next ? (const char*)g.Bt + (size_t)nxt.pn * tstep : cB;
        for (int t = 0; t < nt; t += 2) {
            const bool last = (t == nt - 2);
            const char* a1 = cA + (size_t)(t + 1) * kstep;
            const char* a2 = last ? nA : cA + (size_t)(t + 2) * kstep; const char* b2 = last ? nB : cB + (size_t)(t + 2) * kstep;
            const char* a3 = a2 + kstep; const char* b3 = b2 + kstep;
            if (last && has_next) S.a_ready(nxt);
            if constexpr (SP2) {
            PG8_LDB(B0, 0, 0); PG8_LDB(B1, 0, 1); PG8_SCHED; PG8_LDA(At, 0, 0); PG8_STAGE(PG8_SA(1, 1), a1 + hstep, voffA);
            PG8_WAIT_V(8); PG8_WAIT_L(0); PG8_BAR; PG8_MMA(0, 0, At, B0); PG8_MMA(0, 1, At, B1); PG8_BAR; PG8_SCHED;
            PG8_LDA(At, 0, 1); PG8_STAGE(PG8_SB(0, 0), b2, voffB); PG8_STAGE(PG8_SB(0, 1), b2 + hstep, voffB); PG8_STAGE(PG8_SA(0, 0), a2, voffA);
            PG8_WAIT_V(8); PG8_WAIT_L(0); PG8_BAR; PG8_MMA(1, 0, At, B0); PG8_MMA(1, 1, At, B1); PG8_BAR; PG8_SCHED;
            PG8_LDB(B0, 1, 0); PG8_LDB(B1, 1, 1); PG8_SCHED; PG8_LDA(At, 1, 0); PG8_STAGE(PG8_SA(0, 1), a2 + hstep, voffA);
            PG8_WAIT_V(8); PG8_WAIT_L(0); PG8_BAR; PG8_MMA(0, 0, At, B0); PG8_MMA(0, 1, At, B1); PG8_BAR; PG8_SCHED;
            PG8_LDA(At, 1, 1); PG8_STAGE(PG8_SB(1, 0), b3, voffB); PG8_STAGE(PG8_SB(1, 1), b3 + hstep, voffB); PG8_STAGE(PG8_SA(1, 0), a3, voffA);
            PG8_WAIT_V(8); PG8_WAIT_L(0); PG8_BAR; PG8_MMA(1, 0, At, B0); PG8_MMA(1, 1, At, B1); PG8_BAR; PG8_SCHED;
            } else {
            PG8_LDB(B0, 0, 0); PG8_SCHED; PG8_LDA(At, 0, 0); PG8_STAGE(PG8_SA(1, 1), a1 + hstep, voffA);
            PG8_WAIT_L(8); PG8_BAR; PG8_WAIT_L(0); PG8_MMA(0, 0, At, B0); PG8_BAR; PG8_SCHED;
            PG8_LDB(B1, 0, 1); PG8_STAGE(PG8_SB(0, 0), b2, voffB);
            PG8_BAR; PG8_WAIT_L(0); PG8_MMA(0, 1, At, B1); PG8_BAR;
            PG8_LDA(At, 0, 1); PG8_STAGE(PG8_SA(0, 0), a2, voffA);
            PG8_BAR; PG8_WAIT_L(0); PG8_MMA(1, 0, At, B0); PG8_BAR; PG8_SCHED;
            PG8_STAGE(PG8_SB(0, 1), b2 + hstep, voffB);
            PG8_WAIT_V(6); PG8_BAR; PG8_MMA(1, 1, At, B1); PG8_BAR;
            PG8_LDB(B0, 1, 0); PG8_SCHED; PG8_LDA(At, 1, 0); PG8_STAGE(PG8_SA(0, 1), a2 + hstep, voffA);
            PG8_WAIT_L(8); PG8_BAR; PG8_WAIT_L(0); PG8_MMA(0, 0, At, B0); PG8_BAR; PG8_SCHED;
            PG8_LDB(B1, 1, 1); PG8_STAGE(PG8_SB(1, 0), b3, voffB);
            PG8_BAR; PG8_WAIT_L(0); PG8_MMA(0, 1, At, B1); PG8_BAR;
            PG8_LDA(At, 1, 1); PG8_STAGE(PG8_SA(1, 0), a3, voffA);
            PG8_BAR; PG8_WAIT_L(0); PG8_MMA(1, 0, At, B0); PG8_BAR; PG8_SCHED;
            PG8_STAGE(PG8_SB(1, 1), b3 + hstep, voffB);
            PG8_WAIT_V(6); PG8_BAR; PG8_MMA(1, 1, At, B1); PG8_BAR;
            }
        }
        if constexpr (ALIGN_EPI) { if (wr == 0) PG8_BAR; }
        if constexpr (!Epi::AFTER_DRAIN) { E(acc, cur, wr, wc, fr, fq); S.done(cur); }
        if (!has_next) break;
#pragma unroll
        for (int a = 0; a < 2; ++a)
#pragma unroll
            for (int b = 0; b < 2; ++b)
#pragma unroll
                for (int m = 0; m < 4; ++m)
#pragma unroll
                    for (int n = 0; n < 2; ++n) acc[a][b][m][n] = (f32x4){0.f, 0.f, 0.f, 0.f};
        cur = nxt; cA = nA; cB = nB; ++ui;
        if constexpr (ALIGN_EPI) { if (wr == 1) PG8_BAR; }
    }
    PG8_WAIT_V(0);
    if constexpr (!ALIGN_EPI) { if (wr == 0) PG8_BAR; }
    PG8_BAR;
    if constexpr (Epi::AFTER_DRAIN) { E.fused(acc, cur, wr, wc, fr, fq, lds, wid, lane); S.done(cur); }
#undef PG8_SA
#undef PG8_SB
#undef PG8_STAGE
#undef PG8_LDA
#undef PG8_LDB
#undef PG8_MMA
#undef PG8_WAIT_V
#undef PG8_WAIT_L
#undef PG8_BAR
#undef PG8_SCHED
}
}

#ifndef PG8_SP2
#define PG8_SP2 true
#endif
#ifndef PG8_ALIGN
#define PG8_ALIGN true
#endif

namespace mk {
using pg8::bf16_t; using pg8::f32x4; using pg8::u32x4; using pg8::Unit; using pg8::BM; using pg8::HALF; using pg8::bf16x8;
#define LAS __attribute__((address_space(3)))
#define GAS __attribute__((address_space(1)))
typedef unsigned u32x2 __attribute__((ext_vector_type(2)));
typedef float f32x2 __attribute__((ext_vector_type(2)));
typedef float f32x16 __attribute__((ext_vector_type(16)));

constexpr int M = 32768, D = 1024, FF = 2816, NGU = 5632, DIN = 1952, DINP = 2048, SEQ = 4096;
constexpr float EPS = 1e-6f;
constexpr float LOG2E = 1.4426950408889634f;
constexpr float QSCALE = 0.10206207261596577f * 1.4426950408889634f;

constexpr size_t MiB = 1u << 20;
constexpr size_t WS_CS = 0;
constexpr size_t WS_BAR = 65536;
constexpr size_t WS_WGU1 = 1 * MiB, WS_WD1 = 12 * MiB, WS_WIN = 18 * MiB, WS_WUQ = 22 * MiB, WS_WUKV = 22 * MiB + 512 * 1024,
                 WS_WOUT = 23 * MiB, WS_WGU2 = 25 * MiB, WS_WD2 = 36 * MiB;
constexpr size_t WS_XN = 49 * MiB;
constexpr size_t WS_F = 113 * MiB;
constexpr size_t WS_H = 177 * MiB;
constexpr size_t WS_QM = 305 * MiB;
constexpr size_t WS_KM = 353 * MiB;
constexpr size_t WS_VM = 401 * MiB;
constexpr size_t WS_CQN = 433 * MiB;
constexpr size_t WS_CKVN = 449 * MiB;
constexpr size_t WS_END = 457 * MiB;

constexpr int LDS_BYTES = 147456;

__device__ __forceinline__ float bf_lo(unsigned w) { return __uint_as_float(w << 16); }
__device__ __forceinline__ float bf_hi(unsigned w) { return __uint_as_float(w & 0xffff0000u); }
__device__ __forceinline__ unsigned pk(float lo, float hi) { return pg8::cvt_pk_bf16(lo, hi); }
__device__ __forceinline__ float wave_sum(float v) {
#pragma unroll
    for (int o = 1; o < 64; o <<= 1) v += __shfl_xor(v, o);
    return v;
}
__device__ __forceinline__ float dot4(f32x4 a) { return (a[0] * a[0] + a[1] * a[1]) + (a[2] * a[2] + a[3] * a[3]); }

struct EpiSwiGLU {
    static constexpr bool PERM = true, AFTER_DRAIN = false;
    bf16_t* O; int ldc;
    __device__ __forceinline__ void operator()(const f32x4 (&acc)[2][2][4][2], const Unit& u, int wr, int wc, int fr, int fq) const {
        const int row0 = u.pm * BM + wr * 64 + fr; const int col0 = u.pn * 128 + wc * 32 + 8 * fq;
#pragma unroll
        for (int ai = 0; ai < 2; ++ai)
#pragma unroll
            for (int m = 0; m < 4; ++m) {
                bf16_t* rowp = O + (size_t)(row0 + ai * HALF + m * 16) * ldc + col0;
                float r[8];
#pragma unroll
                for (int n = 0; n < 2; ++n)
#pragma unroll
                    for (int j = 0; j < 4; ++j) { const float g = acc[ai][0][m][n][j], up = acc[ai][1][m][n][j];
                        const float e = __builtin_amdgcn_exp2f(-g * LOG2E); r[4 * n + j] = g * __builtin_amdgcn_rcpf(1.0f + e) * up; }
                u32x4 w; w.x = pk(r[0], r[1]); w.y = pk(r[2], r[3]); w.z = pk(r[4], r[5]); w.w = pk(r[6], r[7]);
                *(u32x4*)rowp = w;
            }
    }
};
struct EpiKV {
    static constexpr bool PERM = true, AFTER_DRAIN = false;
    bf16_t* Km; bf16_t* Vm;
    __device__ __forceinline__ void operator()(const f32x4 (&acc)[2][2][4][2], const Unit& u, int wr, int wc, int fr, int fq) const {
        const int row0 = u.pm * BM + wr * 64 + fr;
#pragma unroll
        for (int bj = 0; bj < 2; ++bj) {
            const int colt = u.pn * BM + bj * HALF + wc * 32 + 8 * fq;
            bf16_t* base; int ld;
            if (colt < 512) { base = Km + 96 * (colt >> 6) + (colt & 63); ld = 768; } else { base = Vm + (colt - 512); ld = 512; }
#pragma unroll
            for (int ai = 0; ai < 2; ++ai)
#pragma unroll
                for (int m = 0; m < 4; ++m) { const f32x4 v0 = acc[ai][bj][m][0], v1 = acc[ai][bj][m][1];
                    u32x4 w; w.x = pk(v0[0], v0[1]); w.y = pk(v0[2], v0[3]); w.z = pk(v1[0], v1[1]); w.w = pk(v1[2], v1[3]);
                    *(u32x4*)(base + (size_t)(row0 + ai * HALF + m * 16) * ld) = w; }
        }
    }
};
struct EpiQ {
    static constexpr bool PERM = false, AFTER_DRAIN = false;
    bf16_t* O; const f32x2* cs;
    __device__ __forceinline__ void operator()(const f32x4 (&acc)[2][2][4][2], const Unit& u, int wr, int wc, int fr, int fq) const {
        const int row0 = u.pm * BM + wr * 64 + fr;
#pragma unroll
        for (int bj = 0; bj < 2; ++bj) {
            const int g32 = u.pn * 8 + bj * 4 + wc; const bool rot = (g32 % 3) == 2; const int cbase = g32 * 32 + 4 * fq;
#pragma unroll
            for (int ai = 0; ai < 2; ++ai)
#pragma unroll
                for (int m = 0; m < 4; ++m) {
                    const int row = row0 + ai * HALF + m * 16;
                    f32x4 x0 = acc[ai][bj][m][0], x1 = acc[ai][bj][m][1];
                    if (rot) { const int t = row & (SEQ - 1); const int pos = (fq < 2) ? (t >> 6) : (t & 63); const f32x2* cp = cs + pos * 8 + 4 * (fq & 1);
                        f32x4 y0, y1;
#pragma unroll
                        for (int j = 0; j < 4; ++j) { const f32x2 c = cp[j]; y0[j] = x0[j] * c.x - x1[j] * c.y; y1[j] = x1[j] * c.x + x0[j] * c.y; }
                        x0 = y0; x1 = y1; }
                    x0 = x0 * QSCALE; x1 = x1 * QSCALE;
                    bf16_t* p = O + (size_t)row * 768 + cbase;
                    u32x2 w0; w0.x = pk(x0[0], x0[1]); w0.y = pk(x0[2], x0[3]); u32x2 w1; w1.x = pk(x1[0], x1[1]); w1.y = pk(x1[2], x1[3]);
                    *(u32x2*)p = w0; *(u32x2*)(p + 16) = w1;
                    asm volatile("" ::: "memory");
                }
        }
    }
};

__device__ __forceinline__ void row_norm_to_bf16(const float* xrow, const float* g, bf16_t* orow, int lane) {
    const f32x4* xr = (const f32x4*)xrow + lane; const f32x4* gr = (const f32x4*)g + lane;
    f32x4 v[4]; float s = 0.f;
#pragma unroll
    for (int j = 0; j < 4; ++j) { v[j] = xr[64 * j]; s += dot4(v[j]); }
    const float rstd = 1.0f / sqrtf(wave_sum(s) * (1.0f / D) + EPS);
#pragma unroll
    for (int j = 0; j < 4; ++j) { const f32x4 o = v[j] * rstd * gr[64 * j]; u32x2 w; w.x = pk(o[0], o[1]); w.y = pk(o[2], o[3]); ((u32x2*)orow)[lane + 64 * j] = w; }
}
template <bool WRITE_XN>
__device__ __forceinline__ void row_mid(const bf16_t* frow, const float* resrow, float* outrow, const float* gpost, float coef, const float* gpre, bf16_t* xnrow, int lane) {
    f32x4 f[4]; float s = 0.f;
#pragma unroll
    for (int j = 0; j < 4; ++j) { const u32x2 w = ((const u32x2*)frow)[lane + 64 * j]; f[j] = (f32x4){bf_lo(w.x), bf_hi(w.x), bf_lo(w.y), bf_hi(w.y)}; s += dot4(f[j]); }
    const float rstd = 1.0f / sqrtf(wave_sum(s) * (1.0f / D) + EPS) * coef;
    float s2 = 0.f;
#pragma unroll
    for (int j = 0; j < 4; ++j) { const f32x4 gp = ((const f32x4*)gpost)[lane + 64 * j]; const f32x4 r = ((const f32x4*)resrow)[lane + 64 * j];
        f[j] = r + f[j] * rstd * gp; ((f32x4*)outrow)[lane + 64 * j] = f[j]; s2 += dot4(f[j]); }
    if (WRITE_XN) {
        const float rstd2 = 1.0f / sqrtf(wave_sum(s2) * (1.0f / D) + EPS);
#pragma unroll
        for (int j = 0; j < 4; ++j) { const f32x4 o = f[j] * rstd2 * ((const f32x4*)gpre)[lane + 64 * j]; u32x2 w; w.x = pk(o[0], o[1]); w.y = pk(o[2], o[3]); ((u32x2*)xnrow)[lane + 64 * j] = w; }
    }
}
__device__ __forceinline__ void row_onorm(bf16_t* orow, const float* gna, const float* gmla, int lane) {
    f32x4 f[4]; float sa = 0.f, sb = 0.f;
#pragma unroll
    for (int j = 0; j < 4; ++j) { const u32x2 w = ((const u32x2*)orow)[lane + 64 * j]; f[j] = (f32x4){bf_lo(w.x), bf_hi(w.x), bf_lo(w.y), bf_hi(w.y)}; if (j < 2) sa += dot4(f[j]); else sb += dot4(f[j]); }
    const float ra = 1.0f / sqrtf(wave_sum(sa) * (1.0f / 512.0f) + EPS), rb = 1.0f / sqrtf(wave_sum(sb) * (1.0f / 512.0f) + EPS);
#pragma unroll
    for (int j = 0; j < 4; ++j) { const f32x4 g = (j < 2) ? ((const f32x4*)gna)[lane + 64 * j] : ((const f32x4*)gmla)[lane + 64 * (j - 2)];
        const f32x4 o = f[j] * ((j < 2) ? ra : rb) * g; u32x2 w; w.x = pk(o[0], o[1]); w.y = pk(o[2], o[3]); ((u32x2*)orow)[lane + 64 * j] = w; }
}
__device__ __forceinline__ void mla_prep_row(const bf16_t* zrow, int row, const float* gq, const float* gkv, const f32x2* cs, bf16_t* cqn, bf16_t* ckvn, bf16_t* km, int lane) {
    const u32x2 wq = ((const u32x2*)(zrow + 1536))[lane];
    const float q0 = bf_lo(wq.x), q1 = bf_hi(wq.x), q2 = bf_lo(wq.y), q3 = bf_hi(wq.y);
    const float rq = 1.0f / sqrtf(wave_sum((q0 * q0 + q1 * q1) + (q2 * q2 + q3 * q3)) * (1.0f / 256.0f) + EPS);
    const unsigned wk = ((const unsigned*)(zrow + 1792))[lane];
    const float k0 = bf_lo(wk), k1 = bf_hi(wk);
    const float rk = 1.0f / sqrtf(wave_sum(k0 * k0 + k1 * k1) * (1.0f / 128.0f) + EPS);
    const f32x4 g = ((const f32x4*)gq)[lane];
    u32x2 o; o.x = pk(q0 * rq * g[0], q1 * rq * g[1]); o.y = pk(q2 * rq * g[2], q3 * rq * g[3]);
    ((u32x2*)(cqn + (size_t)row * 256))[lane] = o;
    const f32x2 g2 = ((const f32x2*)gkv)[lane];
    ((unsigned*)(ckvn + (size_t)row * 128))[lane] = pk(k0 * rk * g2.x, k1 * rk * g2.y);
    if (lane < 16) {
        const int i = lane; const float x1 = bf_lo((unsigned)zrow[1920 + i]), x2 = bf_lo((unsigned)zrow[1936 + i]);
        const int t = row & (SEQ - 1); const int pos = (i < 8) ? (t >> 6) : (t & 63); const f32x2 c = cs[pos * 8 + (i & 7)];
        const unsigned y = pk(x1 * c.x - x2 * c.y, x2 * c.x + x1 * c.y);
        bf16_t* kp = km + (size_t)row * 768 + 64 + i;
#pragma unroll
        for (int h = 0; h < 8; ++h) { kp[96 * h] = (bf16_t)(y & 0xffffu); kp[96 * h + 16] = (bf16_t)(y >> 16); }
    }
}

__device__ __forceinline__ void transpose_item(const float* W, int K, int N, bf16_t* WT, int k0, int n0, int n0_out, LAS float* scr, int lane) {
#pragma unroll 8
    for (int i = 0; i < 32; ++i) { const int kk = 2 * i + (lane >> 5); scr[kk * 33 + (lane & 31)] = W[(size_t)(k0 + kk) * N + n0 + (lane & 31)]; }
    asm volatile("s_waitcnt lgkmcnt(0)" ::: "memory");
    const int c = lane & 7;
#pragma unroll
    for (int j = 0; j < 4; ++j) { const int n = (lane >> 3) + 8 * j; const LAS float* s = scr + (8 * c) * 33 + n;
        u32x4 o; o.x = pk(s[0 * 33], s[1 * 33]); o.y = pk(s[2 * 33], s[3 * 33]); o.z = pk(s[4 * 33], s[5 * 33]); o.w = pk(s[6 * 33], s[7 * 33]);
        *(u32x4*)(WT + (size_t)(n0_out + n) * K + k0 + 8 * c) = o; }
    asm volatile("s_waitcnt lgkmcnt(0)" ::: "memory");
}
__device__ __forceinline__ int remap_gu(int n0) { if (n0 < FF) return 256 * (n0 >> 7) + (n0 & 127); const int m = n0 - FF; return 256 * (m >> 7) + 128 + (m & 127); }
__device__ __forceinline__ int remap_kv(int n0) { const int h = n0 >> 7, j = n0 & 127; return (j < 64) ? (64 * h + j) : (512 + 64 * h + (j - 64)); }
#define XB_TMO      128
#define XB_XCNT(j)  (256  + 64 * (j))
#define XB_XSUB(j)  (1280 + 64 * (j))
#define XB_XGEN(j)  (2304 + 64 * (j))
#define XB_TOP      3328
#define XB_TOPGEN   3392
#define XCD_BAR_WORDS 3456
#define XB_SPIN_CAP (1u << 18)

__device__ __forceinline__ unsigned xb_ld(unsigned* p)              { return __hip_atomic_load(p, __ATOMIC_RELAXED, __HIP_MEMORY_SCOPE_AGENT); }
__device__ __forceinline__ unsigned xb_add(unsigned* p, unsigned v) { return __hip_atomic_fetch_add(p, v, __ATOMIC_RELAXED, __HIP_MEMORY_SCOPE_AGENT); }
__device__ __forceinline__ unsigned xb_xcc_id() { return (unsigned)__builtin_amdgcn_s_getreg((3 << 11) | 20) & 0xFu; }
#define XB_SPIN(cond, bar) do { unsigned _sp = 0; while (cond) { __builtin_amdgcn_s_sleep(1); \
    if ((++_sp & 255u) == 0u) { if (xb_ld(&(bar)[XB_TMO])) break; if (_sp > XB_SPIN_CAP) { atomicAdd(&(bar)[XB_TMO], 1u); break; } } } } while (0)

struct XcdBarrier {
    unsigned* bar; unsigned x;
    volatile LAS unsigned* st;
};

__device__ __forceinline__ XcdBarrier xcd_barrier_post(unsigned* bar, volatile LAS unsigned* st) {
    XcdBarrier b; b.bar = bar; b.x = xb_xcc_id(); b.st = st;
    if (threadIdx.x == 0) (void)xb_add(&bar[XB_XCNT(b.x)], 1u);
    return b;
}
__device__ __forceinline__ void xcd_barrier_complete(unsigned* bar, unsigned x, unsigned& nloc, unsigned& nx) {
    const unsigned G = gridDim.x * gridDim.y * gridDim.z;
    unsigned sum, cnt, mine, sp = 0u;
    for (;;) {
        sum = 0u; cnt = 0u; mine = 0u;
#pragma unroll
        for (unsigned j = 0; j < 16; ++j) { const unsigned c = xb_ld(&bar[XB_XCNT(j)]); sum += c; cnt += (c > 0u) ? 1u : 0u; mine = (j == x) ? c : mine; }
        if (sum == G) break;
        __builtin_amdgcn_s_sleep(1);
        if ((++sp & 255u) == 0u) { if (xb_ld(&bar[XB_TMO])) break; if (sp > XB_SPIN_CAP) { atomicAdd(&bar[XB_TMO], 1u); break; } }
    }
    nloc = mine > 0u ? mine : 1u; nx = cnt > 0u ? cnt : 1u;
}

__device__ __forceinline__ void xcd_barrier(const XcdBarrier& b) {
    asm volatile("s_waitcnt vmcnt(0)" ::: "memory");
    __syncthreads();
    if (threadIdx.x == 0) {
        unsigned* bar = b.bar;
        __builtin_amdgcn_s_waitcnt(0);
        unsigned nloc = b.st[0], nx = b.st[1];
        if (nloc == 0u) { xcd_barrier_complete(bar, b.x, nloc, nx); b.st[0] = nloc; b.st[1] = nx; }
        const unsigned old = xb_add(&bar[XB_XSUB(b.x)], 1u);
        const unsigned gen = old / nloc;
        if (old + 1u == (gen + 1u) * nloc) {
            __builtin_amdgcn_fence(__ATOMIC_RELEASE, "agent");
            asm volatile("s_waitcnt vmcnt(0)" ::: "memory");
            const unsigned og = xb_add(&bar[XB_TOP], 1u);
            const unsigned tg = og / nx;
            if (og + 1u == (tg + 1u) * nx) xb_add(&bar[XB_TOPGEN], 1u);
            else XB_SPIN(xb_ld(&bar[XB_TOPGEN]) == tg, bar);
            __builtin_amdgcn_fence(__ATOMIC_ACQUIRE, "agent");
            xb_add(&bar[XB_XGEN(b.x)], 1u);
            asm volatile("s_waitcnt vmcnt(0)" ::: "memory");
        } else {
            XB_SPIN(xb_ld(&bar[XB_XGEN(b.x)]) == gen, bar);
            __builtin_amdgcn_fence(__ATOMIC_ACQUIRE, "agent");
            asm volatile("s_waitcnt vmcnt(0)" ::: "memory");
        }
    }
    __syncthreads();
}

typedef unsigned short u16_t;
__device__ __forceinline__ int iclamp(int v, int lo, int hi) { return min(max(v, lo), hi); }
__device__ __forceinline__ float max3f(float a, float b, float c) { float r; asm("v_max3_f32 %0, %1, %2, %3" : "=v"(r) : "v"(a), "v"(b), "v"(c)); return r; }
template <bool NA>
__device__ __forceinline__ void attn_unit(LAS unsigned char* lds, const bf16_t* Qsrc, const bf16_t* Ksrc, const bf16_t* Vsrc, const float* rpb, bf16_t* O, int b, int h, int ub) {
    constexpr int DK = NA ? 64 : 96, ND0 = DK / 16, KP = NA ? 144 : 208, VP = 144;
    constexpr int QPITCH = NA ? 2048 : 768, KPITCH = NA ? 2048 : 768, VPITCH = NA ? 2048 : 512;
    constexpr int KB_BYTES = 13312, ABUF = 22528, BIAS_OFF = 2 * ABUF;
    constexpr float THR = 8.0f;
    int tid = threadIdx.x; asm volatile("" : "+v"(tid));
    const int lane = tid & 63, wave = __builtin_amdgcn_readfirstlane(tid >> 6), r32 = lane & 31, hi = lane >> 5;
    const size_t tok0 = (size_t)b * SEQ;
    int qgr = 0, qc = 0, rs_w = 0, t_lo = 0, t_hi = 64; size_t qtok;
    if (NA) { const int r0 = ub * 4; qgr = r0 + (wave >> 1); qc = 32 * (wave & 1) + r32; qtok = tok0 + qgr * 64 + qc;
        rs_w = iclamp(qgr - 4, 0, 56); t_lo = iclamp(r0 - 4, 0, 56); t_hi = iclamp(r0 - 1, 0, 56) + 8; }
    else { qtok = tok0 + ub * 256 + wave * 32 + r32; }
    bf16x8 qr[ND0];
    { const bf16_t* qp = Qsrc + qtok * QPITCH + (NA ? 64 * h : 96 * h) + 8 * hi;
#pragma unroll
      for (int d0 = 0; d0 < ND0; ++d0) qr[d0] = *(const bf16x8*)(qp + 16 * d0); }
    const bf16_t* kg0; const bf16_t* kg1 = nullptr; int lk0, lk1 = 0;
    if (NA) { const int key = tid >> 3, ch = tid & 7; kg0 = Ksrc + (tok0 + key) * KPITCH + 512 + 64 * h + 8 * ch; lk0 = key * KP + 16 * ch; }
    else { const int key0 = tid / 12, ch0 = tid % 12; kg0 = Ksrc + (tok0 + key0) * KPITCH + 96 * h + 8 * ch0; lk0 = key0 * KP + 16 * ch0;
        const int c1 = 512 + (tid & 255), key1 = c1 / 12, ch1 = c1 % 12; kg1 = Ksrc + (tok0 + key1) * KPITCH + 96 * h + 8 * ch1; lk1 = key1 * KP + 16 * ch1; }
    const bool two = !NA && tid < 256;
    const bf16_t* vg = Vsrc + (tok0 + lane) * VPITCH + (NA ? 1024 + 64 * h : 64 * h) + 8 * wave;
    const int pos = (lane & ~12) | ((lane & 4) << 1) | ((lane & 8) >> 1);
    const int lv = KB_BYTES + (8 * wave) * VP + pos * 2;
    const int ka = r32 * KP + 16 * hi, va = KB_BYTES + r32 * VP + 16 * hi;
    if (NA) { if (tid < 465) ((LAS float*)(lds + BIAS_OFF))[tid] = rpb[h * 465 + tid] * LOG2E; }
    u32x4 rk0, rk1 = (u32x4){0u, 0u, 0u, 0u}, rv;
#define AT_LOAD(t) do { rk0 = *(const u32x4*)(kg0 + (size_t)(t) * 64 * KPITCH); if (two) rk1 = *(const u32x4*)(kg1 + (size_t)(t) * 64 * KPITCH); rv = *(const u32x4*)(vg + (size_t)(t) * 64 * VPITCH); } while (0)
#define AT_STORE(buf) do { LAS unsigned char* B_ = lds + (buf) * ABUF; *(LAS u32x4*)(B_ + lk0) = rk0; if (two) *(LAS u32x4*)(B_ + lk1) = rk1; \
        LAS unsigned char* V_ = B_ + lv; \
        *(LAS u16_t*)(V_ + 0 * VP) = (u16_t)(rv.x & 0xffffu); *(LAS u16_t*)(V_ + 1 * VP) = (u16_t)(rv.x >> 16); *(LAS u16_t*)(V_ + 2 * VP) = (u16_t)(rv.y & 0xffffu); *(LAS u16_t*)(V_ + 3 * VP) = (u16_t)(rv.y >> 16); \
        *(LAS u16_t*)(V_ + 4 * VP) = (u16_t)(rv.z & 0xffffu); *(LAS u16_t*)(V_ + 5 * VP) = (u16_t)(rv.z >> 16); *(LAS u16_t*)(V_ + 6 * VP) = (u16_t)(rv.w & 0xffffu); *(LAS u16_t*)(V_ + 7 * VP) = (u16_t)(rv.w >> 16); } while (0)
#ifndef ATT_PRIO
#define ATT_PRIO 1
#endif
#if ATT_PRIO
    if (!NA) { if (wave < 4) __builtin_amdgcn_s_setprio(2); else __builtin_amdgcn_s_setprio(0); }
#endif
    float mx = 0.f, l = 0.f; f32x16 o0, o1, negm;
#pragma unroll
    for (int r = 0; r < 16; ++r) { o0[r] = 0.f; o1[r] = 0.f; negm[r] = 0.f; }
    AT_LOAD(t_lo); AT_STORE(0);
    __syncthreads();
#pragma unroll 1
    for (int t = t_lo; t < t_hi; ++t) {
        const int buf = (t - t_lo) & 1;
        if (t + 1 < t_hi) AT_LOAD(t + 1);
        const bool active = NA ? (t >= rs_w && t < rs_w + 8) : true;
        if (active) {
            LAS unsigned char* B = lds + buf * ABUF;
            bf16x8 kf[2 * ND0], vf[8];
#pragma unroll
            for (int d0 = 0; d0 < ND0; ++d0) { kf[2 * d0] = *(const LAS bf16x8*)(B + ka + 32 * d0); kf[2 * d0 + 1] = *(const LAS bf16x8*)(B + ka + 32 * KP + 32 * d0); }
#pragma unroll
            for (int ks = 0; ks < 4; ++ks) { vf[2 * ks] = *(const LAS bf16x8*)(B + va + 32 * ks); vf[2 * ks + 1] = *(const LAS bf16x8*)(B + va + 32 * VP + 32 * ks); }
            __builtin_amdgcn_sched_barrier(0);
            f32x16 p0, p1;
            if (NA) {
#pragma unroll
                for (int r = 0; r < 16; ++r) { p0[r] = 0.f; p1[r] = 0.f; }
            } else { p0 = negm; p1 = negm; }
#pragma unroll
            for (int d0 = 0; d0 < ND0; ++d0) { p0 = __builtin_amdgcn_mfma_f32_32x32x16_bf16(kf[2 * d0], qr[d0], p0, 0, 0, 0); p1 = __builtin_amdgcn_mfma_f32_32x32x16_bf16(kf[2 * d0 + 1], qr[d0], p1, 0, 0, 0); }
            if (NA) {
                const int ws = iclamp(qc - 8, 0, 48); const LAS float* bt = (const LAS float*)(lds + BIAS_OFF) + (t - qgr + 7) * 31;
                constexpr float C = 0.125f * LOG2E;
#pragma unroll
                for (int r = 0; r < 16; ++r) { const int kc0 = (r & 3) + 8 * (r >> 2) + 4 * hi, kc1 = kc0 + 32;
                    const int d0_ = kc0 - qc + 15, d1_ = kc1 - qc + 15;
                    const bool v0 = (kc0 >= ws) && (kc0 < ws + 16), v1 = (kc1 >= ws) && (kc1 < ws + 16);
                    const float b0 = bt[iclamp(d0_, 0, 30)] - mx, b1 = bt[iclamp(d1_, 0, 30)] - mx;
                    p0[r] = v0 ? fmaf(p0[r], C, b0) : -1e30f; p1[r] = v1 ? fmaf(p1[r], C, b1) : -1e30f; }
            }
            float mt = max3f(p0[0], p0[1], p1[0]);
            mt = max3f(mt, p1[1], p0[2]);
#pragma unroll
            for (int r = 3; r < 16; r += 1) mt = max3f(mt, p0[r], p1[r - 1]);
            mt = fmaxf(mt, p1[15]);
            mt = fmaxf(mt, __shfl_xor(mt, 32));
            const bool first = (t == (NA ? rs_w : t_lo));
            if (first || __any(mt > THR)) {
                const float dl = first ? mt : fmaxf(mt, 0.f); const float al = first ? 1.0f : __builtin_amdgcn_exp2f(-dl); mx += dl; l *= al;
#pragma unroll
                for (int r = 0; r < 16; ++r) { o0[r] *= al; o1[r] *= al; p0[r] -= dl; p1[r] -= dl; }
                if (!NA) {
#pragma unroll
                    for (int r = 0; r < 16; ++r) negm[r] = -mx;
                }
            }
            f32x2 ls2 = (f32x2){0.f, 0.f};
#pragma unroll
            for (int r = 0; r < 16; r += 2) { p0[r] = __builtin_amdgcn_exp2f(p0[r]); p0[r + 1] = __builtin_amdgcn_exp2f(p0[r + 1]); p1[r] = __builtin_amdgcn_exp2f(p1[r]); p1[r + 1] = __builtin_amdgcn_exp2f(p1[r + 1]);
                ls2 += (f32x2){p0[r], p0[r + 1]}; ls2 += (f32x2){p1[r], p1[r + 1]}; }
            l += ls2.x + ls2.y;
            u32x4 pf[4];
#pragma unroll
            for (int s = 0; s < 2; ++s) {
                pf[s] = (u32x4){pk(p0[8 * s], p0[8 * s + 1]), pk(p0[8 * s + 2], p0[8 * s + 3]), pk(p0[8 * s + 4], p0[8 * s + 5]), pk(p0[8 * s + 6], p0[8 * s + 7])};
                pf[2 + s] = (u32x4){pk(p1[8 * s], p1[8 * s + 1]), pk(p1[8 * s + 2], p1[8 * s + 3]), pk(p1[8 * s + 4], p1[8 * s + 5]), pk(p1[8 * s + 6], p1[8 * s + 7])};
            }
#pragma unroll
            for (int ks = 0; ks < 4; ++ks) {
                const bf16x8 pb = __builtin_bit_cast(bf16x8, pf[ks]);
                o0 = __builtin_amdgcn_mfma_f32_32x32x16_bf16(vf[2 * ks], pb, o0, 0, 0, 0); o1 = __builtin_amdgcn_mfma_f32_32x32x16_bf16(vf[2 * ks + 1], pb, o1, 0, 0, 0);
            }
        }
        if (t + 1 < t_hi) AT_STORE(buf ^ 1);
        __syncthreads();
    }
#undef AT_LOAD
#undef AT_STORE
#if ATT_PRIO
    if (!NA) __builtin_amdgcn_s_setprio(0);
#endif
    l += __shfl_xor(l, 32);
    const float inv = 1.0f / l;
    bf16_t* op = O + qtok * 1024 + (NA ? 64 * h : 512 + 64 * h) + 4 * hi;
#pragma unroll
    for (int g = 0; g < 4; ++g) {
        u32x2 w0; w0.x = pk(o0[4 * g] * inv, o0[4 * g + 1] * inv); w0.y = pk(o0[4 * g + 2] * inv, o0[4 * g + 3] * inv);
        u32x2 w1; w1.x = pk(o1[4 * g] * inv, o1[4 * g + 1] * inv); w1.y = pk(o1[4 * g + 2] * inv, o1[4 * g + 3] * inv);
        *(u32x2*)(op + 8 * g) = w0; *(u32x2*)(op + 32 + 8 * g) = w1;
    }
}

constexpr int NPHASE = 14;
struct Args { const float* in[20]; float* out; unsigned char* ws; int ph_lo, ph_hi; };

__global__ void __launch_bounds__(512, 2) mk_fwd(Args a) {
    extern __shared__ __attribute__((aligned(16))) unsigned char lds_raw[];
    LAS unsigned char* lds = (LAS unsigned char*)lds_raw;
    cg::grid_group grid = cg::this_grid();
    const int G = gridDim.x, bx = blockIdx.x, NGW = G * 8;
#define TIDS int tid = threadIdx.x; asm volatile("" : "+v"(tid)); const int lane = tid & 63, wave = __builtin_amdgcn_readfirstlane(tid >> 6), gw = bx * 8 + wave; (void)lane; (void)gw
#define PTRS GAS unsigned char* ws = (GAS unsigned char*)a.ws; asm volatile("" : "+s"(ws)); const float* x = a.in[0]; float* out = a.out; f32x2* cs = (f32x2*)(ws + WS_CS); bf16_t* Wgu1 = (bf16_t*)(ws + WS_WGU1); bf16_t* Wd1 = (bf16_t*)(ws + WS_WD1); bf16_t* Win = (bf16_t*)(ws + WS_WIN); bf16_t* Wuq = (bf16_t*)(ws + WS_WUQ); bf16_t* Wukv = (bf16_t*)(ws + WS_WUKV); bf16_t* Wout = (bf16_t*)(ws + WS_WOUT); bf16_t* Wgu2 = (bf16_t*)(ws + WS_WGU2); bf16_t* Wd2 = (bf16_t*)(ws + WS_WD2); bf16_t* XN = (bf16_t*)(ws + WS_XN); bf16_t* Fb = (bf16_t*)(ws + WS_F); bf16_t* Hb = (bf16_t*)(ws + WS_H); bf16_t* Zb = (bf16_t*)(ws + WS_H); bf16_t* Qm = (bf16_t*)(ws + WS_QM); bf16_t* Km = (bf16_t*)(ws + WS_KM); bf16_t* Vm = (bf16_t*)(ws + WS_VM); bf16_t* CQN = (bf16_t*)(ws + WS_CQN); bf16_t* CKVN = (bf16_t*)(ws + WS_CKVN); (void)x; (void)out; (void)cs; (void)Wgu1; (void)Wd1; (void)Win; (void)Wuq; (void)Wukv; (void)Wout; (void)Wgu2; (void)Wd2; (void)XN; (void)Fb; (void)Hb; (void)Zb; (void)Qm; (void)Km; (void)Vm; (void)CQN; (void)CKVN
    const int lo = a.ph_lo, hi = a.ph_hi;
#ifndef GEMM_REP
#define GEMM_REP 1
#endif
#ifndef PH_MASK
#define PH_MASK 0x3fff
#endif
#define IN(k) ((((PH_MASK) >> (k)) & 1) && lo <= (k) && (k) < hi)
    volatile LAS unsigned* bst = (volatile LAS unsigned*)(lds + 131072 + 64);
    if (threadIdx.x < 2) bst[threadIdx.x] = 0u;
    __syncthreads();
    unsigned* barw = (unsigned*)(a.ws + WS_BAR);
    XcdBarrier bar; bar.bar = barw; bar.x = 0; bar.st = bst;
#define SEAM(k) do { if (IN(k) && IN((k) + 1)) { if ((k) == 0) { grid.sync(); bar = xcd_barrier_post(barw, bst); } else xcd_barrier(bar); } } while (0)
    using SO = pg8::StaticOrder;

    if (IN(0)) { TIDS; PTRS;
        if (bx == 0) {
            const int pos = tid >> 3, f = tid & 7;
            const float inv = 1.0f / powf(10000.0f, (float)f * 0.125f);
            const float ang = (float)pos * inv;
            const float k = rintf(ang * 0.15915494309189535f);
            float r = fmaf(-k, 6.2831854820251465f, ang); r = fmaf(-k, -1.7484555e-7f, r);
            cs[tid] = (f32x2){__cosf(r), __sinf(r)};
        }
        if (bx == 0) for (int i = tid; i < XCD_BAR_WORDS; i += 512) barw[i] = 0u;
        LAS float* scr = (LAS float*)(lds + wave * 16384);
        constexpr int I_GU = 16 * 176, I_D = 44 * 32, I_IN = 16 * 61, I_UQ = 4 * 24, I_UKV = 2 * 32, I_OUT = 16 * 32;
        constexpr int NITEMS = 2 * I_GU + 2 * I_D + I_IN + I_UQ + I_UKV + I_OUT;
        for (int it = gw; it < NITEMS; it += NGW) {
            int r = it;
            if (r < I_GU) { const int kb = r / 176, nb = r % 176; transpose_item(a.in[2], D, NGU, Wgu1, 64 * kb, 32 * nb, remap_gu(32 * nb), scr, lane); continue; } r -= I_GU;
            if (r < I_GU) { const int kb = r / 176, nb = r % 176; transpose_item(a.in[17], D, NGU, Wgu2, 64 * kb, 32 * nb, remap_gu(32 * nb), scr, lane); continue; } r -= I_GU;
            if (r < I_D) { const int kb = r / 32, nb = r % 32; transpose_item(a.in[3], FF, D, Wd1, 64 * kb, 32 * nb, 32 * nb, scr, lane); continue; } r -= I_D;
            if (r < I_D) { const int kb = r / 32, nb = r % 32; transpose_item(a.in[18], FF, D, Wd2, 64 * kb, 32 * nb, 32 * nb, scr, lane); continue; } r -= I_D;
            if (r < I_IN) { const int kb = r / 61, nb = r % 61; transpose_item(a.in[6], D, DIN, Win, 64 * kb, 32 * nb, 32 * nb, scr, lane); continue; } r -= I_IN;
            if (r < I_UQ) { const int kb = r / 24, nb = r % 24; transpose_item(a.in[9], 256, 768, Wuq, 64 * kb, 32 * nb, 32 * nb, scr, lane); continue; } r -= I_UQ;
            if (r < I_UKV) { const int kb = r / 32, nb = r % 32; transpose_item(a.in[11], 128, 1024, Wukv, 64 * kb, 32 * nb, remap_kv(32 * nb), scr, lane); continue; } r -= I_UKV;
            { const int kb = r / 32, nb = r % 32; transpose_item(a.in[14], D, D, Wout, 64 * kb, 32 * nb, 32 * nb, scr, lane); }
        }
        for (int i = bx * 512 + tid; i < (DINP - DIN) * D / 8; i += G * 512) ((u32x4*)(Win + (size_t)DIN * D))[i] = (u32x4){0u, 0u, 0u, 0u};
        for (int m = gw; m < M; m += NGW) row_norm_to_bf16(x + (size_t)m * D, a.in[1], XN + (size_t)m * D, lane);
    }
    SEAM(0);
    if (IN(1)) { PTRS; pg8::Gemm g{XN, Wgu1, M, NGU, D}; SO S; S.init(M, NGU, G, bx); EpiSwiGLU E{Hb, FF};
        for (int rep_ = 0; rep_ < GEMM_REP; ++rep_) pg8::gemm_phase<EpiSwiGLU, SO, true, true>(lds, g, S, E); }
    SEAM(1);
    if (IN(2)) { PTRS; pg8::Gemm g{Hb, Wd1, M, D, FF}; SO S; S.init(M, D, G, bx); pg8::EpiBf16<0> E{Fb, D, nullptr, 0, 0, 1.f};
        for (int rep_ = 0; rep_ < GEMM_REP; ++rep_) pg8::gemm_phase<pg8::EpiBf16<0>, SO, true, true>(lds, g, S, E); }
    SEAM(2);
    if (IN(3)) { TIDS; PTRS; for (int m = gw; m < M; m += NGW) row_mid<true>(Fb + (size_t)m * D, x + (size_t)m * D, out + (size_t)m * D, a.in[4], 0.5f, a.in[5], XN + (size_t)m * D, lane); }
    SEAM(3);
    if (IN(4)) { PTRS; pg8::Gemm g{XN, Win, M, DINP, D}; SO S; S.init(M, DINP, G, bx); pg8::EpiBf16<0> E{Zb, DINP, nullptr, 0, 0, 1.f};
        for (int rep_ = 0; rep_ < GEMM_REP; ++rep_) pg8::gemm_phase<pg8::EpiBf16<0>, SO, true, true>(lds, g, S, E); }
    SEAM(4);
    if (IN(5)) { TIDS; PTRS; for (int m = gw; m < M; m += NGW) mla_prep_row(Zb + (size_t)m * DINP, m, a.in[8], a.in[10], cs, CQN, CKVN, Km, lane); }
    SEAM(5);
    if (IN(6)) { PTRS;
        { pg8::Gemm g{CQN, Wuq, M, 768, 256}; SO S; S.init(M, 768, G, bx); EpiQ E{Qm, cs}; for (int rep_ = 0; rep_ < GEMM_REP; ++rep_) pg8::gemm_phase<EpiQ, SO, true, true>(lds, g, S, E); }
        { pg8::Gemm g{CKVN, Wukv, M, 1024, 128}; SO S; S.init(M, 1024, G, bx); EpiKV E{Km, Vm}; for (int rep_ = 0; rep_ < GEMM_REP; ++rep_) pg8::gemm_phase<EpiKV, SO, true, true>(lds, g, S, E); }
    }
    SEAM(6);
    if (IN(7)) { PTRS;
#ifndef NA_NAIVE
#define NA_NAIVE 0
#endif
#ifndef MLA_NAIVE
#define MLA_NAIVE 0
#endif
#if NA_NAIVE
        for (int u = bx; u < 512; u += G) na_naive(Zb, a.in[7], XN, u);
#else
#ifndef NA_REP
#define NA_REP 1
#endif
#ifndef MLA_REP
#define MLA_REP 1
#endif
        for (int rep = 0; rep < NA_REP; ++rep) for (int u = bx; u < 1024; u += G) { const int idx = (u >> 8) * 32 + ((u >> 3) & 31), bh = (u & 7) * 8 + (idx >> 4); attn_unit<true>(lds, Zb, Zb, Zb, a.in[7], XN, bh >> 3, bh & 7, idx & 15); }
#endif
#if MLA_NAIVE
        for (int u = bx; u < 512; u += G) mla_naive(lds, Qm, Km, Vm, XN, u);
#else
        for (int rep = 0; rep < MLA_REP; ++rep) for (int u = bx; u < 1024; u += G) { const int idx = (u >> 8) * 32 + ((u >> 3) & 31), bh = (u & 7) * 8 + (idx >> 4); attn_unit<false>(lds, Qm, Km, Vm, nullptr, XN, bh >> 3, bh & 7, idx & 15); }
#endif
    }
    SEAM(7);
    if (IN(8)) { TIDS; PTRS; for (int m = gw; m < M; m += NGW) row_onorm(XN + (size_t)m * D, a.in[12], a.in[13], lane); }
    SEAM(8);
    if (IN(9)) { PTRS; pg8::Gemm g{XN, Wout, M, D, D}; SO S; S.init(M, D, G, bx); pg8::EpiBf16<0> E{Fb, D, nullptr, 0, 0, 1.f};
        for (int rep_ = 0; rep_ < GEMM_REP; ++rep_) pg8::gemm_phase<pg8::EpiBf16<0>, SO, true, true>(lds, g, S, E); }
    SEAM(9);
    if (IN(10)) { TIDS; PTRS; for (int m = gw; m < M; m += NGW) row_mid<true>(Fb + (size_t)m * D, out + (size_t)m * D, out + (size_t)m * D, a.in[15], 1.0f, a.in[16], XN + (size_t)m * D, lane); }
    SEAM(10);
    if (IN(11)) { PTRS; pg8::Gemm g{XN, Wgu2, M, NGU, D}; SO S; S.init(M, NGU, G, bx); EpiSwiGLU E{Hb, FF};
        for (int rep_ = 0; rep_ < GEMM_REP; ++rep_) pg8::gemm_phase<EpiSwiGLU, SO, true, true>(lds, g, S, E); }
    SEAM(11);
    if (IN(12)) { PTRS; pg8::Gemm g{Hb, Wd2, M, D, FF}; SO S; S.init(M, D, G, bx); pg8::EpiBf16<0> E{Fb, D, nullptr, 0, 0, 1.f};
        for (int rep_ = 0; rep_ < GEMM_REP; ++rep_) pg8::gemm_phase<pg8::EpiBf16<0>, SO, true, true>(lds, g, S, E); }
    SEAM(12);
    if (IN(13)) { TIDS; PTRS; for (int m = gw; m < M; m += NGW) row_mid<false>(Fb + (size_t)m * D, out + (size_t)m * D, out + (size_t)m * D, a.in[19], 0.5f, nullptr, nullptr, lane); }
#undef IN
#undef SEAM
}
}

#ifndef MK_MULTI
#define MK_MULTI 0
#endif
extern "C" void kernel_launch(void* const* d_in, const int* in_sizes, int n_in, void* d_out, int out_size, void* d_ws, size_t ws_size, hipStream_t stream) {
    static int grid = 0;
    if (grid == 0) {
        if (n_in != 20 || out_size != mk::M * mk::D || ws_size < mk::WS_END) { fprintf(stderr, "kernel_launch: unexpected shapes (n_in %d out %d ws %zu)\n", n_in, out_size, ws_size); grid = -1; return; }
        int dev = 0, cus = 0, per_cu = 0;
        (void)hipGetDevice(&dev); (void)hipDeviceGetAttribute(&cus, hipDeviceAttributeMultiprocessorCount, dev);
        if (hipFuncSetAttribute((const void*)mk::mk_fwd, hipFuncAttributeMaxDynamicSharedMemorySize, mk::LDS_BYTES) != hipSuccess) { fprintf(stderr, "kernel_launch: hipFuncSetAttribute failed\n"); grid = -1; return; }
        if (hipOccupancyMaxActiveBlocksPerMultiprocessor(&per_cu, (const void*)mk::mk_fwd, 512, mk::LDS_BYTES) != hipSuccess || per_cu < 1) { fprintf(stderr, "kernel_launch: occupancy query says %d\n", per_cu); grid = -1; (void)hipGetLastError(); return; }
        grid = cus;
    }
    if (grid < 0) return;
    mk::Args a{};
    for (int i = 0; i < 20; ++i) a.in[i] = (const float*)d_in[i];
    a.out = (float*)d_out; a.ws = (unsigned char*)d_ws;
#if MK_MULTI
    for (int ph = 0; ph < mk::NPHASE; ++ph) { a.ph_lo = ph; a.ph_hi = ph + 1; hipLaunchKernelGGL(mk::mk_fwd, dim3(grid), dim3(512), mk::LDS_BYTES, stream, a); }
#else
    a.ph_lo = 0; a.ph_hi = mk::NPHASE;
    void* args[] = {&a};
    hipError_t e = hipLaunchCooperativeKernel((const void*)mk::mk_fwd, dim3(grid), dim3(512), args, mk::LDS_BYTES, stream);
    if (e != hipSuccess) fprintf(stderr, "kernel_launch: cooperative launch failed: %s\n", hipGetErrorString(e));
#endif
}
```

```cpp
#include <hip/hip_runtime.h>
#include <hip/hip_cooperative_groups.h>
#include <cstdio>
namespace cg = cooperative_groups;
#include <cstdint>
namespace pg8 {
#define PG8_LAS __attribute__((address_space(3)))
typedef unsigned short bf16_t;
typedef short bf16x8 __attribute__((ext_vector_type(8)));
typedef float f32x4 __attribute__((ext_vector_type(4)));
typedef unsigned u32x4 __attribute__((ext_vector_type(4)));
constexpr int BM = 256, BK = 64, HALF = 128, HTB = HALF * BK * 2  , STAGE_BYTES = 8 * HTB, NXCD = 8, WGM = 8;

__host__ __device__ __forceinline__ int lds_byte(int r, int c) { const int st = (r >> 4) * 2 + (c >> 5), rr = r & 15, cc = c & 31, ob = rr * 64 + cc * 2; return st * 1024 + (ob ^ (((ob >> 9) & 1) << 5)); }
__host__ __device__ __forceinline__ void stage_rc(int b, int& R, int& C) { const int st = b / 1024, sb = b % 1024, swz = sb ^ (((sb >> 9) & 1) << 5); R = (st >> 1) * 16 + swz / 64; C = (st & 1) * 32 + (swz % 64) / 2; }
__host__ __device__ __forceinline__ int perm32(int rho) { const int n = rho >> 4, i = rho & 15; return 8 * (i >> 2) + 4 * n + (i & 3); }

struct Unit { int pm, pn; };
struct Gemm { const bf16_t* A; const bf16_t* Bt; int M, N, K; };

struct StaticOrder {
    int nM, nN, nwg, G, c;
    __host__ __device__ void init(int M, int N, int G_, int c_) { nM = M / BM; nN = N / BM; nwg = nM * nN; G = G_; c = c_; }
    __host__ __device__ bool next(int i, Unit& u) const {
        const long L = (long)i * G + c; if (L >= nwg) return false;
        int wgid = (int)L; { const int q = nwg / NXCD, r = nwg % NXCD, xcd = wgid % NXCD, off = wgid / NXCD; wgid = (xcd < r ? xcd * (q + 1) : r * (q + 1) + (xcd - r) * q) + off; }
        const int nig = WGM * nN, gid = wgid / nig, fm = gid * WGM, gsz = (nM - fm) < WGM ? (nM - fm) : WGM;
        u.pm = fm + ((wgid % nig) % gsz); u.pn = (wgid % nig) / gsz; return true;
    }
    __device__ __forceinline__ void a_ready(const Unit&) const {}
    __device__ __forceinline__ void done(const Unit&) const {}
};

__device__ __forceinline__ unsigned cvt_pk_bf16(float lo, float hi) { unsigned r; asm volatile("v_cvt_pk_bf16_f32 %0, %1, %2" : "=v"(r) : "v"(lo), "v"(hi)); return r; }
typedef float f32x2 __attribute__((ext_vector_type(2)));
__device__ __forceinline__ f32x2 gelu_pk(f32x2 v) {
    const f32x2 av = __builtin_elementwise_abs(v), d = av * 0.2316418882f + 1.0f;
    f32x2 t; t.x = __builtin_amdgcn_rcpf(d.x); t.y = __builtin_amdgcn_rcpf(d.y);
    f32x2 q = t * 0.5307027145f + (-0.7265760135f); q = q * t + 0.7107068705f; q = q * t + (-0.142248368f); q = q * t + 0.127414796f; q = q * t;
    const f32x2 s = (v * v) * (-0.72134752044f);
    f32x2 e; e.x = __builtin_amdgcn_exp2f(s.x); e.y = __builtin_amdgcn_exp2f(s.y);
    const f32x2 m = v * (q * e), r = v - m;
    f32x2 o; o.x = v.x < 0.f ? m.x : r.x; o.y = v.y < 0.f ? m.y : r.y; return o;
}

template <int ACT  > struct EpiBf16 {
    static constexpr bool PERM = true, AFTER_DRAIN = false; static_assert(ACT == 0 || ACT == 1, "EpiBf16: ACT is 0 (none) or 1 (gelu_pk)");
    bf16_t* O; int ldc; const float* bias; int split_cols; size_t split_stride; float scale0;
    __device__ __forceinline__ void operator()(const f32x4 (&acc)[2][2][4][2], const Unit& u, int wr, int wc, int fr, int fq) const {
        const int row0 = u.pm * BM + wr * 64 + fr; int colt = u.pn * BM; bf16_t* base = O;
        float sc = 1.f; if (split_cols) { const int t = colt / split_cols; base += (size_t)t * split_stride; colt -= t * split_cols; if (t == 0) sc = scale0; }
        const int col0 = colt + wc * 32 + 8 * fq, bcol0 = u.pn * BM + wc * 32 + 8 * fq;
        f32x4 bv[2][2];
#pragma unroll
        for (int bj = 0; bj < 2; ++bj)
#pragma unroll
            for (int n = 0; n < 2; ++n) bv[bj][n] = bias ? *(const f32x4*)(bias + bcol0 + bj * HALF + 4 * n) : (f32x4){0.f, 0.f, 0.f, 0.f};
#pragma unroll
        for (int ai = 0; ai < 2; ++ai)
#pragma unroll
            for (int m = 0; m < 4; ++m) { bf16_t* rowp = base + (size_t)(row0 + ai * HALF + m * 16) * ldc + col0;
#pragma unroll
                for (int bj = 0; bj < 2; ++bj) { f32x4 v0 = acc[ai][bj][m][0] + bv[bj][0], v1 = acc[ai][bj][m][1] + bv[bj][1];
                    if (ACT == 1) { f32x2 a = gelu_pk((f32x2){v0[0], v0[1]}), b = gelu_pk((f32x2){v0[2], v0[3]}), c = gelu_pk((f32x2){v1[0], v1[1]}), d = gelu_pk((f32x2){v1[2], v1[3]});
                        v0 = (f32x4){a.x, a.y, b.x, b.y}; v1 = (f32x4){c.x, c.y, d.x, d.y}; }
                    v0 = v0 * sc; v1 = v1 * sc; u32x4 w; w.x = cvt_pk_bf16(v0[0], v0[1]); w.y = cvt_pk_bf16(v0[2], v0[3]); w.z = cvt_pk_bf16(v1[0], v1[1]); w.w = cvt_pk_bf16(v1[2], v1[3]);
                    *(u32x4*)(rowp + bj * HALF) = w; } }
    }
};

struct PanelStats {
    unsigned* xbuf;
    unsigned* cnt;
    unsigned* tmo;
    int ntn; float eps;
    unsigned code;
    __device__ __forceinline__ bool run(const f32x4 (&v)[2][2][4][2], const Unit& u, int wr, int wc, int fr, int fq, PG8_LAS unsigned char* lds, int wid, int lane) const {
        typedef float f32x2v __attribute__((ext_vector_type(2)));
        PG8_LAS f32x2v* P = (PG8_LAS f32x2v*)lds;
        PG8_LAS f32x2v* S = (PG8_LAS f32x2v*)(lds + 8192);
        PG8_LAS unsigned* flag = (PG8_LAS unsigned*)(lds + 8192 + 2048);
#pragma unroll
        for (int ai = 0; ai < 2; ++ai)
#pragma unroll
            for (int m = 0; m < 4; ++m) {
                float s = 0.f;
#pragma unroll
                for (int bj = 0; bj < 2; ++bj)
#pragma unroll
                    for (int n = 0; n < 2; ++n) { const f32x4 x = v[ai][bj][m][n]; s += (x[0] + x[1]) + (x[2] + x[3]); }
                s += __shfl_xor(s, 16); s += __shfl_xor(s, 32);
                const float mw = s * (1.0f / 64.0f); float q = 0.f;
#pragma unroll
                for (int bj = 0; bj < 2; ++bj)
#pragma unroll
                    for (int n = 0; n < 2; ++n) { const f32x4 d = v[ai][bj][m][n] - mw; q += (d[0] * d[0] + d[1] * d[1]) + (d[2] * d[2] + d[3] * d[3]); }
                q += __shfl_xor(q, 16); q += __shfl_xor(q, 32);
                if (fq == 0) P[(ai * HALF + wr * 64 + m * 16 + fr) * 4 + wc] = (f32x2v){mw, q};
            }
        asm volatile("s_waitcnt lgkmcnt(0)" ::: "memory"); __builtin_amdgcn_s_barrier(); asm volatile("" ::: "memory");
#if defined(BROKEN_EXCHANGE_NO_WAIT)
#warning BROKEN CONTROL BUILD: the row-statistics exchange does not wait; results are wrong by design
        if (blockIdx.x >= 64) { const long long t0_ = clock64(); while (clock64() - t0_ < 60000) __builtin_amdgcn_s_sleep(8); }
#endif
        const int row = wid * 32 + (lane & 31);
        if (lane < 32) {
            const f32x2v a = P[row * 4 + 0], b = P[row * 4 + 1], c = P[row * 4 + 2], d = P[row * 4 + 3];
            const float mt = (a.x + b.x + c.x + d.x) * 0.25f;
            const float da = a.x - mt, db = b.x - mt, dc = c.x - mt, dd = d.x - mt;
            const float m2 = (a.y + b.y) + (c.y + d.y) + 64.0f * ((da * da + db * db) + (dc * dc + dd * dd));
            unsigned long long* slot = (unsigned long long*)xbuf + ((size_t)(u.pm * BM + row) * 4 + u.pn);
            __hip_atomic_store(slot, ((unsigned long long)__float_as_uint(m2) << 32) | __float_as_uint(mt), __ATOMIC_RELAXED, __HIP_MEMORY_SCOPE_AGENT);
        }
        asm volatile("s_waitcnt vmcnt(0)" ::: "memory");
        if (lane == 0) __hip_atomic_fetch_add(cnt + 64 * u.pm, 1u, __ATOMIC_RELAXED, __HIP_MEMORY_SCOPE_AGENT);
        if (wid == 0) {
            bool dead = false; const unsigned long long t0 = __builtin_amdgcn_s_memrealtime(); const unsigned want = 8u * (unsigned)ntn;
            for (;;) {
#if defined(BROKEN_EXCHANGE_NO_WAIT)
                break;
#endif
                if ((unsigned)__builtin_amdgcn_readfirstlane(__hip_atomic_load(cnt + 64 * u.pm, __ATOMIC_RELAXED, __HIP_MEMORY_SCOPE_AGENT)) >= want) break;
                if (__builtin_amdgcn_s_memrealtime() - t0 > 2000000ull) {
                    if (lane == 0) { unsigned expect = 0u; __hip_atomic_compare_exchange_strong(tmo + 1, &expect, code | (unsigned)(u.pm & 0xff), __ATOMIC_RELAXED, __ATOMIC_RELAXED, __HIP_MEMORY_SCOPE_AGENT);
                                     __hip_atomic_store(tmo, 1u, __ATOMIC_RELAXED, __HIP_MEMORY_SCOPE_AGENT); }
                    dead = true; break; }
                __builtin_amdgcn_s_sleep(2);
            }
            __builtin_amdgcn_fence(__ATOMIC_ACQUIRE, "agent");
            if (lane == 0) flag[0] = dead ? 1u : 0u;
        }
        asm volatile("s_waitcnt vmcnt(0) lgkmcnt(0)" ::: "memory"); __builtin_amdgcn_s_barrier(); asm volatile("" ::: "memory");
        const bool bad = flag[0] != 0u;
        if (lane < 32) {
            const unsigned long long* slot = (const unsigned long long*)xbuf + (size_t)(u.pm * BM + row) * 4; float mt[4], m2[4]; float ms = 0.f;
#pragma unroll
            for (int t = 0; t < 4; ++t) { if (t < ntn) { const unsigned long long w = __hip_atomic_load(slot + t, __ATOMIC_RELAXED, __HIP_MEMORY_SCOPE_AGENT); mt[t] = __uint_as_float((unsigned)w); m2[t] = __uint_as_float((unsigned)(w >> 32)); } else { mt[t] = 0.f; m2[t] = 0.f; } ms += mt[t]; }
            const float mean = ms / (float)ntn; float q = 0.f;
#pragma unroll
            for (int t = 0; t < 4; ++t) if (t < ntn) { const float dm = mt[t] - mean; q += m2[t] + 256.0f * dm * dm; }
            S[row] = (f32x2v){mean, 1.0f / sqrtf(q / (256.0f * (float)ntn) + eps)};
        }
        asm volatile("s_waitcnt lgkmcnt(0)" ::: "memory"); __builtin_amdgcn_s_barrier(); asm volatile("" ::: "memory");
        return bad;
    }
};
struct EpiLnRes {
    static constexpr bool PERM = false, AFTER_DRAIN = true;
    const float* base; float* out; int ldc; const float* bias; PanelStats st; unsigned poison;
    __device__ __forceinline__ void fused(f32x4 (&acc)[2][2][4][2], const Unit& u, int wr, int wc, int fr, int fq, PG8_LAS unsigned char* lds, int wid, int lane) const {
        typedef float f32x2v __attribute__((ext_vector_type(2)));
        const PG8_LAS f32x2v* S = (const PG8_LAS f32x2v*)(lds + 8192);
        const int col0 = u.pn * BM + wc * 32 + 4 * fq;
#pragma unroll
        for (int bj = 0; bj < 2; ++bj)
#pragma unroll
            for (int n = 0; n < 2; ++n) { const f32x4 bv = bias ? *(const f32x4*)(bias + col0 + bj * HALF + n * 16) : (f32x4){0.f, 0.f, 0.f, 0.f};
#pragma unroll
                for (int ai = 0; ai < 2; ++ai)
#pragma unroll
                    for (int m = 0; m < 4; ++m) acc[ai][bj][m][n] += bv; }
        f32x4 pre[4][2][2];
#pragma unroll
        for (int m = 0; m < 4; ++m) { const size_t off = (size_t)(u.pm * BM + wr * 64 + m * 16 + fr) * ldc + col0;
#pragma unroll
            for (int bj = 0; bj < 2; ++bj)
#pragma unroll
                for (int n = 0; n < 2; ++n) pre[m][bj][n] = *(const f32x4*)(base + off + bj * HALF + n * 16); }
        const bool bad = st.run(acc, u, wr, wc, fr, fq, lds, wid, lane) || poison != 0u;
        const float qnan = __builtin_nanf("");
#pragma unroll
        for (int ai = 0; ai < 2; ++ai)
#pragma unroll
            for (int m = 0; m < 4; ++m) { const int r = ai * HALF + wr * 64 + m * 16 + fr; const f32x2v sr = S[r]; const size_t off = (size_t)(u.pm * BM + r) * ldc + col0;
#pragma unroll
                for (int bj = 0; bj < 2; ++bj)
#pragma unroll
                    for (int n = 0; n < 2; ++n) { const f32x4 bs = ai == 0 ? pre[m][bj][n] : *(const f32x4*)(base + off + bj * HALF + n * 16); f32x4 o = bs + (acc[ai][bj][m][n] - sr.x) * sr.y;
                        if (bad) o = (f32x4){qnan, qnan, qnan, qnan}; *(f32x4*)(out + off + bj * HALF + n * 16) = o; }
                if (m & 1) asm volatile("" ::: "memory"); }
    }
};
struct EpiLnResLn {
    static constexpr bool PERM = false, AFTER_DRAIN = true;
    const float* base; float* out; bf16_t* xn; int ldc; const float* bias; PanelStats st1, st2; unsigned poison;
    __device__ __forceinline__ void fused(f32x4 (&acc)[2][2][4][2], const Unit& u, int wr, int wc, int fr, int fq, PG8_LAS unsigned char* lds, int wid, int lane) const {
        typedef float f32x2v __attribute__((ext_vector_type(2))); typedef unsigned u32x2v __attribute__((ext_vector_type(2)));
        const PG8_LAS f32x2v* S = (const PG8_LAS f32x2v*)(lds + 8192);
        const int col0 = u.pn * BM + wc * 32 + 4 * fq;
#pragma unroll
        for (int bj = 0; bj < 2; ++bj)
#pragma unroll
            for (int n = 0; n < 2; ++n) { const f32x4 bv = bias ? *(const f32x4*)(bias + col0 + bj * HALF + n * 16) : (f32x4){0.f, 0.f, 0.f, 0.f};
#pragma unroll
                for (int ai = 0; ai < 2; ++ai)
#pragma unroll
                    for (int m = 0; m < 4; ++m) acc[ai][bj][m][n] += bv; }
        bool bad = st1.run(acc, u, wr, wc, fr, fq, lds, wid, lane) || poison != 0u;
        const float qnan = __builtin_nanf("");
#pragma unroll
        for (int ai = 0; ai < 2; ++ai)
#pragma unroll
            for (int m = 0; m < 4; ++m) { const int r = ai * HALF + wr * 64 + m * 16 + fr; const f32x2v sr = S[r]; const size_t off = (size_t)(u.pm * BM + r) * ldc + col0;
#pragma unroll
                for (int bj = 0; bj < 2; ++bj)
#pragma unroll
                    for (int n = 0; n < 2; ++n) { const f32x4 bs = *(const f32x4*)(base + off + bj * HALF + n * 16); acc[ai][bj][m][n] = bs + (acc[ai][bj][m][n] - sr.x) * sr.y; }
                asm volatile("" : "+v"(acc[ai][0][m][0]), "+v"(acc[ai][0][m][1]), "+v"(acc[ai][1][m][0]), "+v"(acc[ai][1][m][1]));
                if (m & 1) asm volatile("" ::: "memory"); }
        const bool bad1 = bad;
        bad = st2.run(acc, u, wr, wc, fr, fq, lds, wid, lane) || bad;
#pragma unroll
        for (int ai = 0; ai < 2; ++ai)
#pragma unroll
            for (int m = 0; m < 4; ++m) { const int r = ai * HALF + wr * 64 + m * 16 + fr; const f32x2v sr = S[r]; const size_t off = (size_t)(u.pm * BM + r) * ldc + col0;
#pragma unroll
                for (int bj = 0; bj < 2; ++bj)
#pragma unroll
                    for (int n = 0; n < 2; ++n) { const f32x4 x1 = acc[ai][bj][m][n]; *(f32x4*)(out + off + bj * HALF + n * 16) = bad1 ? (f32x4){qnan, qnan, qnan, qnan} : x1;
                        const f32x4 o = (x1 - sr.x) * sr.y; u32x2v w; w.x = cvt_pk_bf16(o[0], o[1]); w.y = cvt_pk_bf16(o[2], o[3]);
                        if (bad) { w.x = 0x7fc07fc0u; w.y = 0x7fc07fc0u; } *(u32x2v*)(xn + off + bj * HALF + n * 16) = w; }
                asm volatile("" ::: "memory"); }
    }
};

template <class Epi, class Sched, bool ALIGN_EPI = false, bool SP2 = false>
__device__ __forceinline__ void gemm_phase(PG8_LAS unsigned char* lds, const Gemm g, const Sched& S, const Epi& E) {
    int tid_ = threadIdx.x; asm volatile("" : "+v"(tid_));
    const int tid = tid_, wid = __builtin_amdgcn_readfirstlane(tid >> 6), lane = tid & 63, wr = wid >> 2, wc = wid & 3, fr = lane & 15, fq = lane >> 4;
    int K_ = g.K; asm volatile("" : "+s"(K_)); const int K = K_, nt = K / BK;
    unsigned voffA[2], voffB[2];
#pragma unroll
    for (int i = 0; i < 2; ++i) { int R, C; stage_rc(tid * 16 + i * 8192, R, C); const int Rb = Epi::PERM ? ((R & ~31) + perm32(R & 31)) : R;
        voffA[i] = (unsigned)(R * K + C) * 2u; voffB[i] = (unsigned)(Rb * K + C) * 2u; }
    const size_t kstep = (size_t)(BK * 2);
    const size_t hstep = (size_t)HALF * K * 2;
    const size_t tstep = 2 * hstep;
    const unsigned ldsw = (unsigned)wid * 1024u;
    const int aoff = lds_byte(wr * 64 + fr, fq * 8), boff = lds_byte(wc * 32 + fr, fq * 8);
#define PG8_SA(b, h) (((b) * 2 + (h)) * HTB)
#define PG8_SB(b, h) ((4 + (b) * 2 + (h)) * HTB)
#define PG8_STAGE(bufoff, gbase, voff) do { _Pragma("unroll") for (int _i = 0; _i < 2; ++_i) \
        __builtin_amdgcn_global_load_lds((const unsigned*)((const char*)(gbase) + (voff)[_i]), (PG8_LAS unsigned*)(lds + (bufoff) + ldsw + _i * 8192), 16, 0, 0); } while (0)
#define PG8_LDA(dst, b, h) do { _Pragma("unroll") for (int m = 0; m < 4; ++m) _Pragma("unroll") for (int k = 0; k < 2; ++k) dst[m][k] = *(const PG8_LAS bf16x8*)(lds + PG8_SA(b, h) + aoff + m * 2048 + k * 1024); } while (0)
#define PG8_LDB(dst, b, h) do { _Pragma("unroll") for (int n = 0; n < 2; ++n) _Pragma("unroll") for (int k = 0; k < 2; ++k) dst[n][k] = *(const PG8_LAS bf16x8*)(lds + PG8_SB(b, h) + boff + n * 2048 + k * 1024); } while (0)
#define PG8_MMA(ai, bj, At, Bt) do { __builtin_amdgcn_s_setprio(1); _Pragma("unroll") for (int m = 0; m < 4; ++m) _Pragma("unroll") for (int n = 0; n < 2; ++n) _Pragma("unroll") for (int k = 0; k < 2; ++k) \
        acc[ai][bj][m][n] = __builtin_amdgcn_mfma_f32_16x16x32_bf16(Bt[n][k], At[m][k], acc[ai][bj][m][n], 0, 0, 0); __builtin_amdgcn_s_setprio(0); } while (0)
#define PG8_WAIT_V(n) asm volatile("s_waitcnt vmcnt(" #n ")" ::: "memory")
#define PG8_WAIT_L(n) asm volatile("s_waitcnt lgkmcnt(" #n ")" ::: "memory")
#define PG8_BAR __builtin_amdgcn_s_barrier()
#define PG8_SCHED __builtin_amdgcn_sched_barrier(0)
    Unit cur, nxt; int ui = 0;
    if (!S.next(0, cur)) return;
    f32x4 acc[2][2][4][2];
#pragma unroll
    for (int a = 0; a < 2; ++a)
#pragma unroll
        for (int b = 0; b < 2; ++b)
#pragma unroll
            for (int m = 0; m < 4; ++m)
#pragma unroll
                for (int n = 0; n < 2; ++n) acc[a][b][m][n] = (f32x4){0.f, 0.f, 0.f, 0.f};
    bf16x8 At[4][2], B0[2][2], B1[2][2];
    const char* cA = (const char*)g.A + (size_t)cur.pm * tstep; const char* cB = (const char*)g.Bt + (size_t)cur.pn * tstep;
    S.a_ready(cur);
    if constexpr (SP2) {
        PG8_STAGE(PG8_SB(0, 0), cB, voffB); PG8_STAGE(PG8_SB(0, 1), cB + hstep, voffB); PG8_STAGE(PG8_SA(0, 0), cA, voffA); PG8_STAGE(PG8_SA(0, 1), cA + hstep, voffA);
        if (wr == 1) PG8_BAR;
        PG8_WAIT_V(2); PG8_BAR;
        PG8_STAGE(PG8_SB(1, 0), cB + kstep, voffB); PG8_STAGE(PG8_SA(1, 0), cA + kstep, voffA); PG8_STAGE(PG8_SB(1, 1), cB + hstep + kstep, voffB);
        PG8_WAIT_V(6); PG8_BAR;
    } else {
        PG8_STAGE(PG8_SB(0, 0), cB, voffB); PG8_STAGE(PG8_SA(0, 0), cA, voffA); PG8_STAGE(PG8_SB(0, 1), cB + hstep, voffB); PG8_STAGE(PG8_SA(0, 1), cA + hstep, voffA);
        if (wr == 1) PG8_BAR;
        PG8_WAIT_V(4); PG8_BAR;
        PG8_STAGE(PG8_SB(1, 0), cB + kstep, voffB); PG8_STAGE(PG8_SA(1, 0), cA + kstep, voffA); PG8_STAGE(PG8_SB(1, 1), cB + hstep + kstep, voffB);
        PG8_WAIT_V(6); PG8_BAR;
    }
    for (;;) {
        const bool has_next = S.next(ui + 1, nxt);
        const char* nA = has_next ? (const char*)g.A + (size_t)nxt.pm * tstep : cA; const char* nB = has_next ? (const char*)g.Bt + (size_t)nxt.pn * tstep : cB;
        for (int t = 0; t < nt; t += 2) {
            const bool last = (t == nt - 2);
            const char* a1 = cA + (size_t)(t + 1) * kstep;
            const char* a2 = last ? nA : cA + (size_t)(t + 2) * kstep; const char* b2 = last ? nB : cB + (size_t)(t + 2) * kstep;
            const char* a3 = a2 + kstep; const char* b3 = b2 + kstep;
            if (last && has_next) S.a_ready(nxt);
            if constexpr (SP2) {
            PG8_LDB(B0, 0, 0); PG8_LDB(B1, 0, 1); PG8_SCHED; PG8_LDA(At, 0, 0); PG8_STAGE(PG8_SA(1, 1), a1 + hstep, voffA);
            PG8_WAIT_V(8); PG8_WAIT_L(0); PG8_BAR; PG8_MMA(0, 0, At, B0); PG8_MMA(0, 1, At, B1); PG8_BAR; PG8_SCHED;
            PG8_LDA(At, 0, 1); PG8_STAGE(PG8_SB(0, 0), b2, voffB); PG8_STAGE(PG8_SB(0, 1), b2 + hstep, voffB); PG8_STAGE(PG8_SA(0, 0), a2, voffA);
            PG8_WAIT_V(8); PG8_WAIT_L(0); PG8_BAR; PG8_MMA(1, 0, At, B0); PG8_MMA(1, 1, At, B1); PG8_BAR; PG8_SCHED;
            PG8_LDB(B0, 1, 0); PG8_LDB(B1, 1, 1); PG8_SCHED; PG8_LDA(At, 1, 0); PG8_STAGE(PG8_SA(0, 1), a2 + hstep, voffA);
            PG8_WAIT_V(8); PG8_WAIT_L(0); PG8_BAR; PG8_MMA(0, 0, At, B0); PG8_MMA(0, 1, At, B1); PG8_BAR; PG8_SCHED;
            PG8_LDA(At, 1, 1); PG8_STAGE(PG8_SB(1, 0), b3, voffB); PG8_STAGE(PG8_SB(1, 1), b3 + hstep, voffB); PG8_STAGE(PG8_SA(1, 0), a3, voffA);
            PG8_WAIT_V(8); PG8_WAIT_L(0); PG8_BAR; PG8_MMA(1, 0, At, B0); PG8_MMA(1, 1, At, B1); PG8_BAR; PG8_SCHED;
            } else {
            PG8_LDB(B0, 0, 0); PG8_SCHED; PG8_LDA(At, 0, 0); PG8_STAGE(PG8_SA(1, 1), a1 + hstep, voffA);
            PG8_WAIT_L(8); PG8_BAR; PG8_WAIT_L(0); PG8_MMA(0, 0, At, B0); PG8_BAR; PG8_SCHED;
            PG8_LDB(B1, 0, 1); PG8_STAGE(PG8_SB(0, 0), b2, voffB);
            PG8_BAR; PG8_WAIT_L(0); PG8_MMA(0, 1, At, B1); PG8_BAR;
            PG8_LDA(At, 0, 1); PG8_STAGE(PG8_SA(0, 0), a2, voffA);
            PG8_BAR; PG8_WAIT_L(0); PG8_MMA(1, 0, At, B0); PG8_BAR; PG8_SCHED;
            PG8_STAGE(PG8_SB(0, 1), b2 + hstep, voffB);
            PG8_WAIT_V(6); PG8_BAR; PG8_MMA(1, 1, At, B1); PG8_BAR;
            PG8_LDB(B0, 1, 0); PG8_SCHED; PG8_LDA(At, 1, 0); PG8_STAGE(PG8_SA(0, 1), a2 + hstep, voffA);
            PG8_WAIT_L(8); PG8_BAR; PG8_WAIT_L(0); PG8_MMA(0, 0, At, B0); PG8_BAR; PG8_SCHED;
            PG8_LDB(B1, 1, 1); PG8_STAGE(PG8_SB(1, 0), b3, voffB);
            PG8_BAR; PG8_WAIT_L(0); PG8_MMA(0, 1, At, B1); PG8_BAR;
            PG8_LDA(At, 1, 1); PG8_STAGE(PG8_SA(1, 0), a3, voffA);
            PG8_BAR; PG8_WAIT_L(0); PG8_MMA(1, 0, At, B0); PG8_BAR; PG8_SCHED;
            PG8_STAGE(PG8_SB(1, 1), b3 + hstep, voffB);
            PG8_WAIT_V(6); PG8_BAR; PG8_MMA(1, 1, At, B1); PG8_BAR;
            }
        }
        if constexpr (ALIGN_EPI) { if (wr == 0) PG8_BAR; }
        if constexpr (!Epi::AFTER_DRAIN) { E(acc, cur, wr, wc, fr, fq); S.done(cur); }
        if (!has_next) break;
#pragma unroll
        for (int a = 0; a < 2; ++a)
#pragma unroll
            for (int b = 0; b < 2; ++b)
#pragma unroll
                for (int m = 0; m < 4; ++m)
#pragma unroll
                    for (int n = 0; n < 2; ++n) acc[a][b][m][n] = (f32x4){0.f, 0.f, 0.f, 0.f};
        cur = nxt; cA = nA; cB = nB; ++ui;
        if constexpr (ALIGN_EPI) { if (wr == 1) PG8_BAR; }
    }
    PG8_WAIT_V(0);
    if constexpr (!ALIGN_EPI) { if (wr == 0) PG8_BAR; }
    PG8_BAR;
    if constexpr (Epi::AFTER_DRAIN) { E.fused(acc, cur, wr, wc, fr, fq, lds, wid, lane); S.done(cur); }
#undef PG8_SA
#undef PG8_SB
#undef PG8_STAGE
#undef PG8_LDA
#undef PG8_LDB
#undef PG8_MMA
#undef PG8_WAIT_V
#undef PG8_WAIT_L
#undef PG8_BAR
#undef PG8_SCHED
}
}

#ifndef PG8_SP2
#define PG8_SP2 true
#endif
#ifndef PG8_ALIGN
#define PG8_ALIGN true
#endif

namespace mk {
using pg8::bf16_t; using pg8::f32x4; using pg8::u32x4; using pg8::Unit; using pg8::BM; using pg8::HALF; using pg8::bf16x8;
#define LAS __attribute__((address_space(3)))
#define GAS __attribute__((address_space(1)))
typedef unsigned u32x2 __attribute__((ext_vector_type(2)));
typedef float f32x2 __attribute__((ext_vector_type(2)));
typedef float f32x16 __attribute__((ext_vector_type(16)));

constexpr int M = 32768, D = 1024, FF = 2816, NGU = 5632, DIN = 1952, DINP = 2048, SEQ = 4096;
constexpr float EPS = 1e-6f;
constexpr float LOG2E = 1.4426950408889634f;
constexpr float QSCALE = 0.10206207261596577f * 1.4426950408889634f;

constexpr size_t MiB = 1u << 20;
constexpr size_t WS_CS = 0;
constexpr size_t WS_BAR = 65536;
constexpr size_t WS_WGU1 = 1 * MiB, WS_WD1 = 12 * MiB, WS_WIN = 18 * MiB, WS_WUQ = 22 * MiB, WS_WUKV = 22 * MiB + 512 * 1024,
                 WS_WOUT = 23 * MiB, WS_WGU2 = 25 * MiB, WS_WD2 = 36 * MiB;
constexpr size_t WS_XN = 49 * MiB;
constexpr size_t WS_F = 113 * MiB;
constexpr size_t WS_KM = 113 * MiB;
constexpr size_t WS_CQN = 161 * MiB;
constexpr size_t WS_H = 177 * MiB;
constexpr size_t WS_QM = 305 * MiB;
constexpr size_t WS_VM = 353 * MiB;
constexpr size_t WS_CKVN = 385 * MiB;
constexpr size_t WS_HB = 393 * MiB;
constexpr size_t WS_END = 457 * MiB;

constexpr int LDS_BYTES = 147456;

__device__ __forceinline__ float bf_lo(unsigned w) { return __uint_as_float(w << 16); }
__device__ __forceinline__ float bf_hi(unsigned w) { return __uint_as_float(w & 0xffff0000u); }
__device__ __forceinline__ unsigned pk(float lo, float hi) { return pg8::cvt_pk_bf16(lo, hi); }
__device__ __forceinline__ float wave_sum(float v) {
#pragma unroll
    for (int o = 1; o < 64; o <<= 1) v += __shfl_xor(v, o);
    return v;
}
__device__ __forceinline__ float dot4(f32x4 a) { return (a[0] * a[0] + a[1] * a[1]) + (a[2] * a[2] + a[3] * a[3]); }

struct EpiSwiGLU {
    static constexpr bool PERM = true, AFTER_DRAIN = false;
    bf16_t* O; int ldc;
    __device__ __forceinline__ void operator()(const f32x4 (&acc)[2][2][4][2], const Unit& u, int wr, int wc, int fr, int fq) const {
        const int row0 = u.pm * BM + wr * 64 + fr; const int col0 = u.pn * 128 + wc * 32 + 8 * fq;
#pragma unroll
        for (int ai = 0; ai < 2; ++ai)
#pragma unroll
            for (int m = 0; m < 4; ++m) {
                bf16_t* rowp = O + (size_t)(row0 + ai * HALF + m * 16) * ldc + col0;
                float r[8];
#pragma unroll
                for (int n = 0; n < 2; ++n)
#pragma unroll
                    for (int j = 0; j < 4; ++j) { const float g = acc[ai][0][m][n][j], up = acc[ai][1][m][n][j];
                        const float e = __builtin_amdgcn_exp2f(-g * LOG2E); r[4 * n + j] = g * __builtin_amdgcn_rcpf(1.0f + e) * up; }
                u32x4 w; w.x = pk(r[0], r[1]); w.y = pk(r[2], r[3]); w.z = pk(r[4], r[5]); w.w = pk(r[6], r[7]);
                *(u32x4*)rowp = w;
            }
    }
};
struct EpiKV {
    static constexpr bool PERM = true, AFTER_DRAIN = false;
    bf16_t* Km; bf16_t* Vm;
    __device__ __forceinline__ void operator()(const f32x4 (&acc)[2][2][4][2], const Unit& u, int wr, int wc, int fr, int fq) const {
        const int row0 = u.pm * BM + wr * 64 + fr;
#pragma unroll
        for (int bj = 0; bj < 2; ++bj) {
            const int colt = u.pn * BM + bj * HALF + wc * 32 + 8 * fq;
            bf16_t* base; int ld;
            if (colt < 512) { base = Km + 96 * (colt >> 6) + (colt & 63); ld = 768; } else { base = Vm + (colt - 512); ld = 512; }
#pragma unroll
            for (int ai = 0; ai < 2; ++ai)
#pragma unroll
                for (int m = 0; m < 4; ++m) { const f32x4 v0 = acc[ai][bj][m][0], v1 = acc[ai][bj][m][1];
                    u32x4 w; w.x = pk(v0[0], v0[1]); w.y = pk(v0[2], v0[3]); w.z = pk(v1[0], v1[1]); w.w = pk(v1[2], v1[3]);
                    *(u32x4*)(base + (size_t)(row0 + ai * HALF + m * 16) * ld) = w; }
        }
    }
};
struct EpiQ {
    static constexpr bool PERM = false, AFTER_DRAIN = false;
    bf16_t* O; const f32x2* cs;
    __device__ __forceinline__ void operator()(const f32x4 (&acc)[2][2][4][2], const Unit& u, int wr, int wc, int fr, int fq) const {
        const int row0 = u.pm * BM + wr * 64 + fr;
#pragma unroll
        for (int bj = 0; bj < 2; ++bj) {
            const int g32 = u.pn * 8 + bj * 4 + wc; const bool rot = (g32 % 3) == 2; const int cbase = g32 * 32 + 4 * fq;
#pragma unroll
            for (int ai = 0; ai < 2; ++ai)
#pragma unroll
                for (int m = 0; m < 4; ++m) {
                    const int row = row0 + ai * HALF + m * 16;
                    f32x4 x0 = acc[ai][bj][m][0], x1 = acc[ai][bj][m][1];
                    if (rot) { const int t = row & (SEQ - 1); const int pos = (fq < 2) ? (t >> 6) : (t & 63); const f32x2* cp = cs + pos * 8 + 4 * (fq & 1);
                        f32x4 y0, y1;
#pragma unroll
                        for (int j = 0; j < 4; ++j) { const f32x2 c = cp[j]; y0[j] = x0[j] * c.x - x1[j] * c.y; y1[j] = x1[j] * c.x + x0[j] * c.y; }
                        x0 = y0; x1 = y1; }
                    x0 = x0 * QSCALE; x1 = x1 * QSCALE;
                    bf16_t* p = O + (size_t)row * 768 + cbase;
                    u32x2 w0; w0.x = pk(x0[0], x0[1]); w0.y = pk(x0[2], x0[3]); u32x2 w1; w1.x = pk(x1[0], x1[1]); w1.y = pk(x1[2], x1[3]);
                    *(u32x2*)p = w0; *(u32x2*)(p + 16) = w1;
                    asm volatile("" ::: "memory");
                }
        }
    }
};

template <int NR>
__device__ __forceinline__ void rows_norm_to_bf16(const float* X, const float* g, bf16_t* O, int m, int rs, int lane) {
    f32x4 v[NR][4]; float s[NR];
#pragma unroll
    for (int r = 0; r < NR; ++r) { const f32x4* xr = (const f32x4*)(X + (size_t)(m + r * rs) * D) + lane;
#pragma unroll
        for (int j = 0; j < 4; ++j) v[r][j] = xr[64 * j]; }
#pragma unroll
    for (int r = 0; r < NR; ++r) { s[r] = 0.f;
#pragma unroll
        for (int j = 0; j < 4; ++j) s[r] += dot4(v[r][j]); }
#pragma unroll
    for (int r = 0; r < NR; ++r) { const float rstd = 1.0f / sqrtf(wave_sum(s[r]) * (1.0f / D) + EPS);
#pragma unroll
        for (int j = 0; j < 4; ++j) { const f32x4 o = v[r][j] * rstd * ((const f32x4*)g)[lane + 64 * j]; u32x2 w; w.x = pk(o[0], o[1]); w.y = pk(o[2], o[3]); ((u32x2*)(O + (size_t)(m + r * rs) * D))[lane + 64 * j] = w; } }
}
template <int NR, bool WRITE_XN, bool RES_BF, bool OUT_BF>
__device__ __forceinline__ void rows_mid(const bf16_t* F, const void* RES, void* OUT, const float* gpost, float coef, const float* gpre, bf16_t* XNo, int m, int rs, int lane) {
    u32x2 fw[NR][4]; f32x4 rr[NR][4]; u32x2 rw[NR][4];
#pragma unroll
    for (int r = 0; r < NR; ++r) { const size_t ro = (size_t)(m + r * rs) * D;
#pragma unroll
        for (int j = 0; j < 4; ++j) { fw[r][j] = ((const u32x2*)(F + ro))[lane + 64 * j];
            if (RES_BF) rw[r][j] = ((const u32x2*)((const bf16_t*)RES + ro))[lane + 64 * j];
            else rr[r][j] = ((const f32x4*)((const float*)RES + ro))[lane + 64 * j]; } }
#pragma unroll
    for (int r = 0; r < NR; ++r) { const size_t ro = (size_t)(m + r * rs) * D;
        f32x4 f[4]; float s = 0.f;
#pragma unroll
        for (int j = 0; j < 4; ++j) { const u32x2 w = fw[r][j]; f[j] = (f32x4){bf_lo(w.x), bf_hi(w.x), bf_lo(w.y), bf_hi(w.y)}; s += dot4(f[j]); }
        const float rstd = 1.0f / sqrtf(wave_sum(s) * (1.0f / D) + EPS) * coef;
        float s2 = 0.f;
#pragma unroll
        for (int j = 0; j < 4; ++j) { const f32x4 gp = ((const f32x4*)gpost)[lane + 64 * j];
            const f32x4 res = RES_BF ? (f32x4){bf_lo(rw[r][j].x), bf_hi(rw[r][j].x), bf_lo(rw[r][j].y), bf_hi(rw[r][j].y)} : rr[r][j];
            f[j] = res + f[j] * rstd * gp;
            if (OUT_BF) { u32x2 w; w.x = pk(f[j][0], f[j][1]); w.y = pk(f[j][2], f[j][3]); ((u32x2*)((bf16_t*)OUT + ro))[lane + 64 * j] = w; } else ((f32x4*)((float*)OUT + ro))[lane + 64 * j] = f[j];
            s2 += dot4(f[j]); }
        if (WRITE_XN) {
            const float rstd2 = 1.0f / sqrtf(wave_sum(s2) * (1.0f / D) + EPS);
#pragma unroll
            for (int j = 0; j < 4; ++j) { const f32x4 o = f[j] * rstd2 * ((const f32x4*)gpre)[lane + 64 * j]; u32x2 w; w.x = pk(o[0], o[1]); w.y = pk(o[2], o[3]); ((u32x2*)(XNo + ro))[lane + 64 * j] = w; }
        }
    }
}
template <int NR>
__device__ __forceinline__ void rows_onorm(bf16_t* O, const float* gna, const float* gmla, int m, int rs, int lane) {
    u32x2 fw[NR][4];
#pragma unroll
    for (int r = 0; r < NR; ++r)
#pragma unroll
        for (int j = 0; j < 4; ++j) fw[r][j] = ((const u32x2*)(O + (size_t)(m + r * rs) * D))[lane + 64 * j];
#pragma unroll
    for (int r = 0; r < NR; ++r) { f32x4 f[4]; float sa = 0.f, sb = 0.f;
#pragma unroll
        for (int j = 0; j < 4; ++j) { const u32x2 w = fw[r][j]; f[j] = (f32x4){bf_lo(w.x), bf_hi(w.x), bf_lo(w.y), bf_hi(w.y)}; if (j < 2) sa += dot4(f[j]); else sb += dot4(f[j]); }
        const float ra = 1.0f / sqrtf(wave_sum(sa) * (1.0f / 512.0f) + EPS), rb = 1.0f / sqrtf(wave_sum(sb) * (1.0f / 512.0f) + EPS);
#pragma unroll
        for (int j = 0; j < 4; ++j) { const f32x4 g = (j < 2) ? ((const f32x4*)gna)[lane + 64 * j] : ((const f32x4*)gmla)[lane + 64 * (j - 2)];
            const f32x4 o = f[j] * ((j < 2) ? ra : rb) * g; u32x2 w; w.x = pk(o[0], o[1]); w.y = pk(o[2], o[3]); ((u32x2*)(O + (size_t)(m + r * rs) * D))[lane + 64 * j] = w; } }
}
__device__ __forceinline__ void mla_prep_row(const bf16_t* zrow, int row, const float* gq, const float* gkv, const f32x2* cs, bf16_t* cqn, bf16_t* ckvn, bf16_t* km, int lane) {
    const u32x2 wq = ((const u32x2*)(zrow + 1536))[lane];
    const float q0 = bf_lo(wq.x), q1 = bf_hi(wq.x), q2 = bf_lo(wq.y), q3 = bf_hi(wq.y);
    const float rq = 1.0f / sqrtf(wave_sum((q0 * q0 + q1 * q1) + (q2 * q2 + q3 * q3)) * (1.0f / 256.0f) + EPS);
    const unsigned wk = ((const unsigned*)(zrow + 1792))[lane];
    const float k0 = bf_lo(wk), k1 = bf_hi(wk);
    const float rk = 1.0f / sqrtf(wave_sum(k0 * k0 + k1 * k1) * (1.0f / 128.0f) + EPS);
    const f32x4 g = ((const f32x4*)gq)[lane];
    u32x2 o; o.x = pk(q0 * rq * g[0], q1 * rq * g[1]); o.y = pk(q2 * rq * g[2], q3 * rq * g[3]);
    ((u32x2*)(cqn + (size_t)row * 256))[lane] = o;
    const f32x2 g2 = ((const f32x2*)gkv)[lane];
    ((unsigned*)(ckvn + (size_t)row * 128))[lane] = pk(k0 * rk * g2.x, k1 * rk * g2.y);
    if (lane < 16) {
        const int i = lane; const float x1 = bf_lo((unsigned)zrow[1920 + i]), x2 = bf_lo((unsigned)zrow[1936 + i]);
        const int t = row & (SEQ - 1); const int pos = (i < 8) ? (t >> 6) : (t & 63); const f32x2 c = cs[pos * 8 + (i & 7)];
        const unsigned y = pk(x1 * c.x - x2 * c.y, x2 * c.x + x1 * c.y);
        bf16_t* kp = km + (size_t)row * 768 + 64 + i;
#pragma unroll
        for (int h = 0; h < 8; ++h) { kp[96 * h] = (bf16_t)(y & 0xffffu); kp[96 * h + 16] = (bf16_t)(y >> 16); }
    }
}

__device__ __forceinline__ void transpose_item(const float* W, int K, int N, bf16_t* WT, int k0, int n0, int n0_out, LAS float* scr, int lane) {
#pragma unroll 8
    for (int i = 0; i < 32; ++i) { const int kk = 2 * i + (lane >> 5); scr[kk * 33 + (lane & 31)] = W[(size_t)(k0 + kk) * N + n0 + (lane & 31)]; }
    asm volatile("s_waitcnt lgkmcnt(0)" ::: "memory");
    const int c = lane & 7;
#pragma unroll
    for (int j = 0; j < 4; ++j) { const int n = (lane >> 3) + 8 * j; const LAS float* s = scr + (8 * c) * 33 + n;
        u32x4 o; o.x = pk(s[0 * 33], s[1 * 33]); o.y = pk(s[2 * 33], s[3 * 33]); o.z = pk(s[4 * 33], s[5 * 33]); o.w = pk(s[6 * 33], s[7 * 33]);
        *(u32x4*)(WT + (size_t)(n0_out + n) * K + k0 + 8 * c) = o; }
    asm volatile("s_waitcnt lgkmcnt(0)" ::: "memory");
}
__device__ __forceinline__ int remap_gu(int n0) { if (n0 < FF) return 256 * (n0 >> 7) + (n0 & 127); const int m = n0 - FF; return 256 * (m >> 7) + 128 + (m & 127); }
__device__ __forceinline__ int remap_kv(int n0) { const int h = n0 >> 7, j = n0 & 127; return (j < 64) ? (64 * h + j) : (512 + 64 * h + (j - 64)); }
#define XB_TMO      128
#define XB_XCNT(j)  (256  + 64 * (j))
#define XB_XSUB(j)  (1280 + 64 * (j))
#define XB_XGEN(j)  (2304 + 64 * (j))
#define XB_TOP      3328
#define XB_TOPGEN   3392
#define XCD_BAR_WORDS 3456
#define XB_SPIN_CAP (1u << 18)

__device__ __forceinline__ unsigned xb_ld(unsigned* p)              { return __hip_atomic_load(p, __ATOMIC_RELAXED, __HIP_MEMORY_SCOPE_AGENT); }
__device__ __forceinline__ unsigned xb_add(unsigned* p, unsigned v) { return __hip_atomic_fetch_add(p, v, __ATOMIC_RELAXED, __HIP_MEMORY_SCOPE_AGENT); }
__device__ __forceinline__ unsigned xb_xcc_id() { return (unsigned)__builtin_amdgcn_s_getreg((3 << 11) | 20) & 0xFu; }
#define XB_SPIN(cond, bar) do { unsigned _sp = 0; while (cond) { __builtin_amdgcn_s_sleep(1); \
    if ((++_sp & 255u) == 0u) { if (xb_ld(&(bar)[XB_TMO])) break; if (_sp > XB_SPIN_CAP) { atomicAdd(&(bar)[XB_TMO], 1u); break; } } } } while (0)

struct XcdBarrier {
    unsigned* bar; unsigned x;
    volatile LAS unsigned* st;
};

__device__ __forceinline__ XcdBarrier xcd_barrier_post(unsigned* bar, volatile LAS unsigned* st) {
    XcdBarrier b; b.bar = bar; b.x = xb_xcc_id(); b.st = st;
    if (threadIdx.x == 0) (void)xb_add(&bar[XB_XCNT(b.x)], 1u);
    return b;
}
__device__ __forceinline__ void xcd_barrier_complete(unsigned* bar, unsigned x, unsigned& nloc, unsigned& nx) {
    const unsigned G = gridDim.x * gridDim.y * gridDim.z;
    unsigned sum, cnt, mine, sp = 0u;
    for (;;) {
        sum = 0u; cnt = 0u; mine = 0u;
#pragma unroll
        for (unsigned j = 0; j < 16; ++j) { const unsigned c = xb_ld(&bar[XB_XCNT(j)]); sum += c; cnt += (c > 0u) ? 1u : 0u; mine = (j == x) ? c : mine; }
        if (sum == G) break;
        __builtin_amdgcn_s_sleep(1);
        if ((++sp & 255u) == 0u) { if (xb_ld(&bar[XB_TMO])) break; if (sp > XB_SPIN_CAP) { atomicAdd(&bar[XB_TMO], 1u); break; } }
    }
    nloc = mine > 0u ? mine : 1u; nx = cnt > 0u ? cnt : 1u;
}

__device__ __forceinline__ void xcd_barrier(const XcdBarrier& b) {
    asm volatile("s_waitcnt vmcnt(0)" ::: "memory");
    __syncthreads();
    if (threadIdx.x == 0) {
        unsigned* bar = b.bar;
        __builtin_amdgcn_s_waitcnt(0);
        unsigned nloc = b.st[0], nx = b.st[1];
        if (nloc == 0u) { xcd_barrier_complete(bar, b.x, nloc, nx); b.st[0] = nloc; b.st[1] = nx; }
        const unsigned old = xb_add(&bar[XB_XSUB(b.x)], 1u);
        const unsigned gen = old / nloc;
        if (old + 1u == (gen + 1u) * nloc) {
            __builtin_amdgcn_fence(__ATOMIC_RELEASE, "agent");
            asm volatile("s_waitcnt vmcnt(0)" ::: "memory");
            const unsigned og = xb_add(&bar[XB_TOP], 1u);
            const unsigned tg = og / nx;
            if (og + 1u == (tg + 1u) * nx) xb_add(&bar[XB_TOPGEN], 1u);
            else XB_SPIN(xb_ld(&bar[XB_TOPGEN]) == tg, bar);
            __builtin_amdgcn_fence(__ATOMIC_ACQUIRE, "agent");
            xb_add(&bar[XB_XGEN(b.x)], 1u);
            asm volatile("s_waitcnt vmcnt(0)" ::: "memory");
        } else {
            XB_SPIN(xb_ld(&bar[XB_XGEN(b.x)]) == gen, bar);
            __builtin_amdgcn_fence(__ATOMIC_ACQUIRE, "agent");
            asm volatile("s_waitcnt vmcnt(0)" ::: "memory");
        }
    }
    __syncthreads();
}

typedef unsigned short u16_t;
__device__ __forceinline__ int iclamp(int v, int lo, int hi) { return min(max(v, lo), hi); }
__device__ __forceinline__ float max3f(float a, float b, float c) { float r; asm("v_max3_f32 %0, %1, %2, %3" : "=v"(r) : "v"(a), "v"(b), "v"(c)); return r; }
template <bool NA>
__device__ __forceinline__ void attn_unit(LAS unsigned char* lds, const bf16_t* Qsrc, const bf16_t* Ksrc, const bf16_t* Vsrc, const float* rpb, bf16_t* O, int b, int h, int ub) {
    constexpr int DK = NA ? 64 : 96, ND0 = DK / 16, KP = NA ? 144 : 208, VP = 144;
    constexpr int QPITCH = NA ? 2048 : 768, KPITCH = NA ? 2048 : 768, VPITCH = NA ? 2048 : 512;
    constexpr int KB_BYTES = 13312, ABUF = 22528, BIAS_OFF = 2 * ABUF;
    constexpr float THR = 8.0f;
    int tid = threadIdx.x; asm volatile("" : "+v"(tid));
    const int lane = tid & 63, wave = __builtin_amdgcn_readfirstlane(tid >> 6), r32 = lane & 31, hi = lane >> 5;
    const size_t tok0 = (size_t)b * SEQ;
    int qgr = 0, qc = 0, rs_w = 0, t_lo = 0, t_hi = 64; size_t qtok;
    if (NA) { const int r0 = ub * 4; qgr = r0 + (wave >> 1); qc = 32 * (wave & 1) + r32; qtok = tok0 + qgr * 64 + qc;
        rs_w = iclamp(qgr - 4, 0, 56); t_lo = iclamp(r0 - 4, 0, 56); t_hi = iclamp(r0 - 1, 0, 56) + 8; }
    else { qtok = tok0 + ub * 256 + wave * 32 + r32; }
    bf16x8 qr[ND0];
    { const bf16_t* qp = Qsrc + qtok * QPITCH + (NA ? 64 * h : 96 * h) + 8 * hi;
#pragma unroll
      for (int d0 = 0; d0 < ND0; ++d0) qr[d0] = *(const bf16x8*)(qp + 16 * d0); }
    const bf16_t* kg0; const bf16_t* kg1 = nullptr; int lk0, lk1 = 0;
    if (NA) { const int key = tid >> 3, ch = tid & 7; kg0 = Ksrc + (tok0 + key) * KPITCH + 512 + 64 * h + 8 * ch; lk0 = key * KP + 16 * ch; }
    else { const int key0 = tid / 12, ch0 = tid % 12; kg0 = Ksrc + (tok0 + key0) * KPITCH + 96 * h + 8 * ch0; lk0 = key0 * KP + 16 * ch0;
        const int c1 = 512 + (tid & 255), key1 = c1 / 12, ch1 = c1 % 12; kg1 = Ksrc + (tok0 + key1) * KPITCH + 96 * h + 8 * ch1; lk1 = key1 * KP + 16 * ch1; }
    const bool two = !NA && tid < 256;
    const bf16_t* vg = Vsrc + (tok0 + lane) * VPITCH + (NA ? 1024 + 64 * h : 64 * h) + 8 * wave;
    const int pos = (lane & ~12) | ((lane & 4) << 1) | ((lane & 8) >> 1);
    const int lv = KB_BYTES + (8 * wave) * VP + pos * 2;
    const int ka = r32 * KP + 16 * hi, va = KB_BYTES + r32 * VP + 16 * hi;
    if (NA) { if (tid < 465) ((LAS float*)(lds + BIAS_OFF))[tid] = rpb[h * 465 + tid] * LOG2E; }
    u32x4 rk0, rk1 = (u32x4){0u, 0u, 0u, 0u}, rv;
#define AT_LOAD(t) do { rk0 = *(const u32x4*)(kg0 + (size_t)(t) * 64 * KPITCH); if (two) rk1 = *(const u32x4*)(kg1 + (size_t)(t) * 64 * KPITCH); rv = *(const u32x4*)(vg + (size_t)(t) * 64 * VPITCH); } while (0)
#define AT_STORE(buf) do { LAS unsigned char* B_ = lds + (buf) * ABUF; *(LAS u32x4*)(B_ + lk0) = rk0; if (two) *(LAS u32x4*)(B_ + lk1) = rk1; \
        LAS unsigned char* V_ = B_ + lv; \
        *(LAS u16_t*)(V_ + 0 * VP) = (u16_t)(rv.x & 0xffffu); *(LAS u16_t*)(V_ + 1 * VP) = (u16_t)(rv.x >> 16); *(LAS u16_t*)(V_ + 2 * VP) = (u16_t)(rv.y & 0xffffu); *(LAS u16_t*)(V_ + 3 * VP) = (u16_t)(rv.y >> 16); \
        *(LAS u16_t*)(V_ + 4 * VP) = (u16_t)(rv.z & 0xffffu); *(LAS u16_t*)(V_ + 5 * VP) = (u16_t)(rv.z >> 16); *(LAS u16_t*)(V_ + 6 * VP) = (u16_t)(rv.w & 0xffffu); *(LAS u16_t*)(V_ + 7 * VP) = (u16_t)(rv.w >> 16); } while (0)
#ifndef ATT_PRIO
#define ATT_PRIO 1
#endif
#if ATT_PRIO
    if (!NA) { if (wave < 4) __builtin_amdgcn_s_setprio(2); else __builtin_amdgcn_s_setprio(0); }
#endif
    float mx = 0.f, l = 0.f; f32x16 o0, o1, negm;
#pragma unroll
    for (int r = 0; r < 16; ++r) { o0[r] = 0.f; o1[r] = 0.f; negm[r] = 0.f; }
    AT_LOAD(t_lo); AT_STORE(0);
    __syncthreads();
#pragma unroll 1
    for (int t = t_lo; t < t_hi; ++t) {
        const int buf = (t - t_lo) & 1;
        if (t + 1 < t_hi) AT_LOAD(t + 1);
        const bool active = NA ? (t >= rs_w && t < rs_w + 8) : true;
        if (active) {
            LAS unsigned char* B = lds + buf * ABUF;
            bf16x8 kf[2 * ND0], vf[8];
#pragma unroll
            for (int d0 = 0; d0 < ND0; ++d0) { kf[2 * d0] = *(const LAS bf16x8*)(B + ka + 32 * d0); kf[2 * d0 + 1] = *(const LAS bf16x8*)(B + ka + 32 * KP + 32 * d0); }
#pragma unroll
            for (int ks = 0; ks < 4; ++ks) { vf[2 * ks] = *(const LAS bf16x8*)(B + va + 32 * ks); vf[2 * ks + 1] = *(const LAS bf16x8*)(B + va + 32 * VP + 32 * ks); }
            __builtin_amdgcn_sched_barrier(0);
            f32x16 p0, p1;
            if (NA) {
#pragma unroll
                for (int r = 0; r < 16; ++r) { p0[r] = 0.f; p1[r] = 0.f; }
            } else { p0 = negm; p1 = negm; }
#pragma unroll
            for (int d0 = 0; d0 < ND0; ++d0) { p0 = __builtin_amdgcn_mfma_f32_32x32x16_bf16(kf[2 * d0], qr[d0], p0, 0, 0, 0); p1 = __builtin_amdgcn_mfma_f32_32x32x16_bf16(kf[2 * d0 + 1], qr[d0], p1, 0, 0, 0); }
            if (NA) {
                const int ws = iclamp(qc - 8, 0, 48); const LAS float* bt = (const LAS float*)(lds + BIAS_OFF) + (t - qgr + 7) * 31;
                constexpr float C = 0.125f * LOG2E;
#pragma unroll
                for (int r = 0; r < 16; ++r) { const int kc0 = (r & 3) + 8 * (r >> 2) + 4 * hi, kc1 = kc0 + 32;
                    const int d0_ = kc0 - qc + 15, d1_ = kc1 - qc + 15;
                    const bool v0 = (kc0 >= ws) && (kc0 < ws + 16), v1 = (kc1 >= ws) && (kc1 < ws + 16);
                    const float b0 = bt[iclamp(d0_, 0, 30)] - mx, b1 = bt[iclamp(d1_, 0, 30)] - mx;
                    p0[r] = v0 ? fmaf(p0[r], C, b0) : -1e30f; p1[r] = v1 ? fmaf(p1[r], C, b1) : -1e30f; }
            }
            float mt = max3f(p0[0], p0[1], p1[0]);
            mt = max3f(mt, p1[1], p0[2]);
#pragma unroll
            for (int r = 3; r < 16; r += 1) mt = max3f(mt, p0[r], p1[r - 1]);
            mt = fmaxf(mt, p1[15]);
            mt = fmaxf(mt, __shfl_xor(mt, 32));
            const bool first = (t == (NA ? rs_w : t_lo));
            if (first || __any(mt > THR)) {
                const float dl = first ? mt : fmaxf(mt, 0.f); const float al = first ? 1.0f : __builtin_amdgcn_exp2f(-dl); mx += dl; l *= al;
#pragma unroll
                for (int r = 0; r < 16; ++r) { o0[r] *= al; o1[r] *= al; p0[r] -= dl; p1[r] -= dl; }
                if (!NA) {
#pragma unroll
                    for (int r = 0; r < 16; ++r) negm[r] = -mx;
                }
            }
            f32x2 ls2 = (f32x2){0.f, 0.f};
#pragma unroll
            for (int r = 0; r < 16; r += 2) { p0[r] = __builtin_amdgcn_exp2f(p0[r]); p0[r + 1] = __builtin_amdgcn_exp2f(p0[r + 1]); p1[r] = __builtin_amdgcn_exp2f(p1[r]); p1[r + 1] = __builtin_amdgcn_exp2f(p1[r + 1]);
                ls2 += (f32x2){p0[r], p0[r + 1]}; ls2 += (f32x2){p1[r], p1[r + 1]}; }
            l += ls2.x + ls2.y;
            u32x4 pf[4];
#pragma unroll
            for (int s = 0; s < 2; ++s) {
                pf[s] = (u32x4){pk(p0[8 * s], p0[8 * s + 1]), pk(p0[8 * s + 2], p0[8 * s + 3]), pk(p0[8 * s + 4], p0[8 * s + 5]), pk(p0[8 * s + 6], p0[8 * s + 7])};
                pf[2 + s] = (u32x4){pk(p1[8 * s], p1[8 * s + 1]), pk(p1[8 * s + 2], p1[8 * s + 3]), pk(p1[8 * s + 4], p1[8 * s + 5]), pk(p1[8 * s + 6], p1[8 * s + 7])};
            }
#pragma unroll
            for (int ks = 0; ks < 4; ++ks) {
                const bf16x8 pb = __builtin_bit_cast(bf16x8, pf[ks]);
                o0 = __builtin_amdgcn_mfma_f32_32x32x16_bf16(vf[2 * ks], pb, o0, 0, 0, 0); o1 = __builtin_amdgcn_mfma_f32_32x32x16_bf16(vf[2 * ks + 1], pb, o1, 0, 0, 0);
            }
        }
        if (t + 1 < t_hi) AT_STORE(buf ^ 1);
        __syncthreads();
    }
#undef AT_LOAD
#undef AT_STORE
#if ATT_PRIO
    if (!NA) __builtin_amdgcn_s_setprio(0);
#endif
    l += __shfl_xor(l, 32);
    const float inv = 1.0f / l;
    bf16_t* op = O + qtok * 1024 + (NA ? 64 * h : 512 + 64 * h) + 4 * hi;
#pragma unroll
    for (int g = 0; g < 4; ++g) {
        u32x2 w0; w0.x = pk(o0[4 * g] * inv, o0[4 * g + 1] * inv); w0.y = pk(o0[4 * g + 2] * inv, o0[4 * g + 3] * inv);
        u32x2 w1; w1.x = pk(o1[4 * g] * inv, o1[4 * g + 1] * inv); w1.y = pk(o1[4 * g + 2] * inv, o1[4 * g + 3] * inv);
        *(u32x2*)(op + 8 * g) = w0; *(u32x2*)(op + 32 + 8 * g) = w1;
    }
}

constexpr int NPHASE = 14;
struct Args { const float* in[20]; float* out; unsigned char* ws; int ph_lo, ph_hi; };

__global__ void __launch_bounds__(512, 2) mk_fwd(Args a) {
    extern __shared__ __attribute__((aligned(16))) unsigned char lds_raw[];
    LAS unsigned char* lds = (LAS unsigned char*)lds_raw;
    cg::grid_group grid = cg::this_grid();
    const int G = gridDim.x, bx = blockIdx.x, NGW = G * 8;
#define TIDS int tid = threadIdx.x; asm volatile("" : "+v"(tid)); const int lane = tid & 63, wave = __builtin_amdgcn_readfirstlane(tid >> 6), gw = bx * 8 + wave; (void)lane; (void)gw
#define PTRS GAS unsigned char* ws = (GAS unsigned char*)a.ws; asm volatile("" : "+s"(ws)); const float* x = a.in[0]; float* out = a.out; f32x2* cs = (f32x2*)(ws + WS_CS); bf16_t* Wgu1 = (bf16_t*)(ws + WS_WGU1); bf16_t* Wd1 = (bf16_t*)(ws + WS_WD1); bf16_t* Win = (bf16_t*)(ws + WS_WIN); bf16_t* Wuq = (bf16_t*)(ws + WS_WUQ); bf16_t* Wukv = (bf16_t*)(ws + WS_WUKV); bf16_t* Wout = (bf16_t*)(ws + WS_WOUT); bf16_t* Wgu2 = (bf16_t*)(ws + WS_WGU2); bf16_t* Wd2 = (bf16_t*)(ws + WS_WD2); bf16_t* XN = (bf16_t*)(ws + WS_XN); bf16_t* Fb = (bf16_t*)(ws + WS_F); bf16_t* Hb = (bf16_t*)(ws + WS_H); bf16_t* Zb = (bf16_t*)(ws + WS_H); bf16_t* Qm = (bf16_t*)(ws + WS_QM); bf16_t* Km = (bf16_t*)(ws + WS_KM); bf16_t* Vm = (bf16_t*)(ws + WS_VM); bf16_t* CQN = (bf16_t*)(ws + WS_CQN); bf16_t* CKVN = (bf16_t*)(ws + WS_CKVN); bf16_t* HB = (bf16_t*)(ws + WS_HB); (void)x; (void)out; (void)cs; (void)Wgu1; (void)Wd1; (void)Win; (void)Wuq; (void)Wukv; (void)Wout; (void)Wgu2; (void)Wd2; (void)XN; (void)Fb; (void)Hb; (void)Zb; (void)Qm; (void)Km; (void)Vm; (void)CQN; (void)CKVN; (void)HB
    const int lo = a.ph_lo, hi = a.ph_hi;
#ifndef GEMM_REP
#define GEMM_REP 1
#endif
#ifndef PH_MASK
#define PH_MASK 0x3fff
#endif
#define IN(k) ((((PH_MASK) >> (k)) & 1) && lo <= (k) && (k) < hi)
    volatile LAS unsigned* bst = (volatile LAS unsigned*)(lds + 131072 + 64);
    if (threadIdx.x < 2) bst[threadIdx.x] = 0u;
    __syncthreads();
    unsigned* barw = (unsigned*)(a.ws + WS_BAR);
    XcdBarrier bar; bar.bar = barw; bar.x = 0; bar.st = bst;
#define SEAM(k) do { if (IN(k) && IN((k) + 1)) { if ((k) == 0) { grid.sync(); bar = xcd_barrier_post(barw, bst); } else xcd_barrier(bar); } } while (0)
    using SO = pg8::StaticOrder;

    if (IN(0)) { TIDS; PTRS;
        if (bx == 0) {
            const int pos = tid >> 3, f = tid & 7;
            const float inv = 1.0f / powf(10000.0f, (float)f * 0.125f);
            const float ang = (float)pos * inv;
            const float k = rintf(ang * 0.15915494309189535f);
            float r = fmaf(-k, 6.2831854820251465f, ang); r = fmaf(-k, -1.7484555e-7f, r);
            cs[tid] = (f32x2){__cosf(r), __sinf(r)};
        }
        if (bx == 0) for (int i = tid; i < XCD_BAR_WORDS; i += 512) barw[i] = 0u;
        LAS float* scr = (LAS float*)(lds + wave * 16384);
        constexpr int I_GU = 16 * 176, I_D = 44 * 32, I_IN = 16 * 61, I_UQ = 4 * 24, I_UKV = 2 * 32, I_OUT = 16 * 32;
        constexpr int NITEMS = 2 * I_GU + 2 * I_D + I_IN + I_UQ + I_UKV + I_OUT;
        for (int it = gw; it < NITEMS; it += NGW) {
            int r = it;
            if (r < I_GU) { const int kb = r / 176, nb = r % 176; transpose_item(a.in[2], D, NGU, Wgu1, 64 * kb, 32 * nb, remap_gu(32 * nb), scr, lane); continue; } r -= I_GU;
            if (r < I_GU) { const int kb = r / 176, nb = r % 176; transpose_item(a.in[17], D, NGU, Wgu2, 64 * kb, 32 * nb, remap_gu(32 * nb), scr, lane); continue; } r -= I_GU;
            if (r < I_D) { const int kb = r / 32, nb = r % 32; transpose_item(a.in[3], FF, D, Wd1, 64 * kb, 32 * nb, 32 * nb, scr, lane); continue; } r -= I_D;
            if (r < I_D) { const int kb = r / 32, nb = r % 32; transpose_item(a.in[18], FF, D, Wd2, 64 * kb, 32 * nb, 32 * nb, scr, lane); continue; } r -= I_D;
            if (r < I_IN) { const int kb = r / 61, nb = r % 61; transpose_item(a.in[6], D, DIN, Win, 64 * kb, 32 * nb, 32 * nb, scr, lane); continue; } r -= I_IN;
            if (r < I_UQ) { const int kb = r / 24, nb = r % 24; transpose_item(a.in[9], 256, 768, Wuq, 64 * kb, 32 * nb, 32 * nb, scr, lane); continue; } r -= I_UQ;
            if (r < I_UKV) { const int kb = r / 32, nb = r % 32; transpose_item(a.in[11], 128, 1024, Wukv, 64 * kb, 32 * nb, remap_kv(32 * nb), scr, lane); continue; } r -= I_UKV;
            { const int kb = r / 32, nb = r % 32; transpose_item(a.in[14], D, D, Wout, 64 * kb, 32 * nb, 32 * nb, scr, lane); }
        }
        for (int i = bx * 512 + tid; i < (DINP - DIN) * D / 8; i += G * 512) ((u32x4*)(Win + (size_t)DIN * D))[i] = (u32x4){0u, 0u, 0u, 0u};
        { int m = gw; for (; m + 7 * NGW < M; m += 8 * NGW) rows_norm_to_bf16<8>(x, a.in[1], XN, m, NGW, lane); for (; m < M; m += NGW) rows_norm_to_bf16<1>(x, a.in[1], XN, m, NGW, lane); }
    }
    SEAM(0);
    if (IN(1)) { PTRS; pg8::Gemm g{XN, Wgu1, M, NGU, D}; SO S; S.init(M, NGU, G, bx); EpiSwiGLU E{Hb, FF};
        for (int rep_ = 0; rep_ < GEMM_REP; ++rep_) pg8::gemm_phase<EpiSwiGLU, SO, true, true>(lds, g, S, E); }
    SEAM(1);
    if (IN(2)) { PTRS; pg8::Gemm g{Hb, Wd1, M, D, FF}; SO S; S.init(M, D, G, bx); pg8::EpiBf16<0> E{Fb, D, nullptr, 0, 0, 1.f};
        for (int rep_ = 0; rep_ < GEMM_REP; ++rep_) pg8::gemm_phase<pg8::EpiBf16<0>, SO, true, true>(lds, g, S, E); }
    SEAM(2);
    if (IN(3)) { TIDS; PTRS; { int m = gw; for (; m + 3 * NGW < M; m += 4 * NGW) rows_mid<4, true, false, true>(Fb, x, HB, a.in[4], 0.5f, a.in[5], XN, m, NGW, lane); for (; m < M; m += NGW) rows_mid<1, true, false, true>(Fb, x, HB, a.in[4], 0.5f, a.in[5], XN, m, NGW, lane); } }
    SEAM(3);
    if (IN(4)) { PTRS; pg8::Gemm g{XN, Win, M, DINP, D}; SO S; S.init(M, DINP, G, bx); pg8::EpiBf16<0> E{Zb, DINP, nullptr, 0, 0, 1.f};
        for (int rep_ = 0; rep_ < GEMM_REP; ++rep_) pg8::gemm_phase<pg8::EpiBf16<0>, SO, true, true>(lds, g, S, E); }
    SEAM(4);
    if (IN(5)) { TIDS; PTRS; for (int m = gw; m < M; m += NGW) mla_prep_row(Zb + (size_t)m * DINP, m, a.in[8], a.in[10], cs, CQN, CKVN, Km, lane); }
    SEAM(5);
    if (IN(6)) { PTRS;
        { pg8::Gemm g{CQN, Wuq, M, 768, 256}; SO S; S.init(M, 768, G, bx); EpiQ E{Qm, cs}; for (int rep_ = 0; rep_ < GEMM_REP; ++rep_) pg8::gemm_phase<EpiQ, SO, true, true>(lds, g, S, E); }
        { pg8::Gemm g{CKVN, Wukv, M, 1024, 128}; SO S; S.init(M, 1024, G, bx); EpiKV E{Km, Vm}; for (int rep_ = 0; rep_ < GEMM_REP; ++rep_) pg8::gemm_phase<EpiKV, SO, true, true>(lds, g, S, E); }
    }
    SEAM(6);
    if (IN(7)) { PTRS;
#ifndef NA_NAIVE
#define NA_NAIVE 0
#endif
#ifndef MLA_NAIVE
#define MLA_NAIVE 0
#endif
#if NA_NAIVE
        for (int u = bx; u < 512; u += G) na_naive(Zb, a.in[7], XN, u);
#else
#ifndef NA_REP
#define NA_REP 1
#endif
#ifndef MLA_REP
#define MLA_REP 1
#endif
        for (int rep = 0; rep < NA_REP; ++rep) for (int u = bx; u < 1024; u += G) { const int idx = (u >> 8) * 32 + ((u >> 3) & 31), bh = (u & 7) * 8 + (idx >> 4); attn_unit<true>(lds, Zb, Zb, Zb, a.in[7], XN, bh >> 3, bh & 7, idx & 15); }
#endif
#if MLA_NAIVE
        for (int u = bx; u < 512; u += G) mla_naive(lds, Qm, Km, Vm, XN, u);
#else
        for (int rep = 0; rep < MLA_REP; ++rep) for (int u = bx; u < 1024; u += G) { const int idx = (u >> 8) * 32 + ((u >> 3) & 31), bh = (u & 7) * 8 + (idx >> 4); attn_unit<false>(lds, Qm, Km, Vm, nullptr, XN, bh >> 3, bh & 7, idx & 15); }
#endif
    }
    SEAM(7);
    if (IN(8)) { TIDS; PTRS; { int m = gw; for (; m + 7 * NGW < M; m += 8 * NGW) rows_onorm<8>(XN, a.in[12], a.in[13], m, NGW, lane); for (; m < M; m += NGW) rows_onorm<1>(XN, a.in[12], a.in[13], m, NGW, lane); } }
    SEAM(8);
    if (IN(9)) { PTRS; pg8::Gemm g{XN, Wout, M, D, D}; SO S; S.init(M, D, G, bx); pg8::EpiBf16<0> E{Fb, D, nullptr, 0, 0, 1.f};
        for (int rep_ = 0; rep_ < GEMM_REP; ++rep_) pg8::gemm_phase<pg8::EpiBf16<0>, SO, true, true>(lds, g, S, E); }
    SEAM(9);
    if (IN(10)) { TIDS; PTRS; { int m = gw; for (; m + 7 * NGW < M; m += 8 * NGW) rows_mid<8, true, true, true>(Fb, HB, HB, a.in[15], 1.0f, a.in[16], XN, m, NGW, lane); for (; m < M; m += NGW) rows_mid<1, true, true, true>(Fb, HB, HB, a.in[15], 1.0f, a.in[16], XN, m, NGW, lane); } }
    SEAM(10);
    if (IN(11)) { PTRS; pg8::Gemm g{XN, Wgu2, M, NGU, D}; SO S; S.init(M, NGU, G, bx); EpiSwiGLU E{Hb, FF};
        for (int rep_ = 0; rep_ < GEMM_REP; ++rep_) pg8::gemm_phase<EpiSwiGLU, SO, true, true>(lds, g, S, E); }
    SEAM(11);
    if (IN(12)) { PTRS; pg8::Gemm g{Hb, Wd2, M, D, FF}; SO S; S.init(M, D, G, bx); pg8::EpiBf16<0> E{Fb, D, nullptr, 0, 0, 1.f};
        for (int rep_ = 0; rep_ < GEMM_REP; ++rep_) pg8::gemm_phase<pg8::EpiBf16<0>, SO, true, true>(lds, g, S, E); }
    SEAM(12);
    if (IN(13)) { TIDS; PTRS; { int m = gw; for (; m + 7 * NGW < M; m += 8 * NGW) rows_mid<8, false, true, false>(Fb, HB, out, a.in[19], 0.5f, nullptr, nullptr, m, NGW, lane); for (; m < M; m += NGW) rows_mid<1, false, true, false>(Fb, HB, out, a.in[19], 0.5f, nullptr, nullptr, m, NGW, lane); } }
#undef IN
#undef SEAM
}
}

#ifndef MK_MULTI
#define MK_MULTI 0
#endif
extern "C" void kernel_launch(void* const* d_in, const int* in_sizes, int n_in, void* d_out, int out_size, void* d_ws, size_t ws_size, hipStream_t stream) {
    static int grid = 0;
    if (grid == 0) {
        if (n_in != 20 || out_size != mk::M * mk::D || ws_size < mk::WS_END) { fprintf(stderr, "kernel_launch: unexpected shapes (n_in %d out %d ws %zu)\n", n_in, out_size, ws_size); grid = -1; return; }
        int dev = 0, cus = 0, per_cu = 0;
        (void)hipGetDevice(&dev); (void)hipDeviceGetAttribute(&cus, hipDeviceAttributeMultiprocessorCount, dev);
        if (hipFuncSetAttribute((const void*)mk::mk_fwd, hipFuncAttributeMaxDynamicSharedMemorySize, mk::LDS_BYTES) != hipSuccess) { fprintf(stderr, "kernel_launch: hipFuncSetAttribute failed\n"); grid = -1; return; }
        if (hipOccupancyMaxActiveBlocksPerMultiprocessor(&per_cu, (const void*)mk::mk_fwd, 512, mk::LDS_BYTES) != hipSuccess || per_cu < 1) { fprintf(stderr, "kernel_launch: occupancy query says %d\n", per_cu); grid = -1; (void)hipGetLastError(); return; }
        grid = cus;
    }
    if (grid < 0) return;
    mk::Args a{};
    for (int i = 0; i < 20; ++i) a.in[i] = (const float*)d_in[i];
    a.out = (float*)d_out; a.ws = (unsigned char*)d_ws;
#if MK_MULTI
    for (int ph = 0; ph < mk::NPHASE; ++ph) { a.ph_lo = ph; a.ph_hi = ph + 1; hipLaunchKernelGGL(mk::mk_fwd, dim3(grid), dim3(512), mk::LDS_BYTES, stream, a); }
#else
    a.ph_lo = 0; a.ph_hi = mk::NPHASE;
    void* args[] = {&a};
    hipError_t e = hipLaunchCooperativeKernel((const void*)mk::mk_fwd, dim3(grid), dim3(512), args, mk::LDS_BYTES, stream);
    if (e != hipSuccess) fprintf(stderr, "kernel_launch: cooperative launch failed: %s\n", hipGetErrorString(e));
#endif
}
```

```cpp
#include <hip/hip_runtime.h>
#include <hip/hip_cooperative_groups.h>
#include <cstdio>
namespace cg = cooperative_groups;
#include <cstdint>
namespace pg8 {
#define PG8_LAS __attribute__((address_space(3)))
typedef unsigned short bf16_t;
typedef short bf16x8 __attribute__((ext_vector_type(8)));
typedef float f32x4 __attribute__((ext_vector_type(4)));
typedef unsigned u32x4 __attribute__((ext_vector_type(4)));
constexpr int BM = 256, BK = 64, HALF = 128, HTB = HALF * BK * 2  , STAGE_BYTES = 8 * HTB, NXCD = 8, WGM = 8;

__host__ __device__ __forceinline__ int lds_byte(int r, int c) { const int st = (r >> 4) * 2 + (c >> 5), rr = r & 15, cc = c & 31, ob = rr * 64 + cc * 2; return st * 1024 + (ob ^ (((ob >> 9) & 1) << 5)); }
__host__ __device__ __forceinline__ void stage_rc(int b, int& R, int& C) { const int st = b / 1024, sb = b % 1024, swz = sb ^ (((sb >> 9) & 1) << 5); R = (st >> 1) * 16 + swz / 64; C = (st & 1) * 32 + (swz % 64) / 2; }
__host__ __device__ __forceinline__ int perm32(int rho) { const int n = rho >> 4, i = rho & 15; return 8 * (i >> 2) + 4 * n + (i & 3); }

struct Unit { int pm, pn; };
struct Gemm { const bf16_t* A; const bf16_t* Bt; int M, N, K; };

struct StaticOrder {
    int nM, nN, nwg, G, c;
    __host__ __device__ void init(int M, int N, int G_, int c_) { nM = M / BM; nN = N / BM; nwg = nM * nN; G = G_; c = c_; }
    __host__ __device__ bool next(int i, Unit& u) const {
        const long L = (long)i * G + c; if (L >= nwg) return false;
        int wgid = (int)L; { const int q = nwg / NXCD, r = nwg % NXCD, xcd = wgid % NXCD, off = wgid / NXCD; wgid = (xcd < r ? xcd * (q + 1) : r * (q + 1) + (xcd - r) * q) + off; }
        const int nig = WGM * nN, gid = wgid / nig, fm = gid * WGM, gsz = (nM - fm) < WGM ? (nM - fm) : WGM;
        u.pm = fm + ((wgid % nig) % gsz); u.pn = (wgid % nig) / gsz; return true;
    }
    __device__ __forceinline__ void a_ready(const Unit&) const {}
    __device__ __forceinline__ void done(const Unit&) const {}
};

__device__ __forceinline__ unsigned cvt_pk_bf16(float lo, float hi) { unsigned r; asm volatile("v_cvt_pk_bf16_f32 %0, %1, %2" : "=v"(r) : "v"(lo), "v"(hi)); return r; }
typedef float f32x2 __attribute__((ext_vector_type(2)));
__device__ __forceinline__ f32x2 gelu_pk(f32x2 v) {
    const f32x2 av = __builtin_elementwise_abs(v), d = av * 0.2316418882f + 1.0f;
    f32x2 t; t.x = __builtin_amdgcn_rcpf(d.x); t.y = __builtin_amdgcn_rcpf(d.y);
    f32x2 q = t * 0.5307027145f + (-0.7265760135f); q = q * t + 0.7107068705f; q = q * t + (-0.142248368f); q = q * t + 0.127414796f; q = q * t;
    const f32x2 s = (v * v) * (-0.72134752044f);
    f32x2 e; e.x = __builtin_amdgcn_exp2f(s.x); e.y = __builtin_amdgcn_exp2f(s.y);
    const f32x2 m = v * (q * e), r = v - m;
    f32x2 o; o.x = v.x < 0.f ? m.x : r.x; o.y = v.y < 0.f ? m.y : r.y; return o;
}

template <int ACT  > struct EpiBf16 {
    static constexpr bool PERM = true, AFTER_DRAIN = false; static_assert(ACT == 0 || ACT == 1, "EpiBf16: ACT is 0 (none) or 1 (gelu_pk)");
    bf16_t* O; int ldc; const float* bias; int split_cols; size_t split_stride; float scale0;
    __device__ __forceinline__ void operator()(const f32x4 (&acc)[2][2][4][2], const Unit& u, int wr, int wc, int fr, int fq) const {
        const int row0 = u.pm * BM + wr * 64 + fr; int colt = u.pn * BM; bf16_t* base = O;
        float sc = 1.f; if (split_cols) { const int t = colt / split_cols; base += (size_t)t * split_stride; colt -= t * split_cols; if (t == 0) sc = scale0; }
        const int col0 = colt + wc * 32 + 8 * fq, bcol0 = u.pn * BM + wc * 32 + 8 * fq;
        f32x4 bv[2][2];
#pragma unroll
        for (int bj = 0; bj < 2; ++bj)
#pragma unroll
            for (int n = 0; n < 2; ++n) bv[bj][n] = bias ? *(const f32x4*)(bias + bcol0 + bj * HALF + 4 * n) : (f32x4){0.f, 0.f, 0.f, 0.f};
#pragma unroll
        for (int ai = 0; ai < 2; ++ai)
#pragma unroll
            for (int m = 0; m < 4; ++m) { bf16_t* rowp = base + (size_t)(row0 + ai * HALF + m * 16) * ldc + col0;
#pragma unroll
                for (int bj = 0; bj < 2; ++bj) { f32x4 v0 = acc[ai][bj][m][0] + bv[bj][0], v1 = acc[ai][bj][m][1] + bv[bj][1];
                    if (ACT == 1) { f32x2 a = gelu_pk((f32x2){v0[0], v0[1]}), b = gelu_pk((f32x2){v0[2], v0[3]}), c = gelu_pk((f32x2){v1[0], v1[1]}), d = gelu_pk((f32x2){v1[2], v1[3]});
                        v0 = (f32x4){a.x, a.y, b.x, b.y}; v1 = (f32x4){c.x, c.y, d.x, d.y}; }
                    v0 = v0 * sc; v1 = v1 * sc; u32x4 w; w.x = cvt_pk_bf16(v0[0], v0[1]); w.y = cvt_pk_bf16(v0[2], v0[3]); w.z = cvt_pk_bf16(v1[0], v1[1]); w.w = cvt_pk_bf16(v1[2], v1[3]);
                    *(u32x4*)(rowp + bj * HALF) = w; } }
    }
};

struct PanelStats {
    unsigned* xbuf;
    unsigned* cnt;
    unsigned* tmo;
    int ntn; float eps;
    unsigned code;
    __device__ __forceinline__ bool run(const f32x4 (&v)[2][2][4][2], const Unit& u, int wr, int wc, int fr, int fq, PG8_LAS unsigned char* lds, int wid, int lane) const {
        typedef float f32x2v __attribute__((ext_vector_type(2)));
        PG8_LAS f32x2v* P = (PG8_LAS f32x2v*)lds;
        PG8_LAS f32x2v* S = (PG8_LAS f32x2v*)(lds + 8192);
        PG8_LAS unsigned* flag = (PG8_LAS unsigned*)(lds + 8192 + 2048);
#pragma unroll
        for (int ai = 0; ai < 2; ++ai)
#pragma unroll
            for (int m = 0; m < 4; ++m) {
                float s = 0.f;
#pragma unroll
                for (int bj = 0; bj < 2; ++bj)
#pragma unroll
                    for (int n = 0; n < 2; ++n) { const f32x4 x = v[ai][bj][m][n]; s += (x[0] + x[1]) + (x[2] + x[3]); }
                s += __shfl_xor(s, 16); s += __shfl_xor(s, 32);
                const float mw = s * (1.0f / 64.0f); float q = 0.f;
#pragma unroll
                for (int bj = 0; bj < 2; ++bj)
#pragma unroll
                    for (int n = 0; n < 2; ++n) { const f32x4 d = v[ai][bj][m][n] - mw; q += (d[0] * d[0] + d[1] * d[1]) + (d[2] * d[2] + d[3] * d[3]); }
                q += __shfl_xor(q, 16); q += __shfl_xor(q, 32);
                if (fq == 0) P[(ai * HALF + wr * 64 + m * 16 + fr) * 4 + wc] = (f32x2v){mw, q};
            }
        asm volatile("s_waitcnt lgkmcnt(0)" ::: "memory"); __builtin_amdgcn_s_barrier(); asm volatile("" ::: "memory");
#if defined(BROKEN_EXCHANGE_NO_WAIT)
#warning BROKEN CONTROL BUILD: the row-statistics exchange does not wait; results are wrong by design
        if (blockIdx.x >= 64) { const long long t0_ = clock64(); while (clock64() - t0_ < 60000) __builtin_amdgcn_s_sleep(8); }
#endif
        const int row = wid * 32 + (lane & 31);
        if (lane < 32) {
            const f32x2v a = P[row * 4 + 0], b = P[row * 4 + 1], c = P[row * 4 + 2], d = P[row * 4 + 3];
            const float mt = (a.x + b.x + c.x + d.x) * 0.25f;
            const float da = a.x - mt, db = b.x - mt, dc = c.x - mt, dd = d.x - mt;
            const float m2 = (a.y + b.y) + (c.y + d.y) + 64.0f * ((da * da + db * db) + (dc * dc + dd * dd));
            unsigned long long* slot = (unsigned long long*)xbuf + ((size_t)(u.pm * BM + row) * 4 + u.pn);
            __hip_atomic_store(slot, ((unsigned long long)__float_as_uint(m2) << 32) | __float_as_uint(mt), __ATOMIC_RELAXED, __HIP_MEMORY_SCOPE_AGENT);
        }
        asm volatile("s_waitcnt vmcnt(0)" ::: "memory");
        if (lane == 0) __hip_atomic_fetch_add(cnt + 64 * u.pm, 1u, __ATOMIC_RELAXED, __HIP_MEMORY_SCOPE_AGENT);
        if (wid == 0) {
            bool dead = false; const unsigned long long t0 = __builtin_amdgcn_s_memrealtime(); const unsigned want = 8u * (unsigned)ntn;
            for (;;) {
#if defined(BROKEN_EXCHANGE_NO_WAIT)
                break;
#endif
                if ((unsigned)__builtin_amdgcn_readfirstlane(__hip_atomic_load(cnt + 64 * u.pm, __ATOMIC_RELAXED, __HIP_MEMORY_SCOPE_AGENT)) >= want) break;
                if (__builtin_amdgcn_s_memrealtime() - t0 > 2000000ull) {
                    if (lane == 0) { unsigned expect = 0u; __hip_atomic_compare_exchange_strong(tmo + 1, &expect, code | (unsigned)(u.pm & 0xff), __ATOMIC_RELAXED, __ATOMIC_RELAXED, __HIP_MEMORY_SCOPE_AGENT);
                                     __hip_atomic_store(tmo, 1u, __ATOMIC_RELAXED, __HIP_MEMORY_SCOPE_AGENT); }
                    dead = true; break; }
                __builtin_amdgcn_s_sleep(2);
            }
            __builtin_amdgcn_fence(__ATOMIC_ACQUIRE, "agent");
            if (lane == 0) flag[0] = dead ? 1u : 0u;
        }
        asm volatile("s_waitcnt vmcnt(0) lgkmcnt(0)" ::: "memory"); __builtin_amdgcn_s_barrier(); asm volatile("" ::: "memory");
        const bool bad = flag[0] != 0u;
        if (lane < 32) {
            const unsigned long long* slot = (const unsigned long long*)xbuf + (size_t)(u.pm * BM + row) * 4; float mt[4], m2[4]; float ms = 0.f;
#pragma unroll
            for (int t = 0; t < 4; ++t) { if (t < ntn) { const unsigned long long w = __hip_atomic_load(slot + t, __ATOMIC_RELAXED, __HIP_MEMORY_SCOPE_AGENT); mt[t] = __uint_as_float((unsigned)w); m2[t] = __uint_as_float((unsigned)(w >> 32)); } else { mt[t] = 0.f; m2[t] = 0.f; } ms += mt[t]; }
            const float mean = ms / (float)ntn; float q = 0.f;
#pragma unroll
            for (int t = 0; t < 4; ++t) if (t < ntn) { const float dm = mt[t] - mean; q += m2[t] + 256.0f * dm * dm; }
            S[row] = (f32x2v){mean, 1.0f / sqrtf(q / (256.0f * (float)ntn) + eps)};
        }
        asm volatile("s_waitcnt lgkmcnt(0)" ::: "memory"); __builtin_amdgcn_s_barrier(); asm volatile("" ::: "memory");
        return bad;
    }
};
struct EpiLnRes {
    static constexpr bool PERM = false, AFTER_DRAIN = true;
    const float* base; float* out; int ldc; const float* bias; PanelStats st; unsigned poison;
    __device__ __forceinline__ void fused(f32x4 (&acc)[2][2][4][2], const Unit& u, int wr, int wc, int fr, int fq, PG8_LAS unsigned char* lds, int wid, int lane) const {
        typedef float f32x2v __attribute__((ext_vector_type(2)));
        const PG8_LAS f32x2v* S = (const PG8_LAS f32x2v*)(lds + 8192);
        const int col0 = u.pn * BM + wc * 32 + 4 * fq;
#pragma unroll
        for (int bj = 0; bj < 2; ++bj)
#pragma unroll
            for (int n = 0; n < 2; ++n) { const f32x4 bv = bias ? *(const f32x4*)(bias + col0 + bj * HALF + n * 16) : (f32x4){0.f, 0.f, 0.f, 0.f};
#pragma unroll
                for (int ai = 0; ai < 2; ++ai)
#pragma unroll
                    for (int m = 0; m < 4; ++m) acc[ai][bj][m][n] += bv; }
        f32x4 pre[4][2][2];
#pragma unroll
        for (int m = 0; m < 4; ++m) { const size_t off = (size_t)(u.pm * BM + wr * 64 + m * 16 + fr) * ldc + col0;
#pragma unroll
            for (int bj = 0; bj < 2; ++bj)
#pragma unroll
                for (int n = 0; n < 2; ++n) pre[m][bj][n] = *(const f32x4*)(base + off + bj * HALF + n * 16); }
        const bool bad = st.run(acc, u, wr, wc, fr, fq, lds, wid, lane) || poison != 0u;
        const float qnan = __builtin_nanf("");
#pragma unroll
        for (int ai = 0; ai < 2; ++ai)
#pragma unroll
            for (int m = 0; m < 4; ++m) { const int r = ai * HALF + wr * 64 + m * 16 + fr; const f32x2v sr = S[r]; const size_t off = (size_t)(u.pm * BM + r) * ldc + col0;
#pragma unroll
                for (int bj = 0; bj < 2; ++bj)
#pragma unroll
                    for (int n = 0; n < 2; ++n) { const f32x4 bs = ai == 0 ? pre[m][bj][n] : *(const f32x4*)(base + off + bj * HALF + n * 16); f32x4 o = bs + (acc[ai][bj][m][n] - sr.x) * sr.y;
                        if (bad) o = (f32x4){qnan, qnan, qnan, qnan}; *(f32x4*)(out + off + bj * HALF + n * 16) = o; }
                if (m & 1) asm volatile("" ::: "memory"); }
    }
};
struct EpiLnResLn {
    static constexpr bool PERM = false, AFTER_DRAIN = true;
    const float* base; float* out; bf16_t* xn; int ldc; const float* bias; PanelStats st1, st2; unsigned poison;
    __device__ __forceinline__ void fused(f32x4 (&acc)[2][2][4][2], const Unit& u, int wr, int wc, int fr, int fq, PG8_LAS unsigned char* lds, int wid, int lane) const {
        typedef float f32x2v __attribute__((ext_vector_type(2))); typedef unsigned u32x2v __attribute__((ext_vector_type(2)));
        const PG8_LAS f32x2v* S = (const PG8_LAS f32x2v*)(lds + 8192);
        const int col0 = u.pn * BM + wc * 32 + 4 * fq;
#pragma unroll
        for (int bj = 0; bj < 2; ++bj)
#pragma unroll
            for (int n = 0; n < 2; ++n) { const f32x4 bv = bias ? *(const f32x4*)(bias + col0 + bj * HALF + n * 16) : (f32x4){0.f, 0.f, 0.f, 0.f};
#pragma unroll
                for (int ai = 0; ai < 2; ++ai)
#pragma unroll
                    for (int m = 0; m < 4; ++m) acc[ai][bj][m][n] += bv; }
        bool bad = st1.run(acc, u, wr, wc, fr, fq, lds, wid, lane) || poison != 0u;
        const float qnan = __builtin_nanf("");
#pragma unroll
        for (int ai = 0; ai < 2; ++ai)
#pragma unroll
            for (int m = 0; m < 4; ++m) { const int r = ai * HALF + wr * 64 + m * 16 + fr; const f32x2v sr = S[r]; const size_t off = (size_t)(u.pm * BM + r) * ldc + col0;
#pragma unroll
                for (int bj = 0; bj < 2; ++bj)
#pragma unroll
                    for (int n = 0; n < 2; ++n) { const f32x4 bs = *(const f32x4*)(base + off + bj * HALF + n * 16); acc[ai][bj][m][n] = bs + (acc[ai][bj][m][n] - sr.x) * sr.y; }
                asm volatile("" : "+v"(acc[ai][0][m][0]), "+v"(acc[ai][0][m][1]), "+v"(acc[ai][1][m][0]), "+v"(acc[ai][1][m][1]));
                if (m & 1) asm volatile("" ::: "memory"); }
        const bool bad1 = bad;
        bad = st2.run(acc, u, wr, wc, fr, fq, lds, wid, lane) || bad;
#pragma unroll
        for (int ai = 0; ai < 2; ++ai)
#pragma unroll
            for (int m = 0; m < 4; ++m) { const int r = ai * HALF + wr * 64 + m * 16 + fr; const f32x2v sr = S[r]; const size_t off = (size_t)(u.pm * BM + r) * ldc + col0;
#pragma unroll
                for (int bj = 0; bj < 2; ++bj)
#pragma unroll
                    for (int n = 0; n < 2; ++n) { const f32x4 x1 = acc[ai][bj][m][n]; *(f32x4*)(out + off + bj * HALF + n * 16) = bad1 ? (f32x4){qnan, qnan, qnan, qnan} : x1;
                        const f32x4 o = (x1 - sr.x) * sr.y; u32x2v w; w.x = cvt_pk_bf16(o[0], o[1]); w.y = cvt_pk_bf16(o[2], o[3]);
                        if (bad) { w.x = 0x7fc07fc0u; w.y = 0x7fc07fc0u; } *(u32x2v*)(xn + off + bj * HALF + n * 16) = w; }
                asm volatile("" ::: "memory"); }
    }
};

template <class E, class = void> struct EpiMidK { static constexpr bool value = false; };
template <class E> struct EpiMidK<E, decltype((void)E::MIDK)> { static constexpr bool value = E::MIDK; };
template <class Epi, class Sched, bool ALIGN_EPI = false, bool SP2 = false>
__device__ __forceinline__ void gemm_phase(PG8_LAS unsigned char* lds, const Gemm g, const Sched& S, const Epi& E) {
    int tid_ = threadIdx.x; asm volatile("" : "+v"(tid_));
    const int tid = tid_, wid = __builtin_amdgcn_readfirstlane(tid >> 6), lane = tid & 63, wr = wid >> 2, wc = wid & 3, fr = lane & 15, fq = lane >> 4;
    int K_ = g.K; asm volatile("" : "+s"(K_)); const int K = K_, nt = K / BK;
    unsigned voffA[2], voffB[2];
#pragma unroll
    for (int i = 0; i < 2; ++i) { int R, C; stage_rc(tid * 16 + i * 8192, R, C); const int Rb = Epi::PERM ? ((R & ~31) + perm32(R & 31)) : R;
        voffA[i] = (unsigned)(R * K + C) * 2u; voffB[i] = (unsigned)(Rb * K + C) * 2u; }
    const size_t kstep = (size_t)(BK * 2);
    const size_t hstep = (size_t)HALF * K * 2;
    const size_t tstep = 2 * hstep;
    const unsigned ldsw = (unsigned)wid * 1024u;
    const int aoff = lds_byte(wr * 64 + fr, fq * 8), boff = lds_byte(wc * 32 + fr, fq * 8);
#define PG8_SA(b, h) (((b) * 2 + (h)) * HTB)
#define PG8_SB(b, h) ((4 + (b) * 2 + (h)) * HTB)
#define PG8_STAGE(bufoff, gbase, voff) do { _Pragma("unroll") for (int _i = 0; _i < 2; ++_i) \
        __builtin_amdgcn_global_load_lds((const unsigned*)((const char*)(gbase) + (voff)[_i]), (PG8_LAS unsigned*)(lds + (bufoff) + ldsw + _i * 8192), 16, 0, 0); } while (0)
#define PG8_LDA(dst, b, h) do { _Pragma("unroll") for (int m = 0; m < 4; ++m) _Pragma("unroll") for (int k = 0; k < 2; ++k) dst[m][k] = *(const PG8_LAS bf16x8*)(lds + PG8_SA(b, h) + aoff + m * 2048 + k * 1024); } while (0)
#define PG8_LDB(dst, b, h) do { _Pragma("unroll") for (int n = 0; n < 2; ++n) _Pragma("unroll") for (int k = 0; k < 2; ++k) dst[n][k] = *(const PG8_LAS bf16x8*)(lds + PG8_SB(b, h) + boff + n * 2048 + k * 1024); } while (0)
#define PG8_MMA(ai, bj, At, Bt) do { __builtin_amdgcn_s_setprio(1); _Pragma("unroll") for (int m = 0; m < 4; ++m) _Pragma("unroll") for (int n = 0; n < 2; ++n) _Pragma("unroll") for (int k = 0; k < 2; ++k) \
        acc[ai][bj][m][n] = __builtin_amdgcn_mfma_f32_16x16x32_bf16(Bt[n][k], At[m][k], acc[ai][bj][m][n], 0, 0, 0); __builtin_amdgcn_s_setprio(0); } while (0)
#define PG8_WAIT_V(n) asm volatile("s_waitcnt vmcnt(" #n ")" ::: "memory")
#define PG8_WAIT_L(n) asm volatile("s_waitcnt lgkmcnt(" #n ")" ::: "memory")
#define PG8_BAR __builtin_amdgcn_s_barrier()
#define PG8_SCHED __builtin_amdgcn_sched_barrier(0)
    Unit cur, nxt; int ui = 0;
    if (!S.next(0, cur)) return;
    f32x4 acc[2][2][4][2];
#pragma unroll
    for (int a = 0; a < 2; ++a)
#pragma unroll
        for (int b = 0; b < 2; ++b)
#pragma unroll
            for (int m = 0; m < 4; ++m)
#pragma unroll
                for (int n = 0; n < 2; ++n) acc[a][b][m][n] = (f32x4){0.f, 0.f, 0.f, 0.f};
    bf16x8 At[4][2], B0[2][2], B1[2][2];
    const char* cA = (const char*)g.A + (size_t)cur.pm * tstep; const char* cB = (const char*)g.Bt + (size_t)cur.pn * tstep;
    S.a_ready(cur);
    if constexpr (SP2) {
        PG8_STAGE(PG8_SB(0, 0), cB, voffB); PG8_STAGE(PG8_SB(0, 1), cB + hstep, voffB); PG8_STAGE(PG8_SA(0, 0), cA, voffA); PG8_STAGE(PG8_SA(0, 1), cA + hstep, voffA);
        if (wr == 1) PG8_BAR;
        PG8_WAIT_V(2); PG8_BAR;
        PG8_STAGE(PG8_SB(1, 0), cB + kstep, voffB); PG8_STAGE(PG8_SA(1, 0), cA + kstep, voffA); PG8_STAGE(PG8_SB(1, 1), cB + hstep + kstep, voffB);
        PG8_WAIT_V(6); PG8_BAR;
    } else {
        PG8_STAGE(PG8_SB(0, 0), cB, voffB); PG8_STAGE(PG8_SA(0, 0), cA, voffA); PG8_STAGE(PG8_SB(0, 1), cB + hstep, voffB); PG8_STAGE(PG8_SA(0, 1), cA + hstep, voffA);
        if (wr == 1) PG8_BAR;
        PG8_WAIT_V(4); PG8_BAR;
        PG8_STAGE(PG8_SB(1, 0), cB + kstep, voffB); PG8_STAGE(PG8_SA(1, 0), cA + kstep, voffA); PG8_STAGE(PG8_SB(1, 1), cB + hstep + kstep, voffB);
        PG8_WAIT_V(6); PG8_BAR;
    }
    for (;;) {
        const bool has_next = S.next(ui + 1, nxt);
        const char* nA = has_next ? (const char*)g.A + (size_t)nxt.pm * tstep : cA; const char* nB = has_next ? (const char*)g.Bt + (size_t)nxt.pn * tstep : cB;
        for (int t = 0; t < nt; t += 2) {
            const bool last = (t == nt - 2);
            if constexpr (EpiMidK<Epi>::value) { if (t == nt / 2) E.midk(acc, cur, wr, fr); }
            const char* a1 = cA + (size_t)(t + 1) * kstep;
            const char* a2 = last ? nA : cA + (size_t)(t + 2) * kstep; const char* b2 = last ? nB : cB + (size_t)(t + 2) * kstep;
            const char* a3 = a2 + kstep; const char* b3 = b2 + kstep;
            if (last && has_next) S.a_ready(nxt);
            if constexpr (SP2) {
            PG8_LDB(B0, 0, 0); PG8_LDB(B1, 0, 1); PG8_SCHED; PG8_LDA(At, 0, 0); PG8_STAGE(PG8_SA(1, 1), a1 + hstep, voffA);
            PG8_WAIT_V(8); PG8_WAIT_L(0); PG8_BAR; PG8_MMA(0, 0, At, B0); PG8_MMA(0, 1, At, B1); PG8_BAR; PG8_SCHED;
            PG8_LDA(At, 0, 1); PG8_STAGE(PG8_SB(0, 0), b2, voffB); PG8_STAGE(PG8_SB(0, 1), b2 + hstep, voffB); PG8_STAGE(PG8_SA(0, 0), a2, voffA);
            PG8_WAIT_V(8); PG8_WAIT_L(0); PG8_BAR; PG8_MMA(1, 0, At, B0); PG8_MMA(1, 1, At, B1); PG8_BAR; PG8_SCHED;
            PG8_LDB(B0, 1, 0); PG8_LDB(B1, 1, 1); PG8_SCHED; PG8_LDA(At, 1, 0); PG8_STAGE(PG8_SA(0, 1), a2 + hstep, voffA);
            PG8_WAIT_V(8); PG8_WAIT_L(0); PG8_BAR; PG8_MMA(0, 0, At, B0); PG8_MMA(0, 1, At, B1); PG8_BAR; PG8_SCHED;
            PG8_LDA(At, 1, 1); PG8_STAGE(PG8_SB(1, 0), b3, voffB); PG8_STAGE(PG8_SB(1, 1), b3 + hstep, voffB); PG8_STAGE(PG8_SA(1, 0), a3, voffA);
            PG8_WAIT_V(8); PG8_WAIT_L(0); PG8_BAR; PG8_MMA(1, 0, At, B0); PG8_MMA(1, 1, At, B1); PG8_BAR; PG8_SCHED;
            } else {
            PG8_LDB(B0, 0, 0); PG8_SCHED; PG8_LDA(At, 0, 0); PG8_STAGE(PG8_SA(1, 1), a1 + hstep, voffA);
            PG8_WAIT_L(8); PG8_BAR; PG8_WAIT_L(0); PG8_MMA(0, 0, At, B0); PG8_BAR; PG8_SCHED;
            PG8_LDB(B1, 0, 1); PG8_STAGE(PG8_SB(0, 0), b2, voffB);
            PG8_BAR; PG8_WAIT_L(0); PG8_MMA(0, 1, At, B1); PG8_BAR;
            PG8_LDA(At, 0, 1); PG8_STAGE(PG8_SA(0, 0), a2, voffA);
            PG8_BAR; PG8_WAIT_L(0); PG8_MMA(1, 0, At, B0); PG8_BAR; PG8_SCHED;
            PG8_STAGE(PG8_SB(0, 1), b2 + hstep, voffB);
            PG8_WAIT_V(6); PG8_BAR; PG8_MMA(1, 1, At, B1); PG8_BAR;
            PG8_LDB(B0, 1, 0); PG8_SCHED; PG8_LDA(At, 1, 0); PG8_STAGE(PG8_SA(0, 1), a2 + hstep, voffA);
            PG8_WAIT_L(8); PG8_BAR; PG8_WAIT_L(0); PG8_MMA(0, 0, At, B0); PG8_BAR; PG8_SCHED;
            PG8_LDB(B1, 1, 1); PG8_STAGE(PG8_SB(1, 0), b3, voffB);
            PG8_BAR; PG8_WAIT_L(0); PG8_MMA(0, 1, At, B1); PG8_BAR;
            PG8_LDA(At, 1, 1); PG8_STAGE(PG8_SA(1, 0), a3, voffA);
            PG8_BAR; PG8_WAIT_L(0); PG8_MMA(1, 0, At, B0); PG8_BAR; PG8_SCHED;
            PG8_STAGE(PG8_SB(1, 1), b3 + hstep, voffB);
            PG8_WAIT_V(6); PG8_BAR; PG8_MMA(1, 1, At, B1); PG8_BAR;
            }
        }
        if constexpr (ALIGN_EPI) { if (wr == 0) PG8_BAR; }
        if constexpr (!Epi::AFTER_DRAIN) { E(acc, cur, wr, wc, fr, fq); S.done(cur); }
        if (!has_next) break;
#pragma unroll
        for (int a = 0; a < 2; ++a)
#pragma unroll
            for (int b = 0; b < 2; ++b)
#pragma unroll
                for (int m = 0; m < 4; ++m)
#pragma unroll
                    for (int n = 0; n < 2; ++n) acc[a][b][m][n] = (f32x4){0.f, 0.f, 0.f, 0.f};
        cur = nxt; cA = nA; cB = nB; ++ui;
        if constexpr (ALIGN_EPI) { if (wr == 1) PG8_BAR; }
    }
    PG8_WAIT_V(0);
    if constexpr (!ALIGN_EPI) { if (wr == 0) PG8_BAR; }
    PG8_BAR;
    if constexpr (Epi::AFTER_DRAIN) { E.fused(acc, cur, wr, wc, fr, fq, lds, wid, lane); S.done(cur); }
#undef PG8_SA
#undef PG8_SB
#undef PG8_STAGE
#undef PG8_LDA
#undef PG8_LDB
#undef PG8_MMA
#undef PG8_WAIT_V
#undef PG8_WAIT_L
#undef PG8_BAR
#undef PG8_SCHED
}
}

#ifndef PG8_SP2
#define PG8_SP2 true
#endif
#ifndef PG8_ALIGN
#define PG8_ALIGN true
#endif

namespace mk {
using pg8::bf16_t; using pg8::f32x4; using pg8::u32x4; using pg8::Unit; using pg8::BM; using pg8::HALF; using pg8::bf16x8;
#define LAS __attribute__((address_space(3)))
#define GAS __attribute__((address_space(1)))
typedef unsigned u32x2 __attribute__((ext_vector_type(2)));
typedef float f32x2 __attribute__((ext_vector_type(2)));
typedef float f32x16 __attribute__((ext_vector_type(16)));

constexpr int M = 32768, D = 1024, FF = 2816, NGU = 5632, DIN = 1952, DINP = 2048, SEQ = 4096;
constexpr float EPS = 1e-6f;
constexpr float LOG2E = 1.4426950408889634f;
constexpr float QSCALE = 0.10206207261596577f * 1.4426950408889634f;

constexpr size_t MiB = 1u << 20;
constexpr size_t WS_CS = 0;
constexpr size_t WS_SS = 262144;
constexpr size_t WS_BAR = 65536;
constexpr size_t WS_WGU1 = 1 * MiB, WS_WD1 = 12 * MiB, WS_WIN = 18 * MiB, WS_WUQ = 22 * MiB, WS_WUKV = 22 * MiB + 512 * 1024,
                 WS_WOUT = 23 * MiB, WS_WGU2 = 25 * MiB, WS_WD2 = 36 * MiB;
constexpr size_t WS_XN = 49 * MiB;
constexpr size_t WS_F = 113 * MiB;
constexpr size_t WS_KM = 113 * MiB;
constexpr size_t WS_CQN = 161 * MiB;
constexpr size_t WS_H = 177 * MiB;
constexpr size_t WS_QM = 305 * MiB;
constexpr size_t WS_VM = 353 * MiB;
constexpr size_t WS_CKVN = 385 * MiB;
constexpr size_t WS_HB = 393 * MiB;
constexpr size_t WS_END = 457 * MiB;

constexpr int LDS_BYTES = 147456;

__device__ __forceinline__ float bf_lo(unsigned w) { return __uint_as_float(w << 16); }
__device__ __forceinline__ float bf_hi(unsigned w) { return __uint_as_float(w & 0xffff0000u); }
__device__ __forceinline__ unsigned pk(float lo, float hi) { return pg8::cvt_pk_bf16(lo, hi); }
__device__ __forceinline__ float wave_sum(float v) {
#pragma unroll
    for (int o = 1; o < 64; o <<= 1) v += __shfl_xor(v, o);
    return v;
}
__device__ __forceinline__ float dot4(f32x4 a) { return (a[0] * a[0] + a[1] * a[1]) + (a[2] * a[2] + a[3] * a[3]); }

struct EpiSwiGLU {
    static constexpr bool PERM = true, AFTER_DRAIN = false;
    bf16_t* O; int ldc;
    __device__ __forceinline__ void operator()(const f32x4 (&acc)[2][2][4][2], const Unit& u, int wr, int wc, int fr, int fq) const {
        const int row0 = u.pm * BM + wr * 64 + fr; const int col0 = u.pn * 128 + wc * 32 + 8 * fq;
#pragma unroll
        for (int ai = 0; ai < 2; ++ai)
#pragma unroll
            for (int m = 0; m < 4; ++m) {
                bf16_t* rowp = O + (size_t)(row0 + ai * HALF + m * 16) * ldc + col0;
                float r[8];
#pragma unroll
                for (int n = 0; n < 2; ++n)
#pragma unroll
                    for (int j = 0; j < 4; ++j) { const float g = acc[ai][0][m][n][j], up = acc[ai][1][m][n][j];
                        const float e = __builtin_amdgcn_exp2f(-g * LOG2E); r[4 * n + j] = g * __builtin_amdgcn_rcpf(1.0f + e) * up; }
                u32x4 w; w.x = pk(r[0], r[1]); w.y = pk(r[2], r[3]); w.z = pk(r[4], r[5]); w.w = pk(r[6], r[7]);
                *(u32x4*)rowp = w;
            }
    }
};
struct EpiKV {
    static constexpr bool PERM = true, AFTER_DRAIN = false;
    bf16_t* Km; bf16_t* Vm;
    __device__ __forceinline__ void operator()(const f32x4 (&acc)[2][2][4][2], const Unit& u, int wr, int wc, int fr, int fq) const {
        const int row0 = u.pm * BM + wr * 64 + fr;
#pragma unroll
        for (int bj = 0; bj < 2; ++bj) {
            const int colt = u.pn * BM + bj * HALF + wc * 32 + 8 * fq;
            bf16_t* base; int ld;
            if (colt < 512) { base = Km + 96 * (colt >> 6) + (colt & 63); ld = 768; } else { base = Vm + (colt - 512); ld = 512; }
#pragma unroll
            for (int ai = 0; ai < 2; ++ai)
#pragma unroll
                for (int m = 0; m < 4; ++m) { const f32x4 v0 = acc[ai][bj][m][0], v1 = acc[ai][bj][m][1];
                    u32x4 w; w.x = pk(v0[0], v0[1]); w.y = pk(v0[2], v0[3]); w.z = pk(v1[0], v1[1]); w.w = pk(v1[2], v1[3]);
                    *(u32x4*)(base + (size_t)(row0 + ai * HALF + m * 16) * ld) = w; }
        }
    }
};
struct EpiQ {
    static constexpr bool PERM = false, AFTER_DRAIN = false;
    bf16_t* O; const f32x2* cs;
    __device__ __forceinline__ void operator()(const f32x4 (&acc)[2][2][4][2], const Unit& u, int wr, int wc, int fr, int fq) const {
        const int row0 = u.pm * BM + wr * 64 + fr;
#pragma unroll
        for (int bj = 0; bj < 2; ++bj) {
            const int g32 = u.pn * 8 + bj * 4 + wc; const bool rot = (g32 % 3) == 2; const int cbase = g32 * 32 + 4 * fq;
#pragma unroll
            for (int ai = 0; ai < 2; ++ai)
#pragma unroll
                for (int m = 0; m < 4; ++m) {
                    const int row = row0 + ai * HALF + m * 16;
                    f32x4 x0 = acc[ai][bj][m][0], x1 = acc[ai][bj][m][1];
                    if (rot) { const int t = row & (SEQ - 1); const int pos = (fq < 2) ? (t >> 6) : (t & 63); const f32x2* cp = cs + pos * 8 + 4 * (fq & 1);
                        f32x4 y0, y1;
#pragma unroll
                        for (int j = 0; j < 4; ++j) { const f32x2 c = cp[j]; y0[j] = x0[j] * c.x - x1[j] * c.y; y1[j] = x1[j] * c.x + x0[j] * c.y; }
                        x0 = y0; x1 = y1; }
                    x0 = x0 * QSCALE; x1 = x1 * QSCALE;
                    bf16_t* p = O + (size_t)row * 768 + cbase;
                    u32x2 w0; w0.x = pk(x0[0], x0[1]); w0.y = pk(x0[2], x0[3]); u32x2 w1; w1.x = pk(x1[0], x1[1]); w1.y = pk(x1[2], x1[3]);
                    *(u32x2*)p = w0; *(u32x2*)(p + 16) = w1;
                    asm volatile("" ::: "memory");
                }
        }
    }
};

struct EpiOut {
    static constexpr bool PERM = true, AFTER_DRAIN = false, MIDK = true;
    bf16_t* O; int ldc; const f32x2* ss;
    __device__ __forceinline__ void midk(f32x4 (&acc)[2][2][4][2], const Unit& u, int wr, int fr) const {
        const int row0 = u.pm * BM + wr * 64 + fr;
#pragma unroll
        for (int ai = 0; ai < 2; ++ai)
#pragma unroll
            for (int m = 0; m < 4; ++m) { const f32x2 s = ss[row0 + ai * HALF + m * 16];
                const float ratio = sqrtf((s.y * (1.0f / 512.0f) + EPS) / (s.x * (1.0f / 512.0f) + EPS));
#pragma unroll
                for (int bj = 0; bj < 2; ++bj)
#pragma unroll
                    for (int n = 0; n < 2; ++n) acc[ai][bj][m][n] = acc[ai][bj][m][n] * ratio; }
    }
    __device__ __forceinline__ void operator()(const f32x4 (&acc)[2][2][4][2], const Unit& u, int wr, int wc, int fr, int fq) const {
        const int row0 = u.pm * BM + wr * 64 + fr; const int col0 = u.pn * BM + wc * 32 + 8 * fq;
#pragma unroll
        for (int ai = 0; ai < 2; ++ai)
#pragma unroll
            for (int m = 0; m < 4; ++m) { const int row = row0 + ai * HALF + m * 16; const float rb = 1.0f / sqrtf(ss[row].y * (1.0f / 512.0f) + EPS);
                bf16_t* rowp = O + (size_t)row * ldc + col0;
#pragma unroll
                for (int bj = 0; bj < 2; ++bj) { const f32x4 v0 = acc[ai][bj][m][0] * rb, v1 = acc[ai][bj][m][1] * rb;
                    u32x4 w; w.x = pk(v0[0], v0[1]); w.y = pk(v0[2], v0[3]); w.z = pk(v1[0], v1[1]); w.w = pk(v1[2], v1[3]);
                    *(u32x4*)(rowp + bj * HALF) = w; } }
    }
};

template <int NR>
__device__ __forceinline__ void rows_norm_to_bf16(const float* X, const float* g, bf16_t* O, int m, int rs, int lane) {
    f32x4 v[NR][4]; float s[NR];
#pragma unroll
    for (int r = 0; r < NR; ++r) { const f32x4* xr = (const f32x4*)(X + (size_t)(m + r * rs) * D) + lane;
#pragma unroll
        for (int j = 0; j < 4; ++j) v[r][j] = xr[64 * j]; }
#pragma unroll
    for (int r = 0; r < NR; ++r) { s[r] = 0.f;
#pragma unroll
        for (int j = 0; j < 4; ++j) s[r] += dot4(v[r][j]); }
#pragma unroll
    for (int r = 0; r < NR; ++r) { const float rstd = 1.0f / sqrtf(wave_sum(s[r]) * (1.0f / D) + EPS);
#pragma unroll
        for (int j = 0; j < 4; ++j) { const f32x4 o = v[r][j] * rstd * ((const f32x4*)g)[lane + 64 * j]; u32x2 w; w.x = pk(o[0], o[1]); w.y = pk(o[2], o[3]); ((u32x2*)(O + (size_t)(m + r * rs) * D))[lane + 64 * j] = w; } }
}
template <int NR, bool WRITE_XN, bool RES_BF, bool OUT_BF>
__device__ __forceinline__ void rows_mid(const bf16_t* F, const void* RES, void* OUT, const float* gpost, float coef, const float* gpre, bf16_t* XNo, int m, int rs, int lane) {
    u32x2 fw[NR][4]; f32x4 rr[NR][4]; u32x2 rw[NR][4];
#pragma unroll
    for (int r = 0; r < NR; ++r) { const size_t ro = (size_t)(m + r * rs) * D;
#pragma unroll
        for (int j = 0; j < 4; ++j) { fw[r][j] = ((const u32x2*)(F + ro))[lane + 64 * j];
            if (RES_BF) rw[r][j] = ((const u32x2*)((const bf16_t*)RES + ro))[lane + 64 * j];
            else rr[r][j] = ((const f32x4*)((const float*)RES + ro))[lane + 64 * j]; } }
#pragma unroll
    for (int r = 0; r < NR; ++r) { const size_t ro = (size_t)(m + r * rs) * D;
        f32x4 f[4]; float s = 0.f;
#pragma unroll
        for (int j = 0; j < 4; ++j) { const u32x2 w = fw[r][j]; f[j] = (f32x4){bf_lo(w.x), bf_hi(w.x), bf_lo(w.y), bf_hi(w.y)}; s += dot4(f[j]); }
        const float rstd = 1.0f / sqrtf(wave_sum(s) * (1.0f / D) + EPS) * coef;
        float s2 = 0.f;
#pragma unroll
        for (int j = 0; j < 4; ++j) { const f32x4 gp = ((const f32x4*)gpost)[lane + 64 * j];
            const f32x4 res = RES_BF ? (f32x4){bf_lo(rw[r][j].x), bf_hi(rw[r][j].x), bf_lo(rw[r][j].y), bf_hi(rw[r][j].y)} : rr[r][j];
            f[j] = res + f[j] * rstd * gp;
            if (OUT_BF) { u32x2 w; w.x = pk(f[j][0], f[j][1]); w.y = pk(f[j][2], f[j][3]); ((u32x2*)((bf16_t*)OUT + ro))[lane + 64 * j] = w; } else ((f32x4*)((float*)OUT + ro))[lane + 64 * j] = f[j];
            s2 += dot4(f[j]); }
        if (WRITE_XN) {
            const float rstd2 = 1.0f / sqrtf(wave_sum(s2) * (1.0f / D) + EPS);
#pragma unroll
            for (int j = 0; j < 4; ++j) { const f32x4 o = f[j] * rstd2 * ((const f32x4*)gpre)[lane + 64 * j]; u32x2 w; w.x = pk(o[0], o[1]); w.y = pk(o[2], o[3]); ((u32x2*)(XNo + ro))[lane + 64 * j] = w; }
        }
    }
}
template <int NR>
__device__ __forceinline__ void rows_onorm(bf16_t* O, const float* gna, const float* gmla, int m, int rs, int lane) {
    u32x2 fw[NR][4];
#pragma unroll
    for (int r = 0; r < NR; ++r)
#pragma unroll
        for (int j = 0; j < 4; ++j) fw[r][j] = ((const u32x2*)(O + (size_t)(m + r * rs) * D))[lane + 64 * j];
#pragma unroll
    for (int r = 0; r < NR; ++r) { f32x4 f[4]; float sa = 0.f, sb = 0.f;
#pragma unroll
        for (int j = 0; j < 4; ++j) { const u32x2 w = fw[r][j]; f[j] = (f32x4){bf_lo(w.x), bf_hi(w.x), bf_lo(w.y), bf_hi(w.y)}; if (j < 2) sa += dot4(f[j]); else sb += dot4(f[j]); }
        const float ra = 1.0f / sqrtf(wave_sum(sa) * (1.0f / 512.0f) + EPS), rb = 1.0f / sqrtf(wave_sum(sb) * (1.0f / 512.0f) + EPS);
#pragma unroll
        for (int j = 0; j < 4; ++j) { const f32x4 g = (j < 2) ? ((const f32x4*)gna)[lane + 64 * j] : ((const f32x4*)gmla)[lane + 64 * (j - 2)];
            const f32x4 o = f[j] * ((j < 2) ? ra : rb) * g; u32x2 w; w.x = pk(o[0], o[1]); w.y = pk(o[2], o[3]); ((u32x2*)(O + (size_t)(m + r * rs) * D))[lane + 64 * j] = w; } }
}
__device__ __forceinline__ void mla_prep_row(const bf16_t* zrow, int row, const float* gq, const float* gkv, const f32x2* cs, bf16_t* cqn, bf16_t* ckvn, bf16_t* km, int lane) {
    const u32x2 wq = ((const u32x2*)(zrow + 1536))[lane];
    const float q0 = bf_lo(wq.x), q1 = bf_hi(wq.x), q2 = bf_lo(wq.y), q3 = bf_hi(wq.y);
    const float rq = 1.0f / sqrtf(wave_sum((q0 * q0 + q1 * q1) + (q2 * q2 + q3 * q3)) * (1.0f / 256.0f) + EPS);
    const unsigned wk = ((const unsigned*)(zrow + 1792))[lane];
    const float k0 = bf_lo(wk), k1 = bf_hi(wk);
    const float rk = 1.0f / sqrtf(wave_sum(k0 * k0 + k1 * k1) * (1.0f / 128.0f) + EPS);
    const f32x4 g = ((const f32x4*)gq)[lane];
    u32x2 o; o.x = pk(q0 * rq * g[0], q1 * rq * g[1]); o.y = pk(q2 * rq * g[2], q3 * rq * g[3]);
    ((u32x2*)(cqn + (size_t)row * 256))[lane] = o;
    const f32x2 g2 = ((const f32x2*)gkv)[lane];
    ((unsigned*)(ckvn + (size_t)row * 128))[lane] = pk(k0 * rk * g2.x, k1 * rk * g2.y);
    if (lane < 16) {
        const int i = lane; const float x1 = bf_lo((unsigned)zrow[1920 + i]), x2 = bf_lo((unsigned)zrow[1936 + i]);
        const int t = row & (SEQ - 1); const int pos = (i < 8) ? (t >> 6) : (t & 63); const f32x2 c = cs[pos * 8 + (i & 7)];
        const unsigned y = pk(x1 * c.x - x2 * c.y, x2 * c.x + x1 * c.y);
        bf16_t* kp = km + (size_t)row * 768 + 64 + i;
#pragma unroll
        for (int h = 0; h < 8; ++h) { kp[96 * h] = (bf16_t)(y & 0xffffu); kp[96 * h + 16] = (bf16_t)(y >> 16); }
    }
}

__device__ __forceinline__ void transpose_item(const float* W, int K, int N, bf16_t* WT, int k0, int n0, int n0_out, LAS float* scr, int lane, const float* kgain = nullptr) {
#pragma unroll 8
    for (int i = 0; i < 32; ++i) { const int kk = 2 * i + (lane >> 5); float w = W[(size_t)(k0 + kk) * N + n0 + (lane & 31)]; if (kgain) w *= kgain[kk]; scr[kk * 33 + (lane & 31)] = w; }
    asm volatile("s_waitcnt lgkmcnt(0)" ::: "memory");
    const int c = lane & 7;
#pragma unroll
    for (int j = 0; j < 4; ++j) { const int n = (lane >> 3) + 8 * j; const LAS float* s = scr + (8 * c) * 33 + n;
        u32x4 o; o.x = pk(s[0 * 33], s[1 * 33]); o.y = pk(s[2 * 33], s[3 * 33]); o.z = pk(s[4 * 33], s[5 * 33]); o.w = pk(s[6 * 33], s[7 * 33]);
        *(u32x4*)(WT + (size_t)(n0_out + n) * K + k0 + 8 * c) = o; }
    asm volatile("s_waitcnt lgkmcnt(0)" ::: "memory");
}
__device__ __forceinline__ int remap_gu(int n0) { if (n0 < FF) return 256 * (n0 >> 7) + (n0 & 127); const int m = n0 - FF; return 256 * (m >> 7) + 128 + (m & 127); }
__device__ __forceinline__ int remap_kv(int n0) { const int h = n0 >> 7, j = n0 & 127; return (j < 64) ? (64 * h + j) : (512 + 64 * h + (j - 64)); }
#define XB_TMO      128
#define XB_XCNT(j)  (256  + 64 * (j))
#define XB_XSUB(j)  (1280 + 64 * (j))
#define XB_XGEN(j)  (2304 + 64 * (j))
#define XB_TOP      3328
#define XB_TOPGEN   3392
#define XCD_BAR_WORDS 3456
#define XB_SPIN_CAP (1u << 18)

__device__ __forceinline__ unsigned xb_ld(unsigned* p)              { return __hip_atomic_load(p, __ATOMIC_RELAXED, __HIP_MEMORY_SCOPE_AGENT); }
__device__ __forceinline__ unsigned xb_add(unsigned* p, unsigned v) { return __hip_atomic_fetch_add(p, v, __ATOMIC_RELAXED, __HIP_MEMORY_SCOPE_AGENT); }
__device__ __forceinline__ unsigned xb_xcc_id() { return (unsigned)__builtin_amdgcn_s_getreg((3 << 11) | 20) & 0xFu; }
#define XB_SPIN(cond, bar) do { unsigned _sp = 0; while (cond) { __builtin_amdgcn_s_sleep(1); \
    if ((++_sp & 255u) == 0u) { if (xb_ld(&(bar)[XB_TMO])) break; if (_sp > XB_SPIN_CAP) { atomicAdd(&(bar)[XB_TMO], 1u); break; } } } } while (0)

struct XcdBarrier {
    unsigned* bar; unsigned x;
    volatile LAS unsigned* st;
};

__device__ __forceinline__ XcdBarrier xcd_barrier_post(unsigned* bar, volatile LAS unsigned* st) {
    XcdBarrier b; b.bar = bar; b.x = xb_xcc_id(); b.st = st;
    if (threadIdx.x == 0) (void)xb_add(&bar[XB_XCNT(b.x)], 1u);
    return b;
}
__device__ __forceinline__ void xcd_barrier_complete(unsigned* bar, unsigned x, unsigned& nloc, unsigned& nx) {
    const unsigned G = gridDim.x * gridDim.y * gridDim.z;
    unsigned sum, cnt, mine, sp = 0u;
    for (;;) {
        sum = 0u; cnt = 0u; mine = 0u;
#pragma unroll
        for (unsigned j = 0; j < 16; ++j) { const unsigned c = xb_ld(&bar[XB_XCNT(j)]); sum += c; cnt += (c > 0u) ? 1u : 0u; mine = (j == x) ? c : mine; }
        if (sum == G) break;
        __builtin_amdgcn_s_sleep(1);
        if ((++sp & 255u) == 0u) { if (xb_ld(&bar[XB_TMO])) break; if (sp > XB_SPIN_CAP) { atomicAdd(&bar[XB_TMO], 1u); break; } }
    }
    nloc = mine > 0u ? mine : 1u; nx = cnt > 0u ? cnt : 1u;
}

__device__ __forceinline__ void xcd_barrier(const XcdBarrier& b) {
    asm volatile("s_waitcnt vmcnt(0)" ::: "memory");
    __syncthreads();
    if (threadIdx.x == 0) {
        unsigned* bar = b.bar;
        __builtin_amdgcn_s_waitcnt(0);
        unsigned nloc = b.st[0], nx = b.st[1];
        if (nloc == 0u) { xcd_barrier_complete(bar, b.x, nloc, nx); b.st[0] = nloc; b.st[1] = nx; }
        const unsigned old = xb_add(&bar[XB_XSUB(b.x)], 1u);
        const unsigned gen = old / nloc;
        if (old + 1u == (gen + 1u) * nloc) {
            __builtin_amdgcn_fence(__ATOMIC_RELEASE, "agent");
            asm volatile("s_waitcnt vmcnt(0)" ::: "memory");
            const unsigned og = xb_add(&bar[XB_TOP], 1u);
            const unsigned tg = og / nx;
            if (og + 1u == (tg + 1u) * nx) xb_add(&bar[XB_TOPGEN], 1u);
            else XB_SPIN(xb_ld(&bar[XB_TOPGEN]) == tg, bar);
            __builtin_amdgcn_fence(__ATOMIC_ACQUIRE, "agent");
            xb_add(&bar[XB_XGEN(b.x)], 1u);
            asm volatile("s_waitcnt vmcnt(0)" ::: "memory");
        } else {
            XB_SPIN(xb_ld(&bar[XB_XGEN(b.x)]) == gen, bar);
            __builtin_amdgcn_fence(__ATOMIC_ACQUIRE, "agent");
            asm volatile("s_waitcnt vmcnt(0)" ::: "memory");
        }
    }
    __syncthreads();
}

typedef unsigned short u16_t;
__device__ __forceinline__ int iclamp(int v, int lo, int hi) { return min(max(v, lo), hi); }
__device__ __forceinline__ float max3f(float a, float b, float c) { float r; asm("v_max3_f32 %0, %1, %2, %3" : "=v"(r) : "v"(a), "v"(b), "v"(c)); return r; }
template <bool NA, int VAR = 0>
__device__ __forceinline__ void attn_unit(LAS unsigned char* lds, const bf16_t* Qsrc, const bf16_t* Ksrc, const bf16_t* Vsrc, const float* rpb, bf16_t* O, float* ss, int b, int h, int ub) {
    constexpr int DK = NA ? 64 : 96, ND0 = DK / 16, KP = NA ? 144 : 208, VP = 144;
    constexpr int QPITCH = NA ? 2048 : 768, KPITCH = NA ? 2048 : 768, VPITCH = NA ? 2048 : 512;
    constexpr int KB_BYTES = 13312, ABUF = 22528, BIAS_OFF = 2 * ABUF;
    constexpr float THR = 8.0f;
    int tid = threadIdx.x; asm volatile("" : "+v"(tid));
    const int lane = tid & 63, wave = __builtin_amdgcn_readfirstlane(tid >> 6), r32 = lane & 31, hi = lane >> 5;
    const size_t tok0 = (size_t)b * SEQ;
    int qgr = 0, qc = 0, rs_w = 0, t_lo = 0, t_hi = 64; size_t qtok;
    if (NA) { const int r0 = ub * 4; qgr = r0 + (wave >> 1); qc = 32 * (wave & 1) + r32; qtok = tok0 + qgr * 64 + qc;
        rs_w = iclamp(qgr - 4, 0, 56); t_lo = iclamp(r0 - 4, 0, 56); t_hi = iclamp(r0 - 1, 0, 56) + 8; }
    else { qtok = tok0 + ub * 256 + wave * 32 + r32; }
    bf16x8 qr[ND0];
    { const bf16_t* qp = Qsrc + qtok * QPITCH + (NA ? 64 * h : 96 * h) + 8 * hi;
#pragma unroll
      for (int d0 = 0; d0 < ND0; ++d0) qr[d0] = *(const bf16x8*)(qp + 16 * d0); }
    const bf16_t* kg0; const bf16_t* kg1 = nullptr; int lk0, lk1 = 0;
    if (NA) { const int key = tid >> 3, ch = tid & 7; kg0 = Ksrc + (tok0 + key) * KPITCH + 512 + 64 * h + 8 * ch; lk0 = key * KP + 16 * ch; }
    else { const int key0 = tid / 12, ch0 = tid % 12; kg0 = Ksrc + (tok0 + key0) * KPITCH + 96 * h + 8 * ch0; lk0 = key0 * KP + 16 * ch0;
        const int c1 = 512 + (tid & 255), key1 = c1 / 12, ch1 = c1 % 12; kg1 = Ksrc + (tok0 + key1) * KPITCH + 96 * h + 8 * ch1; lk1 = key1 * KP + 16 * ch1; }
    const bool two = !NA && tid < 256;
    const bf16_t* vg = Vsrc + (tok0 + lane) * VPITCH + (NA ? 1024 + 64 * h : 64 * h) + 8 * wave;
    const int pos = (lane & ~12) | ((lane & 4) << 1) | ((lane & 8) >> 1);
    const int lv = KB_BYTES + (8 * wave) * VP + pos * 2;
    const int ka = r32 * KP + 16 * hi, va = KB_BYTES + r32 * VP + 16 * hi;
    if (NA) { if (tid < 465) ((LAS float*)(lds + BIAS_OFF))[tid] = rpb[h * 465 + tid] * LOG2E; }
    u32x4 rk0, rk1 = (u32x4){0u, 0u, 0u, 0u}, rv;
#define AT_LOAD(t) do { rk0 = *(const u32x4*)(kg0 + (size_t)(t) * 64 * KPITCH); if (two) rk1 = *(const u32x4*)(kg1 + (size_t)(t) * 64 * KPITCH); rv = *(const u32x4*)(vg + (size_t)(t) * 64 * VPITCH); } while (0)
#define AT_STORE(buf) do { LAS unsigned char* B_ = lds + (buf) * ABUF; *(LAS u32x4*)(B_ + lk0) = rk0; if (two) *(LAS u32x4*)(B_ + lk1) = rk1; \
        LAS unsigned char* V_ = B_ + lv; \
        *(LAS u16_t*)(V_ + 0 * VP) = (u16_t)(rv.x & 0xffffu); *(LAS u16_t*)(V_ + 1 * VP) = (u16_t)(rv.x >> 16); *(LAS u16_t*)(V_ + 2 * VP) = (u16_t)(rv.y & 0xffffu); *(LAS u16_t*)(V_ + 3 * VP) = (u16_t)(rv.y >> 16); \
        *(LAS u16_t*)(V_ + 4 * VP) = (u16_t)(rv.z & 0xffffu); *(LAS u16_t*)(V_ + 5 * VP) = (u16_t)(rv.z >> 16); *(LAS u16_t*)(V_ + 6 * VP) = (u16_t)(rv.w & 0xffffu); *(LAS u16_t*)(V_ + 7 * VP) = (u16_t)(rv.w >> 16); } while (0)
#ifndef ATT_PRIO
#define ATT_PRIO 1
#endif
#if ATT_PRIO
    if (!NA) { if (wave < 4) __builtin_amdgcn_s_setprio(2); else __builtin_amdgcn_s_setprio(0); }
#endif
    float mx = 0.f, l = 0.f; f32x16 o0, o1, negm;
#pragma unroll
    for (int r = 0; r < 16; ++r) { o0[r] = 0.f; o1[r] = 0.f; negm[r] = 0.f; }
#ifndef ATT_STAGGER
#define ATT_STAGGER 1
#endif
    const bool late = ATT_STAGGER && (wave >= 4);
    bool pending = false; u32x4 pf[4]; bf16x8 vf[8]; bf16x8 kf[2 * ND0];
#define AT_PV() do { _Pragma("unroll") for (int ks = 0; ks < 4; ++ks) { const bf16x8 pb = __builtin_bit_cast(bf16x8, pf[ks]); \
        o0 = __builtin_amdgcn_mfma_f32_32x32x16_bf16(vf[2 * ks], pb, o0, 0, 0, 0); o1 = __builtin_amdgcn_mfma_f32_32x32x16_bf16(vf[2 * ks + 1], pb, o1, 0, 0, 0); } } while (0)
    AT_LOAD(t_lo); AT_STORE(0);
    __syncthreads();
#pragma unroll 1
    for (int t = t_lo; t < t_hi; ++t) {
        const int buf = (t - t_lo) & 1;
        if (VAR != 1 && VAR != 3 && t + 1 < t_hi) AT_LOAD(t + 1);
        const bool active = NA ? (t >= rs_w && t < rs_w + 8) : true;
        if (active) {
            LAS unsigned char* B = lds + buf * ABUF;
            if (VAR != 3 || t == t_lo) {
#pragma unroll
            for (int d0 = 0; d0 < ND0; ++d0) { kf[2 * d0] = *(const LAS bf16x8*)(B + ka + 32 * d0); kf[2 * d0 + 1] = *(const LAS bf16x8*)(B + ka + 32 * KP + 32 * d0); }
            }
            if (late && pending) { AT_PV(); pending = false; }
            if (VAR != 3 || t == t_lo) {
#pragma unroll
            for (int ks = 0; ks < 4; ++ks) { vf[2 * ks] = *(const LAS bf16x8*)(B + va + 32 * ks); vf[2 * ks + 1] = *(const LAS bf16x8*)(B + va + 32 * VP + 32 * ks); }
            }
            __builtin_amdgcn_sched_barrier(0);
            f32x16 p0, p1;
            if (NA) {
#pragma unroll
                for (int r = 0; r < 16; ++r) { p0[r] = 0.f; p1[r] = 0.f; }
            } else { p0 = negm; p1 = negm; }
#pragma unroll
            for (int d0 = 0; d0 < ND0; ++d0) { p0 = __builtin_amdgcn_mfma_f32_32x32x16_bf16(kf[2 * d0], qr[d0], p0, 0, 0, 0); p1 = __builtin_amdgcn_mfma_f32_32x32x16_bf16(kf[2 * d0 + 1], qr[d0], p1, 0, 0, 0); }
            if (NA) {
                const int ws = iclamp(qc - 8, 0, 48); const LAS float* bt = (const LAS float*)(lds + BIAS_OFF) + (t - qgr + 7) * 31;
                constexpr float C = 0.125f * LOG2E;
#pragma unroll
                for (int r = 0; r < 16; ++r) { const int kc0 = (r & 3) + 8 * (r >> 2) + 4 * hi, kc1 = kc0 + 32;
                    const int d0_ = kc0 - qc + 15, d1_ = kc1 - qc + 15;
                    const bool v0 = (kc0 >= ws) && (kc0 < ws + 16), v1 = (kc1 >= ws) && (kc1 < ws + 16);
                    const float b0 = bt[iclamp(d0_, 0, 30)] - mx, b1 = bt[iclamp(d1_, 0, 30)] - mx;
                    p0[r] = v0 ? fmaf(p0[r], C, b0) : -1e30f; p1[r] = v1 ? fmaf(p1[r], C, b1) : -1e30f; }
            }
            if (VAR != 2 && VAR != 3) {
            float mt = max3f(p0[0], p0[1], p1[0]);
            mt = max3f(mt, p1[1], p0[2]);
#pragma unroll
            for (int r = 3; r < 16; r += 1) mt = max3f(mt, p0[r], p1[r - 1]);
            mt = fmaxf(mt, p1[15]);
            mt = fmaxf(mt, __shfl_xor(mt, 32));
            const bool first = (t == (NA ? rs_w : t_lo));
            if (first || __any(mt > THR)) {
                const float dl = first ? mt : fmaxf(mt, 0.f); const float al = first ? 1.0f : __builtin_amdgcn_exp2f(-dl); mx += dl; l *= al;
#pragma unroll
                for (int r = 0; r < 16; ++r) { o0[r] *= al; o1[r] *= al; p0[r] -= dl; p1[r] -= dl; }
                if (!NA) {
#pragma unroll
                    for (int r = 0; r < 16; ++r) negm[r] = -mx;
                }
            }
            f32x2 ls2 = (f32x2){0.f, 0.f};
#pragma unroll
            for (int r = 0; r < 16; r += 2) { p0[r] = __builtin_amdgcn_exp2f(p0[r]); p0[r + 1] = __builtin_amdgcn_exp2f(p0[r + 1]); p1[r] = __builtin_amdgcn_exp2f(p1[r]); p1[r + 1] = __builtin_amdgcn_exp2f(p1[r + 1]);
                ls2 += (f32x2){p0[r], p0[r + 1]}; ls2 += (f32x2){p1[r], p1[r + 1]}; }
            l += ls2.x + ls2.y;
            } else { l += p0[0]; }
#pragma unroll
            for (int s = 0; s < 2; ++s) {
                pf[s] = (u32x4){pk(p0[8 * s], p0[8 * s + 1]), pk(p0[8 * s + 2], p0[8 * s + 3]), pk(p0[8 * s + 4], p0[8 * s + 5]), pk(p0[8 * s + 6], p0[8 * s + 7])};
                pf[2 + s] = (u32x4){pk(p1[8 * s], p1[8 * s + 1]), pk(p1[8 * s + 2], p1[8 * s + 3]), pk(p1[8 * s + 4], p1[8 * s + 5]), pk(p1[8 * s + 6], p1[8 * s + 7])};
            }
            if (late) pending = true; else AT_PV();
        }
        if (VAR != 1 && VAR != 3 && t + 1 < t_hi) AT_STORE(buf ^ 1);
        __syncthreads();
    }
    if (late && pending) AT_PV();
#undef AT_PV
#undef AT_LOAD
#undef AT_STORE
#if ATT_PRIO
    if (!NA) __builtin_amdgcn_s_setprio(0);
#endif
    l += __shfl_xor(l, 32);
    const float inv = 1.0f / l;
    { float sq = 0.f;
#pragma unroll
      for (int r = 0; r < 16; ++r) { const float a0 = o0[r] * inv, a1 = o1[r] * inv; sq += a0 * a0 + a1 * a1; }
      sq += __shfl_xor(sq, 32);
      if (hi == 0 && ss) (void)__hip_atomic_fetch_add(ss + qtok * 2 + (NA ? 0 : 1), sq, __ATOMIC_RELAXED, __HIP_MEMORY_SCOPE_AGENT); }
    bf16_t* op = O + qtok * 1024 + (NA ? 64 * h : 512 + 64 * h) + 4 * hi;
#pragma unroll
    for (int g = 0; g < 4; ++g) {
        u32x2 w0; w0.x = pk(o0[4 * g] * inv, o0[4 * g + 1] * inv); w0.y = pk(o0[4 * g + 2] * inv, o0[4 * g + 3] * inv);
        u32x2 w1; w1.x = pk(o1[4 * g] * inv, o1[4 * g + 1] * inv); w1.y = pk(o1[4 * g + 2] * inv, o1[4 * g + 3] * inv);
        *(u32x2*)(op + 8 * g) = w0; *(u32x2*)(op + 32 + 8 * g) = w1;
    }
}

constexpr int NPHASE = 14;
struct Args { const float* in[20]; float* out; unsigned char* ws; int ph_lo, ph_hi; };

__global__ void __launch_bounds__(512, 2) mk_fwd(Args a) {
    extern __shared__ __attribute__((aligned(16))) unsigned char lds_raw[];
    LAS unsigned char* lds = (LAS unsigned char*)lds_raw;
    cg::grid_group grid = cg::this_grid();
    const int G = gridDim.x, bx = blockIdx.x, NGW = G * 8;
#define TIDS int tid = threadIdx.x; asm volatile("" : "+v"(tid)); const int lane = tid & 63, wave = __builtin_amdgcn_readfirstlane(tid >> 6), gw = bx * 8 + wave; (void)lane; (void)gw
#define PTRS GAS unsigned char* ws = (GAS unsigned char*)a.ws; asm volatile("" : "+s"(ws)); const float* x = a.in[0]; float* out = a.out; f32x2* cs = (f32x2*)(ws + WS_CS); bf16_t* Wgu1 = (bf16_t*)(ws + WS_WGU1); bf16_t* Wd1 = (bf16_t*)(ws + WS_WD1); bf16_t* Win = (bf16_t*)(ws + WS_WIN); bf16_t* Wuq = (bf16_t*)(ws + WS_WUQ); bf16_t* Wukv = (bf16_t*)(ws + WS_WUKV); bf16_t* Wout = (bf16_t*)(ws + WS_WOUT); bf16_t* Wgu2 = (bf16_t*)(ws + WS_WGU2); bf16_t* Wd2 = (bf16_t*)(ws + WS_WD2); bf16_t* XN = (bf16_t*)(ws + WS_XN); bf16_t* Fb = (bf16_t*)(ws + WS_F); bf16_t* Hb = (bf16_t*)(ws + WS_H); bf16_t* Zb = (bf16_t*)(ws + WS_H); bf16_t* Qm = (bf16_t*)(ws + WS_QM); bf16_t* Km = (bf16_t*)(ws + WS_KM); bf16_t* Vm = (bf16_t*)(ws + WS_VM); bf16_t* CQN = (bf16_t*)(ws + WS_CQN); bf16_t* CKVN = (bf16_t*)(ws + WS_CKVN); bf16_t* HB = (bf16_t*)(ws + WS_HB); float* SS = (float*)(ws + WS_SS); (void)x; (void)out; (void)cs; (void)Wgu1; (void)Wd1; (void)Win; (void)Wuq; (void)Wukv; (void)Wout; (void)Wgu2; (void)Wd2; (void)XN; (void)Fb; (void)Hb; (void)Zb; (void)Qm; (void)Km; (void)Vm; (void)CQN; (void)CKVN; (void)HB; (void)SS
    const int lo = a.ph_lo, hi = a.ph_hi;
#ifndef GEMM_ALIGN
#define GEMM_ALIGN true
#endif
#ifndef GEMM_REP
#define GEMM_REP 1
#endif
#ifndef PH_MASK
#define PH_MASK 0x3fff
#endif
#define IN(k) ((((PH_MASK) >> (k)) & 1) && lo <= (k) && (k) < hi)
    volatile LAS unsigned* bst = (volatile LAS unsigned*)(lds + 131072 + 64);
    if (threadIdx.x < 2) bst[threadIdx.x] = 0u;
    __syncthreads();
    unsigned* barw = (unsigned*)(a.ws + WS_BAR);
    XcdBarrier bar; bar.bar = barw; bar.x = 0; bar.st = bst;
#ifndef SEAM0_CG
#define SEAM0_CG 0
#endif
#if SEAM0_CG
#define SEAM(k) do { if (IN(k) && IN((k) + 1)) { if ((k) == 0) { grid.sync(); bar = xcd_barrier_post(barw, bst); } else xcd_barrier(bar); } } while (0)
#else
    bar = xcd_barrier_post(barw, bst);
#define SEAM(k) do { if (IN(k) && IN((k) + 1)) xcd_barrier(bar); } while (0)
#endif
    using SO = pg8::StaticOrder;

    if (IN(0)) { TIDS; PTRS;
        if (bx == 0) {
            const int pos = tid >> 3, f = tid & 7;
            const float inv = 1.0f / powf(10000.0f, (float)f * 0.125f);
            const float ang = (float)pos * inv;
            const float k = rintf(ang * 0.15915494309189535f);
            float r = fmaf(-k, 6.2831854820251465f, ang); r = fmaf(-k, -1.7484555e-7f, r);
            cs[tid] = (f32x2){__cosf(r), __sinf(r)};
        }
#if SEAM0_CG
        if (bx == 0) for (int i = tid; i < XCD_BAR_WORDS; i += 512) barw[i] = 0u;
#endif
        LAS float* scr = (LAS float*)(lds + wave * 16384);
        constexpr int I_GU = 16 * 176, I_D = 44 * 32, I_IN = 16 * 61, I_UQ = 4 * 24, I_UKV = 2 * 32, I_OUT = 16 * 32;
        constexpr int NITEMS = 2 * I_GU + 2 * I_D + I_IN + I_UQ + I_UKV + I_OUT;
        for (int it = gw; it < NITEMS; it += NGW) {
            int r = it;
            if (r < I_GU) { const int kb = r / 176, nb = r % 176; transpose_item(a.in[2], D, NGU, Wgu1, 64 * kb, 32 * nb, remap_gu(32 * nb), scr, lane); continue; } r -= I_GU;
            if (r < I_GU) { const int kb = r / 176, nb = r % 176; transpose_item(a.in[17], D, NGU, Wgu2, 64 * kb, 32 * nb, remap_gu(32 * nb), scr, lane); continue; } r -= I_GU;
            if (r < I_D) { const int kb = r / 32, nb = r % 32; transpose_item(a.in[3], FF, D, Wd1, 64 * kb, 32 * nb, 32 * nb, scr, lane); continue; } r -= I_D;
            if (r < I_D) { const int kb = r / 32, nb = r % 32; transpose_item(a.in[18], FF, D, Wd2, 64 * kb, 32 * nb, 32 * nb, scr, lane); continue; } r -= I_D;
            if (r < I_IN) { const int kb = r / 61, nb = r % 61; transpose_item(a.in[6], D, DIN, Win, 64 * kb, 32 * nb, 32 * nb, scr, lane); continue; } r -= I_IN;
            if (r < I_UQ) { const int kb = r / 24, nb = r % 24; transpose_item(a.in[9], 256, 768, Wuq, 64 * kb, 32 * nb, 32 * nb, scr, lane); continue; } r -= I_UQ;
            if (r < I_UKV) { const int kb = r / 32, nb = r % 32; transpose_item(a.in[11], 128, 1024, Wukv, 64 * kb, 32 * nb, remap_kv(32 * nb), scr, lane); continue; } r -= I_UKV;
            { const int kb = r / 32, nb = r % 32; transpose_item(a.in[14], D, D, Wout, 64 * kb, 32 * nb, 32 * nb, scr, lane, kb < 8 ? a.in[12] + 64 * kb : a.in[13] + 64 * (kb - 8)); }
        }
        for (int i = bx * 512 + tid; i < M * 2 / 4; i += G * 512) ((f32x4*)SS)[i] = (f32x4){0.f, 0.f, 0.f, 0.f};
        for (int i = bx * 512 + tid; i < (DINP - DIN) * D / 8; i += G * 512) ((u32x4*)(Win + (size_t)DIN * D))[i] = (u32x4){0u, 0u, 0u, 0u};
        { int m = gw; for (; m + 7 * NGW < M; m += 8 * NGW) rows_norm_to_bf16<8>(x, a.in[1], XN, m, NGW, lane); for (; m < M; m += NGW) rows_norm_to_bf16<1>(x, a.in[1], XN, m, NGW, lane); }
    }
    SEAM(0);
    if (IN(1)) { PTRS; pg8::Gemm g{XN, Wgu1, M, NGU, D}; SO S; S.init(M, NGU, G, bx); EpiSwiGLU E{Hb, FF};
        for (int rep_ = 0; rep_ < GEMM_REP; ++rep_) pg8::gemm_phase<EpiSwiGLU, SO, GEMM_ALIGN, true>(lds, g, S, E); }
    SEAM(1);
    if (IN(2)) { PTRS; pg8::Gemm g{Hb, Wd1, M, D, FF}; SO S; S.init(M, D, G, bx); pg8::EpiBf16<0> E{Fb, D, nullptr, 0, 0, 1.f};
        for (int rep_ = 0; rep_ < GEMM_REP; ++rep_) pg8::gemm_phase<pg8::EpiBf16<0>, SO, GEMM_ALIGN, true>(lds, g, S, E); }
    SEAM(2);
    if (IN(3)) { TIDS; PTRS; { int m = gw; for (; m + 3 * NGW < M; m += 4 * NGW) rows_mid<4, true, false, true>(Fb, x, HB, a.in[4], 0.5f, a.in[5], XN, m, NGW, lane); for (; m < M; m += NGW) rows_mid<1, true, false, true>(Fb, x, HB, a.in[4], 0.5f, a.in[5], XN, m, NGW, lane); } }
    SEAM(3);
    if (IN(4)) { PTRS; pg8::Gemm g{XN, Win, M, DINP, D}; SO S; S.init(M, DINP, G, bx); pg8::EpiBf16<0> E{Zb, DINP, nullptr, 0, 0, 1.f};
        for (int rep_ = 0; rep_ < GEMM_REP; ++rep_) pg8::gemm_phase<pg8::EpiBf16<0>, SO, GEMM_ALIGN, true>(lds, g, S, E); }
    SEAM(4);
    if (IN(5)) { TIDS; PTRS; for (int m = gw; m < M; m += NGW) mla_prep_row(Zb + (size_t)m * DINP, m, a.in[8], a.in[10], cs, CQN, CKVN, Km, lane); }
    SEAM(5);
    if (IN(6)) { PTRS;
        { pg8::Gemm g{CQN, Wuq, M, 768, 256}; SO S; S.init(M, 768, G, bx); EpiQ E{Qm, cs}; for (int rep_ = 0; rep_ < GEMM_REP; ++rep_) pg8::gemm_phase<EpiQ, SO, GEMM_ALIGN, true>(lds, g, S, E); }
        { pg8::Gemm g{CKVN, Wukv, M, 1024, 128}; SO S; S.init(M, 1024, G, bx); EpiKV E{Km, Vm}; for (int rep_ = 0; rep_ < GEMM_REP; ++rep_) pg8::gemm_phase<EpiKV, SO, GEMM_ALIGN, true>(lds, g, S, E); }
    }
    SEAM(6);
    if (IN(7)) { PTRS;
#ifndef NA_NAIVE
#define NA_NAIVE 0
#endif
#ifndef MLA_NAIVE
#define MLA_NAIVE 0
#endif
#if NA_NAIVE
        for (int u = bx; u < 512; u += G) na_naive(Zb, a.in[7], XN, u);
#else
#ifndef NA_REP
#define NA_REP 1
#endif
#ifndef MLA_REP
#define MLA_REP 1
#endif
        for (int rep = 0; rep < NA_REP; ++rep) for (int u = bx; u < 1024; u += G) { const int idx = (u >> 8) * 32 + ((u >> 3) & 31), bh = (u & 7) * 8 + (idx >> 4); attn_unit<true>(lds, Zb, Zb, Zb, a.in[7], XN, SS, bh >> 3, bh & 7, idx & 15); }
#endif
#if MLA_NAIVE
        for (int u = bx; u < 512; u += G) mla_naive(lds, Qm, Km, Vm, XN, u);
#else
        for (int rep = 0; rep < MLA_REP; ++rep) for (int u = bx; u < 1024; u += G) { const int idx = (u >> 8) * 32 + ((u >> 3) & 31), bh = (u & 7) * 8 + (idx >> 4); attn_unit<false>(lds, Qm, Km, Vm, nullptr, XN, SS, bh >> 3, bh & 7, idx & 15); }
#endif
#ifdef MLA_PROBE_VAR
        for (int u = bx; u < 1024; u += G) { const int idx = (u >> 8) * 32 + ((u >> 3) & 31), bh = (u & 7) * 8 + (idx >> 4); attn_unit<false, MLA_PROBE_VAR>(lds, Qm, Km, Vm, nullptr, (bf16_t*)out, nullptr, bh >> 3, bh & 7, idx & 15); }
#endif
    }
    SEAM(7);
    if (IN(9)) { PTRS; pg8::Gemm g{XN, Wout, M, D, D}; SO S; S.init(M, D, G, bx); EpiOut E{Fb, D, (const f32x2*)SS};
        for (int rep_ = 0; rep_ < GEMM_REP; ++rep_) pg8::gemm_phase<EpiOut, SO, GEMM_ALIGN, true>(lds, g, S, E); }
    SEAM(9);
    if (IN(10)) { TIDS; PTRS; { int m = gw; for (; m + 7 * NGW < M; m += 8 * NGW) rows_mid<8, true, true, true>(Fb, HB, HB, a.in[15], 1.0f, a.in[16], XN, m, NGW, lane); for (; m < M; m += NGW) rows_mid<1, true, true, true>(Fb, HB, HB, a.in[15], 1.0f, a.in[16], XN, m, NGW, lane); } }
    SEAM(10);
    if (IN(11)) { PTRS; pg8::Gemm g{XN, Wgu2, M, NGU, D}; SO S; S.init(M, NGU, G, bx); EpiSwiGLU E{Hb, FF};
        for (int rep_ = 0; rep_ < GEMM_REP; ++rep_) pg8::gemm_phase<EpiSwiGLU, SO, GEMM_ALIGN, true>(lds, g, S, E); }
    SEAM(11);
    if (IN(12)) { PTRS; pg8::Gemm g{Hb, Wd2, M, D, FF}; SO S; S.init(M, D, G, bx); pg8::EpiBf16<0> E{Fb, D, nullptr, 0, 0, 1.f};
        for (int rep_ = 0; rep_ < GEMM_REP; ++rep_) pg8::gemm_phase<pg8::EpiBf16<0>, SO, GEMM_ALIGN, true>(lds, g, S, E); }
    SEAM(12);
    if (IN(13)) { TIDS; PTRS; { int m = gw; for (; m + 7 * NGW < M; m += 8 * NGW) rows_mid<8, false, true, false>(Fb, HB, out, a.in[19], 0.5f, nullptr, nullptr, m, NGW, lane); for (; m < M; m += NGW) rows_mid<1, false, true, false>(Fb, HB, out, a.in[19], 0.5f, nullptr, nullptr, m, NGW, lane); } }
#undef IN
#undef SEAM
}
}

#ifndef MK_MULTI
#define MK_MULTI 0
#endif
extern "C" void kernel_launch(void* const* d_in, const int* in_sizes, int n_in, void* d_out, int out_size, void* d_ws, size_t ws_size, hipStream_t stream) {
    static int grid = 0;
    if (grid == 0) {
        if (n_in != 20 || out_size != mk::M * mk::D || ws_size < mk::WS_END) { fprintf(stderr, "kernel_launch: unexpected shapes (n_in %d out %d ws %zu)\n", n_in, out_size, ws_size); grid = -1; return; }
        int dev = 0, cus = 0, per_cu = 0;
        (void)hipGetDevice(&dev); (void)hipDeviceGetAttribute(&cus, hipDeviceAttributeMultiprocessorCount, dev);
        if (hipFuncSetAttribute((const void*)mk::mk_fwd, hipFuncAttributeMaxDynamicSharedMemorySize, mk::LDS_BYTES) != hipSuccess) { fprintf(stderr, "kernel_launch: hipFuncSetAttribute failed\n"); grid = -1; return; }
        if (hipOccupancyMaxActiveBlocksPerMultiprocessor(&per_cu, (const void*)mk::mk_fwd, 512, mk::LDS_BYTES) != hipSuccess || per_cu < 1) { fprintf(stderr, "kernel_launch: occupancy query says %d\n", per_cu); grid = -1; (void)hipGetLastError(); return; }
        grid = cus;
    }
    if (grid < 0) return;
    mk::Args a{};
    for (int i = 0; i < 20; ++i) a.in[i] = (const float*)d_in[i];
    a.out = (float*)d_out; a.ws = (unsigned char*)d_ws;
#if MK_MULTI
    for (int ph = 0; ph < mk::NPHASE; ++ph) { a.ph_lo = ph; a.ph_hi = ph + 1; hipLaunchKernelGGL(mk::mk_fwd, dim3(grid), dim3(512), mk::LDS_BYTES, stream, a); }
#else
    a.ph_lo = 0; a.ph_hi = mk::NPHASE;
#if SEAM0_CG
    void* args[] = {&a};
    hipError_t e = hipLaunchCooperativeKernel((const void*)mk::mk_fwd, dim3(grid), dim3(512), args, mk::LDS_BYTES, stream);
    if (e != hipSuccess) fprintf(stderr, "kernel_launch: cooperative launch failed: %s\n", hipGetErrorString(e));
#else
    if (hipMemsetAsync((char*)d_ws + mk::WS_BAR, 0, XCD_BAR_WORDS * 4, stream) != hipSuccess) { fprintf(stderr, "kernel_launch: memset failed\n"); return; }
    hipLaunchKernelGGL(mk::mk_fwd, dim3(grid), dim3(512), mk::LDS_BYTES, stream, a);
#endif
#endif
}
```
